# Optimizing an MI355X kernel written in HIP

```python
import jax, jax.numpy as jnp
from jax import lax
import numpy as np

D_MODEL = 1024
BATCH = 8
SEQ = 4096
DEPTH = 2

FOX_HEADS = 8
FOX_HEAD_DIM = 64
FOX_WIDTH = FOX_HEADS * FOX_HEAD_DIM
FOX_BLOCK = 128
MLSTM_HEADS = 4
MLSTM_HEAD_DIM = 128
MLSTM_WIDTH = MLSTM_HEADS * MLSTM_HEAD_DIM
MLSTM_CHUNK = 128
MLSTM_CONV = 4
SGU_GROUPS = 4
SGU_WIDTH = 512
SGU_GROUP_DIM = SGU_WIDTH // SGU_GROUPS
SGU_CHUNK = 128
N_BRANCH = 3
BRANCH_WIDTH = 512
N_GROUPS = 4
EXPERTS_PER_GROUP = 8
N_EXPERTS = N_GROUPS * EXPERTS_PER_GROUP
TOP_K = 2
D_EXPERT = 512
MOE_BLOCK = 128
DEEPNORM_ALPHA = (2 * DEPTH) ** 0.25
DEEPNORM_BETA = (8 * DEPTH) ** -0.25
LN_EPS = 1e-5
FORGET_BIAS = 3.0
NEG_INF = -1e30

IN_SIZES = (3 * FOX_WIDTH, FOX_HEADS, 2 * MLSTM_WIDTH, MLSTM_WIDTH, MLSTM_WIDTH,
            2 * MLSTM_HEADS, 2 * SGU_WIDTH, N_BRANCH * D_MODEL)
D_IN = sum(IN_SIZES)

kernel_name = "fox_mlstm_sgu_gated_hier_moe_deepnorm"


def layer_norm(x, g, b):
    xf = x.astype(jnp.float32)
    mu = xf.mean(-1, keepdims=True)
    var = jnp.square(xf - mu).mean(-1, keepdims=True)
    return ((xf - mu) * lax.rsqrt(var + LN_EPS) * g.astype(jnp.float32) + b.astype(jnp.float32)).astype(x.dtype)


def split_cols(h, sizes):
    idx = [int(c) for c in np.cumsum(sizes)[:-1]]
    return jnp.split(h, idx, axis=-1)


def causal_conv(x, w):
    kw = w.shape[0]
    s = x.shape[1]
    xp = jnp.pad(x, ((0, 0), (kw - 1, 0), (0, 0)))
    y = xp[:, 0:s] * w[0]
    for j in range(1, kw):
        y = y + xp[:, j:j + s] * w[j]
    return y


def fox_attention(q, k, v, log_f):
    b, s, h, dh = q.shape
    L = FOX_BLOCK
    nb = s // L
    f32 = jnp.float32
    F = jnp.cumsum(log_f.astype(f32), axis=1)

    def to_blocks(t):
        return t.reshape(b, nb, L, h, dh).transpose(1, 0, 3, 2, 4).astype(f32)

    qb = to_blocks(q) * (dh ** -0.5)
    kb = to_blocks(k)
    vb = to_blocks(v)
    Fb = F.reshape(b, nb, L, h).transpose(1, 0, 3, 2)
    pos = jnp.arange(L)

    def query_block(args):
        i, q_i, F_i = args

        def key_block(j, carry):
            m, l, acc = carry
            logits = jnp.einsum('bhqd,bhkd->bhqk', q_i, kb[j]) + F_i[..., :, None] - Fb[j][..., None, :]
            causal = (i * L + pos)[:, None] >= (j * L + pos)[None, :]
            logits = jnp.where(causal, logits, NEG_INF)
            m_new = jnp.maximum(m, logits.max(-1))
            p = jnp.exp(logits - m_new[..., None])
            corr = jnp.exp(m - m_new)
            return (m_new, l * corr + p.sum(-1),
                    acc * corr[..., None] + jnp.einsum('bhqk,bhkd->bhqd', p, vb[j]))

        init = (jnp.full((b, h, L), NEG_INF, f32), jnp.zeros((b, h, L), f32), jnp.zeros((b, h, L, dh), f32))
        m, l, acc = lax.fori_loop(0, i + 1, key_block, init)
        return acc / l[..., None]

    out = lax.map(query_block, (jnp.arange(nb), qb, Fb))
    return out.transpose(1, 0, 3, 2, 4).reshape(b, s, h * dh).astype(q.dtype)


def mlstm_chunkwise(q, k, v, i_pre, f_pre):
    b, s, h, dh = q.shape
    L = MLSTM_CHUNK
    nc = s // L
    f32 = jnp.float32

    def chunks(t):
        return t.reshape(b, nc, L, h, dh).transpose(1, 0, 3, 2, 4).astype(f32)

    def gchunks(t):
        return t.astype(f32).reshape(b, nc, L, h).transpose(1, 0, 3, 2)

    qc = chunks(q)
    kc = chunks(k) * (dh ** -0.5)
    vc = chunks(v)
    log_f = gchunks(jax.nn.log_sigmoid(f_pre.astype(f32)))
    log_i = gchunks(i_pre)
    causal = jnp.tril(jnp.ones((L, L), bool))

    def step(carry, xs):
        C, n, m = carry
        q_c, k_c, v_c, lf, li = xs
        bcum = jnp.cumsum(lf, axis=-1)
        D = jnp.where(causal, bcum[..., :, None] - bcum[..., None, :] + li[..., None, :], NEG_INF)
        inter = bcum + m[..., None]
        m_t = jnp.maximum(inter, D.max(-1))
        w_intra = jnp.exp(D - m_t[..., None])
        w_inter = jnp.exp(inter - m_t)
        qk = jnp.einsum('bhtd,bhsd->bhts', q_c, k_c) * w_intra
        num = jnp.einsum('bhts,bhse->bhte', qk, v_c) + w_inter[..., None] * jnp.einsum('bhtd,bhde->bhte', q_c, C)
        den = qk.sum(-1) + w_inter * jnp.einsum('bhtd,bhd->bht', q_c, n)
        h_c = num / jnp.maximum(jnp.abs(den), jnp.exp(-m_t))[..., None]
        b_last = bcum[..., -1]
        g = b_last[..., None] - bcum + li
        m_new = jnp.maximum(b_last + m, g.max(-1))
        decay = jnp.exp(b_last + m - m_new)
        w_k = jnp.exp(g - m_new[..., None])
        C_new = decay[..., None, None] * C + jnp.einsum('bhs,bhsd,bhse->bhde', w_k, k_c, v_c)
        n_new = decay[..., None] * n + jnp.einsum('bhs,bhsd->bhd', w_k, k_c)
        return (C_new, n_new, m_new), h_c

    init = (jnp.zeros((b, h, dh, dh), f32), jnp.zeros((b, h, dh), f32), jnp.zeros((b, h), f32))
    _, hs = lax.scan(step, init, (qc, kc, vc, log_f, log_i))
    return hs.transpose(1, 0, 3, 2, 4).reshape(b, s, h * dh).astype(q.dtype)


def spatial_gating(u, v, ln_g, ln_b, w_s, b_s):
    v = layer_norm(v, ln_g, ln_b)
    b, s, _ = v.shape
    nc = s // SGU_CHUNK
    vg = v.reshape(b, nc, SGU_CHUNK, SGU_GROUPS, SGU_GROUP_DIM)
    w = jnp.where(jnp.tril(jnp.ones((SGU_CHUNK, SGU_CHUNK), bool)), w_s, 0.0)
    z = jnp.einsum('gts,bnsgc->bntgc', w, vg) + b_s.T[None, None, :, :, None]
    return u * z.reshape(b, s, SGU_WIDTH)


def mixing_sublayer(x, w_in, b_in, conv_w, sgu_ln_g, sgu_ln_b, sgu_w, sgu_b, w_branch, w_out):
    b, s, _ = x.shape
    h = x @ w_in + b_in
    fox_qkv, fox_f, ml_qk, ml_v, ml_o, ml_if, sgu_uv, gate_pre = split_cols(h, IN_SIZES)
    fq, fk, fv = jnp.split(fox_qkv, 3, axis=-1)
    hs = (b, s, FOX_HEADS, FOX_HEAD_DIM)
    y_a = fox_attention(fq.reshape(hs), fk.reshape(hs), fv.reshape(hs),
                        jax.nn.log_sigmoid(fox_f.astype(jnp.float32)))
    mq, mk = jnp.split(jax.nn.silu(causal_conv(ml_qk, conv_w)), 2, axis=-1)
    mi, mf = jnp.split(ml_if, 2, axis=-1)
    ms = (b, s, MLSTM_HEADS, MLSTM_HEAD_DIM)
    y_b = jax.nn.sigmoid(ml_o) * mlstm_chunkwise(mq.reshape(ms), mk.reshape(ms), ml_v.reshape(ms), mi, mf)
    u, v = jnp.split(jax.nn.gelu(sgu_uv), 2, axis=-1)
    y_c = spatial_gating(u, v, sgu_ln_g, sgu_ln_b, sgu_w, sgu_b)
    branches = jnp.stack([y_a, y_b, y_c])
    proj = jnp.einsum('nbsc,ncd->nbsd', branches, w_branch)
    gates = jax.nn.sigmoid(gate_pre.reshape(b, s, N_BRANCH, D_MODEL))
    merged = jnp.einsum('nbsd,bsnd->bsd', proj, gates)
    return merged @ w_out


def hierarchical_moe(x, w_group, b_group, w_router, b_router, w_gate, w_up, w_down):
    b, s, d = x.shape
    t = x.reshape(-1, d)
    T = t.shape[0]
    f32 = jnp.float32
    logits_g = (t @ w_group + b_group).astype(f32)
    p_g = jax.nn.softmax(logits_g, axis=-1)
    g_top = jnp.argmax(logits_g, axis=-1)
    p_gsel = jnp.take_along_axis(p_g, g_top[:, None], axis=-1)
    logits_e = (t @ w_router + b_router).astype(f32).reshape(T, N_GROUPS, EXPERTS_PER_GROUP)
    logits_e = jnp.take_along_axis(logits_e, g_top[:, None, None], axis=1)[:, 0]
    p_e = jax.nn.softmax(logits_e, axis=-1)
    top_p, top_j = lax.top_k(p_e, TOP_K)
    gate = p_gsel * top_p / top_p.sum(-1, keepdims=True)
    expert = g_top[:, None] * EXPERTS_PER_GROUP + top_j
    A = T * TOP_K
    e_flat = expert.reshape(-1)
    tok = jnp.repeat(jnp.arange(T), TOP_K)
    gw = gate.reshape(-1)
    order = jnp.argsort(e_flat)
    e_sorted = e_flat[order]
    tok_sorted = tok[order]
    gw_sorted = gw[order]
    counts = jnp.bincount(e_flat, length=N_EXPERTS)
    padded = (counts + MOE_BLOCK - 1) // MOE_BLOCK * MOE_BLOCK
    start = jnp.cumsum(counts) - counts
    pend = jnp.cumsum(padded)
    pstart = pend - padded
    dest = pstart[e_sorted] + (jnp.arange(A) - start[e_sorted])
    n_blocks = -(-A // MOE_BLOCK) + N_EXPERTS
    rows = jnp.zeros((n_blocks * MOE_BLOCK, d), x.dtype).at[dest].set(t[tok_sorted])
    block_expert = jnp.minimum(jnp.searchsorted(pend, jnp.arange(n_blocks) * MOE_BLOCK, side='right'),
                               N_EXPERTS - 1)

    def expert_block(args):
        xb, e = args
        hid = jax.nn.silu(xb @ w_gate[e]) * (xb @ w_up[e])
        return hid @ w_down[e]

    y = lax.map(expert_block, (rows.reshape(n_blocks, MOE_BLOCK, d), block_expert)).reshape(-1, d)
    out = jnp.zeros_like(t).at[tok_sorted].add(gw_sorted[:, None].astype(t.dtype) * y[dest])
    return out.reshape(b, s, d)


def setup_inputs(seed: int = 0) -> dict:
    key = jax.random.key(seed)
    ks = jax.random.split(key, 24)
    f32 = jnp.float32
    nrm = lambda k, shape, scale: (jax.random.normal(k, shape, f32) * scale)
    L = DEPTH
    bias_offset = jnp.concatenate([
        jnp.zeros((3 * FOX_WIDTH,), f32), jnp.full((FOX_HEADS,), FORGET_BIAS, f32),
        jnp.zeros((4 * MLSTM_WIDTH + MLSTM_HEADS,), f32), jnp.full((MLSTM_HEADS,), FORGET_BIAS, f32),
        jnp.zeros((2 * SGU_WIDTH + N_BRANCH * D_MODEL,), f32)])
    return {
        "x": nrm(ks[0], (BATCH, SEQ, D_MODEL), 1.0),
        "ln_in_g": 1.0 + nrm(ks[1], (D_MODEL,), 0.01),
        "ln_in_b": nrm(ks[2], (D_MODEL,), 0.01),
        "w_in": nrm(ks[3], (L, D_MODEL, D_IN), D_MODEL ** -0.5),
        "b_in": nrm(ks[4], (L, D_IN), 0.02) + bias_offset,
        "conv_w": nrm(ks[5], (L, MLSTM_CONV, 2 * MLSTM_WIDTH), MLSTM_CONV ** -0.5),
        "sgu_ln_g": 1.0 + nrm(ks[6], (L, SGU_WIDTH), 0.01),
        "sgu_ln_b": nrm(ks[7], (L, SGU_WIDTH), 0.01),
        "sgu_w": nrm(ks[8], (L, SGU_GROUPS, SGU_CHUNK, SGU_CHUNK), SGU_CHUNK ** -0.5),
        "sgu_b": 1.0 + nrm(ks[9], (L, SGU_GROUPS, SGU_CHUNK), 0.01),
        "w_branch": nrm(ks[10], (L, N_BRANCH, BRANCH_WIDTH, D_MODEL), BRANCH_WIDTH ** -0.5),
        "w_out": nrm(ks[11], (L, D_MODEL, D_MODEL), DEEPNORM_BETA * D_MODEL ** -0.5),
        "ln1_g": 1.0 + nrm(ks[12], (L, D_MODEL), 0.01),
        "ln1_b": nrm(ks[13], (L, D_MODEL), 0.01),
        "w_group": nrm(ks[14], (L, D_MODEL, N_GROUPS), D_MODEL ** -0.5),
        "b_group": nrm(ks[15], (L, N_GROUPS), 0.01),
        "w_router": nrm(ks[16], (L, D_MODEL, N_EXPERTS), D_MODEL ** -0.5),
        "b_router": nrm(ks[17], (L, N_EXPERTS), 0.01),
        "w_gate": nrm(ks[18], (L, N_EXPERTS, D_MODEL, D_EXPERT), D_MODEL ** -0.5),
        "w_up": nrm(ks[19], (L, N_EXPERTS, D_MODEL, D_EXPERT), D_MODEL ** -0.5),
        "w_down": nrm(ks[20], (L, N_EXPERTS, D_EXPERT, D_MODEL), DEEPNORM_BETA * D_EXPERT ** -0.5),
        "ln2_g": 1.0 + nrm(ks[21], (L, D_MODEL), 0.01),
        "ln2_b": nrm(ks[22], (L, D_MODEL), 0.01),
    }


def reference(x, ln_in_g, ln_in_b, w_in, b_in, conv_w, sgu_ln_g, sgu_ln_b, sgu_w, sgu_b, w_branch, w_out,
              ln1_g, ln1_b, w_group, b_group, w_router, b_router, w_gate, w_up, w_down, ln2_g, ln2_b):
    x = layer_norm(x, ln_in_g, ln_in_b)
    for l in range(DEPTH):
        mix = mixing_sublayer(x, w_in[l], b_in[l], conv_w[l], sgu_ln_g[l], sgu_ln_b[l], sgu_w[l], sgu_b[l],
                              w_branch[l], w_out[l])
        x = layer_norm(DEEPNORM_ALPHA * x + mix, ln1_g[l], ln1_b[l])
        ffn = hierarchical_moe(x, w_group[l], b_group[l], w_router[l], b_router[l], w_gate[l], w_up[l], w_down[l])
        x = layer_norm(DEEPNORM_ALPHA * x + ffn, ln2_g[l], ln2_b[l])
    return x
```

```cpp
#include <hip/hip_runtime.h>
#ifndef PROBE_PH
#define PROBE_PH -1
#endif
#ifndef SOLO_PH
#define SOLO_PH -1
#endif
#ifndef SKIP_PH
#define SKIP_PH -1
#endif
#include <cstdio>
#include <cstdint>
#include <utility>

namespace pg8 {
#define PG8_LAS __attribute__((address_space(3)))
typedef unsigned short bf16_t;
typedef short bf16x8 __attribute__((ext_vector_type(8)));
typedef float f32x4 __attribute__((ext_vector_type(4)));
typedef float f32x2 __attribute__((ext_vector_type(2)));
typedef unsigned u32x4 __attribute__((ext_vector_type(4)));
typedef int i32x4 __attribute__((ext_vector_type(4)));
typedef int i32x8 __attribute__((ext_vector_type(8)));
constexpr int BM = 256, BK = 64, HALF = 128, HTB = HALF * BK * 2  , STAGE_BYTES = 8 * HTB;

__host__ __device__ __forceinline__ int lds_byte(int r, int c) { const int st = (r >> 4) * 2 + (c >> 5), rr = r & 15, cc = c & 31, ob = rr * 64 + cc * 2; return st * 1024 + (ob ^ (((ob >> 9) & 1) << 5)); }
__host__ __device__ __forceinline__ void stage_rc(int b, int& R, int& C) { const int st = b / 1024, sb = b % 1024, swz = sb ^ (((sb >> 9) & 1) << 5); R = (st >> 1) * 16 + swz / 64; C = (st & 1) * 32 + (swz % 64) / 2; }
__host__ __device__ __forceinline__ int perm32(int rho) { const int n = rho >> 4, i = rho & 15; return 8 * (i >> 2) + 4 * n + (i & 3); }

struct Unit { int pm, pn, ex, nv, gt; };

__device__ __forceinline__ unsigned cvt_pk_bf16(float lo, float hi) { unsigned r; asm volatile("v_cvt_pk_bf16_f32 %0, %1, %2" : "=v"(r) : "v"(lo), "v"(hi)); return r; }

template <class Epi, class Sched>
__device__ __forceinline__ void gemm_phase(PG8_LAS unsigned char* lds, int tid_, const Sched& S, const Epi& E) {
    asm volatile("" : "+v"(tid_));
    const int tid = tid_, wid = __builtin_amdgcn_readfirstlane(tid >> 6), lane = tid & 63, wr = wid >> 2, wc = wid & 3, fr = lane & 15, fq = lane >> 4;
    const int nt = S.ktiles();
    const int lda = S.lda(), ldb = S.ldb();
    unsigned voffA[2][2], voffAn[2][2], voffB[2]; int Rl[2], Cl[2];
#pragma unroll
    for (int i = 0; i < 2; ++i) { stage_rc(tid * 16 + i * 8192, Rl[i], Cl[i]); const int Rb = Epi::PERM ? ((Rl[i] & ~31) + perm32(Rl[i] & 31)) : Rl[i];
        voffB[i] = (unsigned)(Rb * ldb + Cl[i]) * 2u; }
#define PG8_SETA(vo, u) do { int t_ = tid; asm volatile("" : "+v"(t_)); _Pragma("unroll") for (int i_ = 0; i_ < 2; ++i_) { int R_, C_; stage_rc(t_ * 16 + i_ * 8192, R_, C_);     \
        _Pragma("unroll") for (int h_ = 0; h_ < 2; ++h_) { \
        if constexpr (Sched::GATHER) vo[h_][i_] = S.rowoff(u, h_ * HALF + R_) + (unsigned)C_ * 2u; else vo[h_][i_] = (unsigned)((h_ * HALF + R_) * lda + C_) * 2u; } } } while (0)
    const size_t kstep = (size_t)(BK * 2);
    const size_t hstepB = (size_t)HALF * ldb * 2;
    const unsigned ldsw = (unsigned)wid * 1024u;
    constexpr bool F8 = Epi::F8, I8 = Epi::I8; constexpr int KOFF = F8 ? 16 : 1024;
    const int aoff = lds_byte(wr * 64 + fr, F8 ? fq * 16 : fq * 8), boff = lds_byte(wc * 32 + fr, F8 ? fq * 16 : fq * 8);
#define PG8_SA(b, h) (((b) * 2 + (h)) * HTB)
#define PG8_SB(b, h) ((4 + (b) * 2 + (h)) * HTB)
#define PG8_STAGE(bufoff, gbase, voff) do { const char* gb_ = (const char*)(gbase); asm volatile("" : "+s"(gb_)); _Pragma("unroll") for (int _i = 0; _i < 2; ++_i) { \
        unsigned vo_ = (voff)[_i]; asm volatile("" : "+v"(vo_));     \
        __builtin_amdgcn_global_load_lds((const unsigned*)(gb_ + vo_), (PG8_LAS unsigned*)(lds + (bufoff) + ldsw + _i * 8192), 16, 0, 0); } } while (0)
#define PG8_LDA(dst, b, h) do { _Pragma("unroll") for (int m = 0; m < 4; ++m) _Pragma("unroll") for (int k = 0; k < 2; ++k) dst[m][k] = *(const PG8_LAS bf16x8*)(lds + PG8_SA(b, h) + aoff + m * 2048 + k * KOFF); } while (0)
#define PG8_LDB(dst, b, h) do { _Pragma("unroll") for (int n = 0; n < 2; ++n) _Pragma("unroll") for (int k = 0; k < 2; ++k) dst[n][k] = *(const PG8_LAS bf16x8*)(lds + PG8_SB(b, h) + boff + n * 2048 + k * KOFF); } while (0)
#define PG8_CAT(X) __builtin_shufflevector(__builtin_bit_cast(i32x4, X[0]), __builtin_bit_cast(i32x4, X[1]), 0, 1, 2, 3, 4, 5, 6, 7)
#define PG8_MMA(ai, bj, At, Bt) do { __builtin_amdgcn_s_setprio(1); _Pragma("unroll") for (int m = 0; m < 4; ++m) _Pragma("unroll") for (int n = 0; n < 2; ++n) { \
        if constexpr (F8) acc[ai][bj][m][n] = __builtin_amdgcn_mfma_scale_f32_16x16x128_f8f6f4(PG8_CAT(Bt[n]), PG8_CAT(At[m]), acc[ai][bj][m][n], 0, 0, 0, 0x7f7f7f7f, 0, 0x7f7f7f7f); \
        else if constexpr (I8) { _Pragma("unroll") for (int k = 0; k < 2; ++k) acc[ai][bj][m][n] = __builtin_bit_cast(f32x4, __builtin_amdgcn_mfma_i32_16x16x64_i8(__builtin_bit_cast(i32x4, Bt[n][k]), __builtin_bit_cast(i32x4, At[m][k]), __builtin_bit_cast(i32x4, acc[ai][bj][m][n]), 0, 0, 0)); } \
        else { _Pragma("unroll") for (int k = 0; k < 2; ++k) acc[ai][bj][m][n] = __builtin_amdgcn_mfma_f32_16x16x32_bf16(Bt[n][k], At[m][k], acc[ai][bj][m][n], 0, 0, 0); } } __builtin_amdgcn_s_setprio(0); } while (0)
#define PG8_WAIT_V(n) asm volatile("s_waitcnt vmcnt(" #n ")" ::: "memory")
#define PG8_WAIT_L(n) asm volatile("s_waitcnt lgkmcnt(" #n ")" ::: "memory")
#define PG8_BAR __builtin_amdgcn_s_barrier()
#define PG8_SCHED __builtin_amdgcn_sched_barrier(0)
    Unit cur, nxt; int ui = 0;
    if (!S.next(0, cur)) return;
    PG8_SETA(voffA, cur);
    f32x4 acc[2][2][4][2];
#pragma unroll
    for (int a = 0; a < 2; ++a)
#pragma unroll
        for (int b = 0; b < 2; ++b)
#pragma unroll
            for (int m = 0; m < 4; ++m)
#pragma unroll
                for (int n = 0; n < 2; ++n) acc[a][b][m][n] = (f32x4){0.f, 0.f, 0.f, 0.f};
    bf16x8 At[4][2], B0[2][2], B1[2][2];
    {
        const char* cA = S.aptr(cur, 0); const char* cB = S.bptr(cur, 0); const char* cA1 = S.aptr(cur, 1); const char* cB1 = S.bptr(cur, 1);
        PG8_STAGE(PG8_SB(0, 0), cB, voffB); PG8_STAGE(PG8_SB(0, 1), cB + hstepB, voffB); PG8_STAGE(PG8_SA(0, 0), cA, voffA[0]); PG8_STAGE(PG8_SA(0, 1), cA, voffA[1]);
        if (wr == 1) PG8_BAR;
        PG8_WAIT_V(2); PG8_BAR;
        PG8_STAGE(PG8_SB(1, 0), cB1, voffB); PG8_STAGE(PG8_SA(1, 0), cA1, voffA[0]); PG8_STAGE(PG8_SB(1, 1), cB1 + hstepB, voffB);
        PG8_WAIT_V(6); PG8_BAR;
    }
    for (;;) {
        const bool has_next = S.next(ui + 1, nxt);
        const Unit& nu = has_next ? nxt : cur;
        if constexpr (Sched::GATHER) { if (has_next) PG8_SETA(voffAn, nxt); else { _Pragma("unroll") for (int h_ = 0; h_ < 2; ++h_) _Pragma("unroll") for (int i_ = 0; i_ < 2; ++i_) voffAn[h_][i_] = voffA[h_][i_]; } }
        const int seglen = Epi::HAS_MID ? Epi::SEG : nt;
        _Pragma("nounroll") for (int tb = 0; tb < nt; tb += seglen) {
        if constexpr (Epi::HAS_MID) { if (tb > 0) E.mid(acc, cur, tb, wr, wc, fr, fq); }
        _Pragma("nounroll") for (int t = tb; t < tb + seglen; t += 2) {
            const bool last = (t == nt - 2);
            const char* a1 = S.aptr(cur, t + 1);
            const char* a2 = last ? S.aptr(nu, 0) : S.aptr(cur, t + 2); const char* b2 = last ? S.bptr(nu, 0) : S.bptr(cur, t + 2);
            const char* a3 = last ? S.aptr(nu, 1) : S.aptr(cur, t + 3); const char* b3 = last ? S.bptr(nu, 1) : S.bptr(cur, t + 3);
            const unsigned lmask_ = last ? 0xffffffffu : 0u;
            PG8_LDB(B0, 0, 0); PG8_LDB(B1, 0, 1); PG8_SCHED; PG8_LDA(At, 0, 0); PG8_STAGE(PG8_SA(1, 1), a1, voffA[1]);
            if constexpr (Sched::GATHER) { _Pragma("unroll") for (int h_ = 0; h_ < 2; ++h_) _Pragma("unroll") for (int i_ = 0; i_ < 2; ++i_) voffA[h_][i_] ^= (voffA[h_][i_] ^ voffAn[h_][i_]) & lmask_; }
            PG8_WAIT_V(8); PG8_WAIT_L(0); PG8_BAR; PG8_MMA(0, 0, At, B0); PG8_MMA(0, 1, At, B1); PG8_BAR; PG8_SCHED;
            PG8_LDA(At, 0, 1); PG8_STAGE(PG8_SB(0, 0), b2, voffB); PG8_STAGE(PG8_SB(0, 1), b2 + hstepB, voffB); PG8_STAGE(PG8_SA(0, 0), a2, voffA[0]);
            PG8_WAIT_V(8); PG8_WAIT_L(0); PG8_BAR; PG8_MMA(1, 0, At, B0); PG8_MMA(1, 1, At, B1); PG8_BAR; PG8_SCHED;
            PG8_LDB(B0, 1, 0); PG8_LDB(B1, 1, 1); PG8_SCHED; PG8_LDA(At, 1, 0); PG8_STAGE(PG8_SA(0, 1), a2, voffA[1]);
            PG8_WAIT_V(8); PG8_WAIT_L(0); PG8_BAR; PG8_MMA(0, 0, At, B0); PG8_MMA(0, 1, At, B1); PG8_BAR; PG8_SCHED;
            PG8_LDA(At, 1, 1); PG8_STAGE(PG8_SB(1, 0), b3, voffB); PG8_STAGE(PG8_SB(1, 1), b3 + hstepB, voffB); PG8_STAGE(PG8_SA(1, 0), a3, voffA[0]);
            PG8_WAIT_V(8); PG8_WAIT_L(0); PG8_BAR; PG8_MMA(1, 0, At, B0); PG8_MMA(1, 1, At, B1); PG8_BAR; PG8_SCHED;
        }
        }
        if (wr == 0) PG8_BAR;
        { int t_ = tid; asm volatile("" : "+v"(t_)); E(acc, cur, wr, wc, t_ & 15, (t_ & 63) >> 4); }
        if (!has_next) break;
#pragma unroll
        for (int a = 0; a < 2; ++a)
#pragma unroll
            for (int b = 0; b < 2; ++b)
#pragma unroll
                for (int m = 0; m < 4; ++m)
#pragma unroll
                    for (int n = 0; n < 2; ++n) acc[a][b][m][n] = (f32x4){0.f, 0.f, 0.f, 0.f};
        cur = nxt; ++ui;
        if constexpr (Sched::GATHER) { _Pragma("unroll") for (int h_ = 0; h_ < 2; ++h_) _Pragma("unroll") for (int i_ = 0; i_ < 2; ++i_) voffA[h_][i_] = voffAn[h_][i_]; }
        if (wr == 1) PG8_BAR;
    }
    PG8_WAIT_V(0);
    PG8_BAR;
#undef PG8_SETA
#undef PG8_SA
#undef PG8_SB
#undef PG8_STAGE
#undef PG8_LDA
#undef PG8_LDB
#undef PG8_MMA
#undef PG8_CAT
#undef PG8_WAIT_V
#undef PG8_WAIT_L
#undef PG8_BAR
#undef PG8_SCHED
}
}


constexpr int NWAVES = 8, NTHR = 512;
constexpr int D = 1024, BATCH = 8, SEQ = 4096, T = BATCH * SEQ, DEPTH = 2;
constexpr int DIN = 7696, NH = 7680;
constexpr int NEXP = 32, DEXP = 512;
constexpr float ALPHA = 1.41421356237309515f;
constexpr float LN_EPS = 1e-5f;
constexpr float LOG2E = 1.4426950408889634f;
constexpr float QSCALE = 0.125f * LOG2E;
constexpr int MAXROWS = 73728, MAXTILES = MAXROWS / 256;

constexpr size_t MiB = 1u << 20;
constexpr size_t WS_CTL = 0, CTL_ZERO_BYTES = 1 * MiB;
constexpr size_t WS_BIAS = 1 * MiB;
constexpr size_t WS_WIN = 2 * MiB, WS_WBR = 18 * MiB, WS_WOUT = 21 * MiB;
constexpr size_t WS_XB = 24 * MiB;
constexpr size_t WS_SM = 88 * MiB;
constexpr size_t WS_LFOX = WS_SM;
constexpr size_t WS_FC = WS_SM + 1 * MiB;
constexpr size_t WS_MLI = WS_SM + 2 * MiB;
constexpr size_t WS_MLF = WS_SM + 2 * MiB + 512 * 1024;
constexpr size_t WS_MST = WS_SM + 3 * MiB;
constexpr size_t WS_NV = WS_SM + 3 * MiB + 64 * 1024;
constexpr size_t WS_TOKE = WS_SM + 4 * MiB;
constexpr size_t WS_TOKP = WS_SM + 4 * MiB + 256 * 1024;
constexpr size_t WS_TOKG = WS_SM + 4 * MiB + 512 * 1024;
constexpr size_t WS_ENT = WS_SM + 5 * MiB;
constexpr size_t WS_SGUW = WS_SM + 7 * MiB;
constexpr size_t WS_WRT = WS_SM + 7 * MiB + 256 * 1024;
constexpr size_t WS_H = 96 * MiB, SEGB = 32 * MiB;
constexpr size_t SEGE = (size_t)T * 512;
enum Seg { S_Q = 0, S_K = 1, S_V = 2, S_MLQ = 3, S_MLK = 4, S_MLV = 5, S_MLO = 6, S_SU = 7, S_SV = 8, S_G0 = 9 };
constexpr size_t WS_MERGED = WS_H + 1 * SEGB;
constexpr size_t WS_ENT2 = WS_H;
constexpr size_t WS_HID = WS_H + 144 * MiB;
constexpr size_t WS_YBUF = WS_H + 216 * MiB;
constexpr size_t WS_WD = WS_H + 448 * MiB;
constexpr size_t WS_XB8 = WS_H + 384 * MiB;
constexpr size_t WS_SA = WS_SM + 6 * MiB;
constexpr size_t WS_END = WS_H + 480 * MiB;
constexpr int CW_BAR = 4096;
constexpr int CW_CNT = 16384;
constexpr int CW_CMAX = 32768;

constexpr int RING_BYTES = 131072;
constexpr int LDS_BYTES = 147456;
constexpr int LDSCTL_OFF = LDS_BYTES - 1024, MISC_OFF = LDSCTL_OFF + 320;
constexpr int XTRA_OFF = RING_BYTES;
constexpr int SCR_BYTES = LDSCTL_OFF;

#define GAS __attribute__((address_space(1)))
#define LAS __attribute__((address_space(3)))
typedef unsigned short bf16;
typedef unsigned v4u __attribute__((ext_vector_type(4)));
typedef unsigned v2u __attribute__((ext_vector_type(2)));
typedef float f32x4 __attribute__((ext_vector_type(4)));
typedef float f32x2 __attribute__((ext_vector_type(2)));
typedef short bf16x8 __attribute__((ext_vector_type(8)));
typedef GAS unsigned gu32;
#define RLX_AGENT __ATOMIC_RELAXED, __HIP_MEMORY_SCOPE_AGENT
#define LDS_WAIT() asm volatile("s_waitcnt lgkmcnt(0)" ::: "memory")
#define VM_WAIT() asm volatile("s_waitcnt vmcnt(0)" ::: "memory")
__device__ __forceinline__ unsigned f2bf(float f) { unsigned u = __builtin_bit_cast(unsigned, f); return (u + 0x7fffu + ((u >> 16) & 1u)) >> 16; }
__device__ __forceinline__ unsigned pk2(float lo, float hi) { return f2bf(lo) | (f2bf(hi) << 16); }
__device__ __forceinline__ float bf2f(unsigned h) { return __builtin_bit_cast(float, h << 16); }
__device__ __forceinline__ float bflo(unsigned w) { return __builtin_bit_cast(float, w << 16); }
__device__ __forceinline__ float bfhi(unsigned w) { return __builtin_bit_cast(float, w & 0xffff0000u); }
__device__ __forceinline__ float fexp2(float x) { return __builtin_amdgcn_exp2f(x); }
__device__ __forceinline__ float fexp(float x) { return __builtin_amdgcn_exp2f(x * LOG2E); }
__device__ __forceinline__ float frcp(float x) { return __builtin_amdgcn_rcpf(x); }
__device__ __forceinline__ float sigmoidf_(float x) { return frcp(1.f + fexp(-x)); }
__device__ __forceinline__ float siluf_(float x) { return x * sigmoidf_(x); }
__device__ __forceinline__ float gelu_tanh(float x) { const float y = 0.7978845608028654f * (x + 0.044715f * x * x * x); return x * sigmoidf_(2.f * y); }
__device__ __forceinline__ float log_sigmoid(float x) { return fminf(x, 0.f) - 0.6931471805599453f * __builtin_amdgcn_logf(1.f + fexp(-fabsf(x))); }
template <int CTRL> __device__ __forceinline__ float dpp_f(float v) { return __builtin_bit_cast(float, __builtin_amdgcn_update_dpp(0, __builtin_bit_cast(int, v), CTRL, 0xF, 0xF, true)); }
__device__ __forceinline__ float wave_sum(float v) {
    v += dpp_f<0xB1>(v);
    v += dpp_f<0x4E>(v);
    v += dpp_f<0x141>(v);
    v += dpp_f<0x140>(v);
    { auto r = __builtin_amdgcn_permlane16_swap(__float_as_uint(v), __float_as_uint(v), false, false); v = __uint_as_float(r[0]) + __uint_as_float(r[1]); }
    { auto r = __builtin_amdgcn_permlane32_swap(__float_as_uint(v), __float_as_uint(v), false, false); v = __uint_as_float(r[0]) + __uint_as_float(r[1]); }
    return v;
}
__device__ __forceinline__ float wave_max(float v) {
    v = fmaxf(v, dpp_f<0xB1>(v)); v = fmaxf(v, dpp_f<0x4E>(v)); v = fmaxf(v, dpp_f<0x141>(v)); v = fmaxf(v, dpp_f<0x140>(v));
    { auto r = __builtin_amdgcn_permlane16_swap(__float_as_uint(v), __float_as_uint(v), false, false); v = fmaxf(__uint_as_float(r[0]), __uint_as_float(r[1])); }
    { auto r = __builtin_amdgcn_permlane32_swap(__float_as_uint(v), __float_as_uint(v), false, false); v = fmaxf(__uint_as_float(r[0]), __uint_as_float(r[1])); }
    return v;
}

#define XB_TMO      128
#define XB_XCNT(j)  (256  + 64 * (j))
#define XB_XSUB(j)  (1280 + 64 * (j))
#define XB_XGEN(j)  (2304 + 64 * (j))
#define XB_TOP      3328
#define XB_TOPGEN   3392
#define XCD_BAR_WORDS 3456
#define XB_SPIN_CAP (1u << 22)
__device__ __forceinline__ unsigned xb_ld(unsigned* p)              { return __hip_atomic_load(p, __ATOMIC_RELAXED, __HIP_MEMORY_SCOPE_AGENT); }
__device__ __forceinline__ unsigned xb_add(unsigned* p, unsigned v) { return __hip_atomic_fetch_add(p, v, __ATOMIC_RELAXED, __HIP_MEMORY_SCOPE_AGENT); }
__device__ __forceinline__ unsigned xb_xcc_id() { return (unsigned)__builtin_amdgcn_s_getreg((3 << 11) | 20) & 0xFu; }
#define XB_SPIN(cond, bar) do { unsigned _sp = 0; while (cond) { __builtin_amdgcn_s_sleep(1); \
    if ((++_sp & 255u) == 0u) { if (xb_ld(&(bar)[XB_TMO])) break; if (_sp > XB_SPIN_CAP) { atomicAdd(&(bar)[XB_TMO], 1u); break; } } } } while (0)
struct XcdBarrier { unsigned* bar; unsigned x; volatile LAS unsigned* st; };
__device__ __forceinline__ XcdBarrier xcd_barrier_post(unsigned* bar, volatile LAS unsigned* st) {
    XcdBarrier b; b.bar = bar; b.x = xb_xcc_id(); b.st = st;
    if (threadIdx.x == 0) (void)xb_add(&bar[XB_XCNT(b.x)], 1u);
    return b;
}
__device__ __forceinline__ void xcd_barrier_complete(unsigned* bar, unsigned x, unsigned& nloc, unsigned& nx) {
    const unsigned G = gridDim.x * gridDim.y * gridDim.z;
    unsigned sum, cnt, mine, sp = 0u;
    for (;;) {
        sum = 0u; cnt = 0u; mine = 0u;
#pragma nounroll
        for (unsigned j = 0; j < 16; ++j) { const unsigned c = xb_ld(&bar[XB_XCNT(j)]); sum += c; cnt += (c > 0u) ? 1u : 0u; mine = (j == x) ? c : mine; }
        if (sum == G) break;
        __builtin_amdgcn_s_sleep(1);
        if ((++sp & 255u) == 0u) { if (xb_ld(&bar[XB_TMO])) break; if (sp > XB_SPIN_CAP) { atomicAdd(&bar[XB_TMO], 1u); break; } }
    }
    nloc = mine > 0u ? mine : 1u; nx = cnt > 0u ? cnt : 1u;
}
template <class Fill>
__device__ __forceinline__ void xcd_barrier(const XcdBarrier& b, bool leader, const Fill& fill) {
    asm volatile("s_waitcnt vmcnt(0)" ::: "memory");
    __syncthreads();
    fill();
    if (leader) {
        unsigned* bar = b.bar;
        __builtin_amdgcn_s_waitcnt(0);
        unsigned nloc = b.st[0], nx = b.st[1];
        if (nloc == 0u) { xcd_barrier_complete(bar, b.x, nloc, nx); b.st[0] = nloc; b.st[1] = nx; }
        const unsigned old = xb_add(&bar[XB_XSUB(b.x)], 1u);
        const unsigned gen = old / nloc;
        if (old + 1u == (gen + 1u) * nloc) {
            __builtin_amdgcn_fence(__ATOMIC_RELEASE, "agent");
            asm volatile("s_waitcnt vmcnt(0)" ::: "memory");
            const unsigned og = xb_add(&bar[XB_TOP], 1u);
            const unsigned tg = og / nx;
            if (og + 1u == (tg + 1u) * nx) xb_add(&bar[XB_TOPGEN], 1u);
            else XB_SPIN(xb_ld(&bar[XB_TOPGEN]) == tg, bar);
            __builtin_amdgcn_fence(__ATOMIC_ACQUIRE, "agent");
            xb_add(&bar[XB_XGEN(b.x)], 1u);
            asm volatile("s_waitcnt vmcnt(0)" ::: "memory");
        } else {
            XB_SPIN(xb_ld(&bar[XB_XGEN(b.x)]) == gen, bar);
            __builtin_amdgcn_fence(__ATOMIC_ACQUIRE, "agent");
            asm volatile("s_waitcnt vmcnt(0)" ::: "memory");
        }
    }
    __syncthreads();
}

struct Args { const float* in[23]; float* out; unsigned char* ws; int ph_lo, ph_hi; };
struct Frame {
    LAS unsigned char* lds;
    volatile LAS unsigned* MISC;
    gu32* ctl;
    int tid, lane, wave, G, bid, cpass;
    unsigned char* ws;
    float* XF;
    bf16* XB;
    bf16* H;
};
__device__ __forceinline__ bf16* seg(const Frame& F, int s) { return F.H + (size_t)s * SEGE; }
constexpr int INTBL_OFF = LDSCTL_OFF + 512, TICKET_OFF = LDSCTL_OFF + 768;
__device__ __forceinline__ const float* inptr(const Frame& F, int k) {
    const LAS unsigned* t = (const LAS unsigned*)(F.lds + INTBL_OFF) + 2 * k;
    const unsigned lo = __builtin_amdgcn_readfirstlane(t[0]), hi = __builtin_amdgcn_readfirstlane(t[1]);
    return (const float*)(((unsigned long long)hi << 32) | lo);
}

__device__ __forceinline__ void transpose_item(const float* src, int src_pitch, int k0, int n0, bf16* dst, int dst_pitch, int dst_row0, int dst_k0, LAS float* scr, int lane) {
    float tv[32];
#pragma unroll
    for (int i = 0; i < 32; ++i) tv[i] = __builtin_nontemporal_load(src + (size_t)(k0 + 2 * i + (lane >> 5)) * src_pitch + n0 + (lane & 31));
#pragma unroll
    for (int i = 0; i < 32; ++i) scr[(2 * i + (lane >> 5)) * 33 + (lane & 31)] = tv[i];
    LDS_WAIT(); asm volatile("" ::: "memory");
    const int c = lane & 7;
#pragma unroll
    for (int j = 0; j < 4; ++j) { const int n = (lane >> 3) + 8 * j; const LAS float* s = scr + (8 * c) * 33 + n;
        v4u o; o.x = pk2(s[0 * 33], s[1 * 33]); o.y = pk2(s[2 * 33], s[3 * 33]); o.z = pk2(s[4 * 33], s[5 * 33]); o.w = pk2(s[6 * 33], s[7 * 33]);
        asm volatile("global_store_dwordx4 %0, %1, off sc1\n\ts_nop 1" :: "v"(dst + (size_t)(dst_row0 + n) * dst_pitch + dst_k0 + k0 + 8 * c), "v"(o) : "memory"); }
    LDS_WAIT(); asm volatile("" ::: "memory");
}
__device__ __forceinline__ unsigned f8pk4(float a, float b, float c, float d) { int w = 0; w = __builtin_amdgcn_cvt_pk_fp8_f32(a, b, w, false); w = __builtin_amdgcn_cvt_pk_fp8_f32(c, d, w, true); return (unsigned)w; }
__device__ __forceinline__ unsigned i8pk4(float a, float b, float c, float d) {
    unsigned w = 0u; w = __builtin_amdgcn_cvt_pk_u8_f32(a + 128.f, 0u, w); w = __builtin_amdgcn_cvt_pk_u8_f32(b + 128.f, 1u, w); w = __builtin_amdgcn_cvt_pk_u8_f32(c + 128.f, 2u, w); w = __builtin_amdgcn_cvt_pk_u8_f32(d + 128.f, 3u, w);
    return w ^ 0x80808080u; }
#define I8_LOAD(tv, k0_) do { _Pragma("unroll") for (int i = 0; i < 32; ++i) tv[i] = __builtin_nontemporal_load(src + (size_t)((k0_) + 2 * i + (lane >> 5)) * src_pitch + n0 + (lane & 31)); } while (0)
#define I8_EMIT(tv, k0_) do { _Pragma("unroll") for (int i = 0; i < 32; ++i) scr[(2 * i + (lane >> 5)) * 33 + (lane & 31)] = tv[i]; \
        LDS_WAIT(); asm volatile("" ::: "memory"); \
        _Pragma("unroll") for (int j = 0; j < 4; ++j) { const int n = (lane >> 3) + 8 * j; const LAS float* s_ = scr + (8 * c) * 33 + n; \
            v2u o; o.x = i8pk4(__builtin_rintf(s_[0 * 33] * sc), __builtin_rintf(s_[1 * 33] * sc), __builtin_rintf(s_[2 * 33] * sc), __builtin_rintf(s_[3 * 33] * sc)); \
            o.y = i8pk4(__builtin_rintf(s_[4 * 33] * sc), __builtin_rintf(s_[5 * 33] * sc), __builtin_rintf(s_[6 * 33] * sc), __builtin_rintf(s_[7 * 33] * sc)); \
            asm volatile("global_store_dwordx2 %0, %1, off sc1\n\ts_nop 1" :: "v"(dst + (size_t)(dst_row0 + n) * dst_pitch + (k0_) + 8 * c), "v"(o) : "memory"); } \
        LDS_WAIT(); asm volatile("" ::: "memory"); } while (0)
__device__ __forceinline__ void strip_i8(const float* src, int src_pitch, int n0, unsigned char* dst, int dst_pitch, int dst_row0, unsigned* cmax1, LAS float* scr, LAS float* red, int wave, int lane) {
    float ta[32], tb[32];
    I8_LOAD(ta, wave * 64); I8_LOAD(tb, (wave + 8) * 64);
    float m = 0.f;
#pragma unroll
    for (int i = 0; i < 32; ++i) m = fmaxf(m, fmaxf(fabsf(ta[i]), fabsf(tb[i])));
    m = wave_max(m);
    if (lane == 0) red[wave] = m;
    __syncthreads();
    float mm = red[0];
#pragma unroll
    for (int w = 1; w < NWAVES; ++w) mm = fmaxf(mm, red[w]);
    if (wave == 0 && lane == 0) *cmax1 = __float_as_uint(mm);
    const float sc = 127.f * frcp(fmaxf(mm, 1e-30f)); const int c = lane & 7;
    I8_EMIT(ta, wave * 64); I8_EMIT(tb, (wave + 8) * 64);
    __syncthreads();
}
#undef I8_LOAD
#undef I8_EMIT
__device__ __forceinline__ float f8clamp(float x) { return __builtin_amdgcn_fmed3f(x, -448.f, 448.f); }
__device__ __forceinline__ void transpose_item8(const float* src, int src_pitch, int k0, int n0, unsigned char* dst, int dst_pitch, int dst_row0, int dst_k0, float scale, LAS float* scr, int lane) {
    float tv[32];
#pragma unroll
    for (int i = 0; i < 32; ++i) tv[i] = __builtin_nontemporal_load(src + (size_t)(k0 + 2 * i + (lane >> 5)) * src_pitch + n0 + (lane & 31));
#pragma unroll
    for (int i = 0; i < 32; ++i) scr[(2 * i + (lane >> 5)) * 33 + (lane & 31)] = tv[i];
    LDS_WAIT(); asm volatile("" ::: "memory");
    const int c = lane & 7;
#pragma unroll
    for (int j = 0; j < 4; ++j) { const int n = (lane >> 3) + 8 * j; const LAS float* s = scr + (8 * c) * 33 + n;
        v2u o; o.x = f8pk4(f8clamp(s[0 * 33] * scale), f8clamp(s[1 * 33] * scale), f8clamp(s[2 * 33] * scale), f8clamp(s[3 * 33] * scale));
        o.y = f8pk4(f8clamp(s[4 * 33] * scale), f8clamp(s[5 * 33] * scale), f8clamp(s[6 * 33] * scale), f8clamp(s[7 * 33] * scale));
        asm volatile("global_store_dwordx2 %0, %1, off sc1\n\ts_nop 1" :: "v"(dst + (size_t)(dst_row0 + n) * dst_pitch + dst_k0 + k0 + 8 * c), "v"(o) : "memory"); }
    LDS_WAIT(); asm volatile("" ::: "memory");
}
__device__ __forceinline__ int orig_col(int n) { return n < 1536 ? n : (n < 3584 ? n + 8 : n + 16); }

__device__ __forceinline__ void convert_small(const Frame& F, const Args& args, int l) {
    LAS float* scr = (LAS float*)(F.lds + F.wave * 16384);
    const int gw = F.bid * NWAVES + F.wave, NGW = F.G * NWAVES;
    const float* w_in = inptr(F, 3) + (size_t)l * D * DIN;
    const float* w_br = inptr(F, 10) + (size_t)l * 3 * 512 * D;
    const float* w_out = inptr(F, 11) + (size_t)l * D * D;
    bf16* Wbr_t = (bf16*)(F.ws + WS_WBR); bf16* Wout_t = (bf16*)(F.ws + WS_WOUT);
    constexpr int I_BR = 3 * (512 / 64) * (D / 32), I_OUT = (D / 64) * (D / 32);
    for (int strip = F.bid; strip < NH / 32; strip += F.G) { const int n0 = strip * 32;
        strip_i8(w_in, DIN, orig_col(n0), (unsigned char*)(F.ws + WS_WIN), D, n0, (unsigned*)(F.ctl + CW_CMAX) + l * (NH / 32) + strip, scr, (LAS float*)(F.lds + XTRA_OFF), F.wave, F.lane); }
    for (int it = gw; it < I_BR + I_OUT; it += NGW) {
        int r = it;
        if (r < I_BR) { const int n = r / ((512 / 64) * (D / 32)), q = r % ((512 / 64) * (D / 32)); const int kb = q / (D / 32), nb = q % (D / 32);
            transpose_item(w_br + (size_t)n * 512 * D, D, kb * 64, nb * 32, Wbr_t, 1536, nb * 32, n * 512, scr, F.lane); continue; }
        r -= I_BR;
        { const int kb = r / (D / 32), nb = r % (D / 32); transpose_item(w_out, D, kb * 64, nb * 32, Wout_t, D, nb * 32, 0, scr, F.lane); }
    }
    float* bias_p = (float*)(F.ws + WS_BIAS); const float* b_in = inptr(F, 4) + (size_t)l * DIN;
    for (int i = F.bid * NTHR + F.tid; i < NH; i += F.G * NTHR) bias_p[i] = b_in[orig_col(i)];
    { const float* wrt = inptr(F, 16) + (size_t)l * D * NEXP; float* wrT = (float*)(F.ws + WS_WRT);
      for (int i = F.bid * NTHR + F.tid; i < NEXP * D; i += F.G * NTHR) wrT[i] = wrt[(size_t)(i & 1023) * NEXP + (i >> 10)]; }
    { const float* sw = inptr(F, 8) + (size_t)l * 4 * 128 * 128; bf16* Wm = (bf16*)(F.ws + WS_SGUW);
      for (int i = F.bid * NTHR + F.tid; i < 4 * 128 * 128; i += F.G * NTHR) { const int t = (i >> 7) & 127, s = i & 127; Wm[i] = (bf16)((s <= t) ? f2bf(sw[i]) : 0u); } }
}

__device__ __forceinline__ unsigned char* wgu_ptr(const Frame& F) { return (unsigned char*)(F.XF + (size_t)16 * 1024 * 1024); }
constexpr float W8SCALE = 64.f, W8INV = 1.f / 64.f;
__device__ __forceinline__ void expert_item(const Frame& F, int l, int kind, int idx, LAS float* scr) {
    if (kind == 0) { const int e = idx >> 9, which = (idx >> 8) & 1, q = idx & 255, kb = q >> 4, n0 = (q & 15) * 32;
        const float* w = inptr(F, which ? 19 : 18) + ((size_t)l * NEXP + e) * D * DEXP;
        transpose_item8(w, DEXP, kb * 64, n0, wgu_ptr(F) + (size_t)e * 1024 * 1024, 1024, 256 * (n0 >> 7) + (n0 & 127) + which * 128, 0, W8SCALE, scr, F.lane); }
    else { const int e = idx >> 8, q = idx & 255, kb = q >> 5, nb = q & 31;
        const float* w = inptr(F, 20) + ((size_t)l * NEXP + e) * DEXP * D;
        transpose_item8(w, D, kb * 64, nb * 32, (unsigned char*)(F.ws + WS_WD) + (size_t)e * 1024 * 512, 512, nb * 32, 0, W8SCALE, scr, F.lane); }
}
__device__ __forceinline__ void convert_experts(const Frame& F, int l, int iu0, int id0) {
    LAS float* scr = (LAS float*)(F.lds + F.wave * 16384);
    if (F.G == 256) {
        const int nu = 64 - iu0, nd = 32 - id0;
#pragma nounroll
        for (int j = F.wave; j < nu + nd; j += NWAVES) { if (j < nu) expert_item(F, l, 0, F.bid + 256 * (iu0 + j), scr); else expert_item(F, l, 1, F.bid + 256 * (id0 + j - nu), scr); }
    } else {
        const int gw = F.bid * NWAVES + F.wave, NGW = F.G * NWAVES;
#pragma nounroll
        for (int it = gw; it < 16384 + 8192; it += NGW) { if (it < 16384) expert_item(F, l, 0, it, scr); else expert_item(F, l, 1, it - 16384, scr); }
    }
}

#if defined(EXPT) && EXPT == 3
#define EXPT3 1
#else
#define EXPT3 0
#endif
template <int MODE>
__device__ __forceinline__ void ln_rows(const Frame& F, const Args& args, const float* lng, const float* lnb, int gl) {
    constexpr int WP = 1032;
    LAS bf16* wt = (LAS bf16*)F.lds;
    if (gl >= 0) {
        const float* w_in = inptr(F, 3) + (size_t)gl * D * DIN;
        for (int k = F.tid; k < D; k += NTHR) {
#pragma unroll
            for (int c = 0; c < 16; ++c) wt[c * WP + k] = (bf16)f2bf(w_in[(size_t)k * DIN + (c < 8 ? 1536 + c : 3592 + (c - 8))]);
        }
        __syncthreads();
    }
    const int gw = F.bid * NWAVES + F.wave, NGW = F.G * NWAVES;
    const float* xin = inptr(F, 0);
    const unsigned char* ybuf = (const unsigned char*)(F.ws + WS_YBUF); const float* tokg = (const float*)(F.ws + WS_TOKG);
    float* lfox = (float*)(F.ws + WS_LFOX); float* mli = (float*)(F.ws + WS_MLI); float* mlf = (float*)(F.ws + WS_MLF);
    unsigned char* xb8 = F.ws + WS_XB8; float* sa = (float*)(F.ws + WS_SA);
    f32x4 gv[4], bv[4];
#pragma unroll
    for (int j = 0; j < 4; ++j) { gv[j] = *(const f32x4*)(lng + 4 * F.lane + 256 * j); bv[j] = *(const f32x4*)(lnb + 4 * F.lane + 256 * j); }
    f32x4 vn[4]; unsigned yan[4], ybn[4]; float g0n = 0.f, g1n = 0.f;
#define LNR_LOAD(rw) do { const size_t ro_ = (size_t)(rw) * D + 4 * F.lane; \
        if (MODE == 0) { _Pragma("unroll") for (int j = 0; j < 4; ++j) vn[j] = __builtin_nontemporal_load((const f32x4*)(xin + ro_ + 256 * j)); } \
        else { _Pragma("unroll") for (int j = 0; j < 4; ++j) { const v2u x_ = *(const v2u*)(F.XB + ro_ + 256 * j); vn[j] = (f32x4){bflo(x_.x), bfhi(x_.x), bflo(x_.y), bfhi(x_.y)}; } } \
        if (MODE == 2 && !(EXPT3 && F.cpass == 0)) { g0n = tokg[2 * (rw)]; g1n = tokg[2 * (rw) + 1]; \
            _Pragma("unroll") for (int j = 0; j < 4; ++j) { yan[j] = *(const unsigned*)(ybuf + (size_t)(2 * (rw)) * D + 4 * F.lane + 256 * j); ybn[j] = *(const unsigned*)(ybuf + (size_t)(2 * (rw) + 1) * D + 4 * F.lane + 256 * j); } } } while (0)
    if (gw < T) LNR_LOAD(gw);
#pragma nounroll
    for (int row = gw; row < T; row += NGW) {
        f32x4 v[4]; float s = 0.f;
        const size_t ro = (size_t)row * D + 4 * F.lane;
#pragma unroll
        for (int j = 0; j < 4; ++j) v[j] = vn[j];
        if (MODE == 2) {
#pragma unroll
            for (int j = 0; j < 4; ++j) { const int a = (int)yan[j], b = (int)ybn[j]; const float ga = g0n * (1.f / 16.f), gb = g1n * (1.f / 16.f);
                v[j].x = ALPHA * v[j].x + ga * __builtin_amdgcn_cvt_f32_fp8(a, 0) + gb * __builtin_amdgcn_cvt_f32_fp8(b, 0); v[j].y = ALPHA * v[j].y + ga * __builtin_amdgcn_cvt_f32_fp8(a, 1) + gb * __builtin_amdgcn_cvt_f32_fp8(b, 1);
                v[j].z = ALPHA * v[j].z + ga * __builtin_amdgcn_cvt_f32_fp8(a, 2) + gb * __builtin_amdgcn_cvt_f32_fp8(b, 2); v[j].w = ALPHA * v[j].w + ga * __builtin_amdgcn_cvt_f32_fp8(a, 3) + gb * __builtin_amdgcn_cvt_f32_fp8(b, 3); } }
        if (row + NGW < T) LNR_LOAD(row + NGW);
#pragma unroll
        for (int j = 0; j < 4; ++j) s += (v[j].x + v[j].y) + (v[j].z + v[j].w);
        const float mean = wave_sum(s) * (1.f / D); float s2 = 0.f;
#pragma unroll
        for (int j = 0; j < 4; ++j) { v[j] = v[j] - mean; s2 += (v[j].x * v[j].x + v[j].y * v[j].y) + (v[j].z * v[j].z + v[j].w * v[j].w); }
        const float rstd = 1.f / sqrtf(wave_sum(s2) * (1.f / D) + LN_EPS);
#pragma unroll
        for (int j = 0; j < 4; ++j) { v[j] = v[j] * rstd * gv[j] + bv[j];
            if (MODE == 2 && gl < 0) __builtin_nontemporal_store(v[j], (f32x4*)(F.XF + ro + 256 * j));
            else { v2u o; o.x = pk2(v[j].x, v[j].y); o.y = pk2(v[j].z, v[j].w); *(v2u*)(F.XB + ro + 256 * j) = o; } }
        if (gl >= 0) {
            float am = 0.f;
#pragma unroll
            for (int j = 0; j < 4; ++j) am = fmaxf(fmaxf(am, fmaxf(fabsf(v[j].x), fabsf(v[j].y))), fmaxf(fabsf(v[j].z), fabsf(v[j].w)));
            am = fmaxf(wave_max(am), 1e-30f); const float qs = 127.f * frcp(am);
#pragma unroll
            for (int j = 0; j < 4; ++j) *(unsigned*)(xb8 + ro + 256 * j) = i8pk4(__builtin_rintf(v[j].x * qs), __builtin_rintf(v[j].y * qs), __builtin_rintf(v[j].z * qs), __builtin_rintf(v[j].w * qs));
            if (F.lane == 0) sa[row] = am * (1.f / 127.f); }
    }
    if (gl >= 0) {
        typedef float f32x4m __attribute__((ext_vector_type(4)));
        asm volatile("s_waitcnt vmcnt(0)" ::: "memory");
        __builtin_amdgcn_fence(__ATOMIC_ACQUIRE, "agent");
        const int r16 = F.lane & 15, kq = F.lane >> 4;
        const int arow = gw + r16 * NGW;
        bf16x8 af[32];
#pragma unroll
        for (int ks = 0; ks < 32; ++ks) af[ks] = (arow < T) ? *(const bf16x8*)(F.XB + (size_t)arow * D + 32 * ks + 8 * kq) : (bf16x8){0, 0, 0, 0, 0, 0, 0, 0};
        f32x4m acc = {0.f, 0.f, 0.f, 0.f};
#pragma unroll
        for (int ks = 0; ks < 32; ++ks) acc = __builtin_amdgcn_mfma_f32_16x16x32_bf16(af[ks], *(const LAS bf16x8*)(wt + r16 * WP + 32 * ks + 8 * kq), acc, 0, 0, 0);
        const int c = r16; const float* b_in = inptr(F, 4) + (size_t)gl * DIN; const float bias = b_in[c < 8 ? 1536 + c : 3592 + (c - 8)];
#pragma unroll
        for (int i = 0; i < 4; ++i) { const int row = gw + (4 * kq + i) * NGW; if (row < T) { const float logit = acc[i] + bias;
            if (c < 8) lfox[(size_t)row * 8 + c] = log_sigmoid(logit);
            else if (c < 12) mli[(size_t)row * 4 + (c - 8)] = logit;
            else mlf[(size_t)row * 4 + (c - 12)] = log_sigmoid(logit); } }
    }
#undef LNR_LOAD
    __syncthreads();
}

__device__ __forceinline__ void fox_scan(const Frame& F) {
    if (F.bid >= 64) return;
    const float* lfox = (const float*)(F.ws + WS_LFOX); float* Fc = (float*)(F.ws + WS_FC);
    LAS float* wt = (LAS float*)(F.lds + XTRA_OFF);
    for (int bh = F.bid; bh < 64; bh += F.G) {
        const int b = bh >> 3, h = bh & 7; const int s0 = F.tid * 8;
        float v[8]; float run = 0.f;
#pragma unroll
        for (int i = 0; i < 8; ++i) { run += lfox[((size_t)b * SEQ + s0 + i) * 8 + h]; v[i] = run; }
        float inc = run;
#pragma unroll
        for (int o = 1; o < 64; o <<= 1) { const float t = __shfl_up(inc, o); if (F.lane >= o) inc += t; }
        if (F.lane == 63) wt[F.wave] = inc;
        __syncthreads();
        float base = inc - run;
        for (int w = 0; w < F.wave; ++w) base += wt[w];
#pragma unroll
        for (int i = 0; i < 8; ++i) Fc[(size_t)bh * SEQ + s0 + i] = base + v[i];
        __syncthreads();
    }
}

__device__ __forceinline__ void attn_naive(const Frame& F) {
    bf16* Qs = seg(F, S_Q); const bf16* Ks = seg(F, S_K); const bf16* Vs = seg(F, S_V);
    const float* Fc = (const float*)(F.ws + WS_FC);
    LAS unsigned* Kt = (LAS unsigned*)F.lds;
    LAS unsigned* Vt = (LAS unsigned*)(F.lds + 8192);
    LAS float* Ft = (LAS float*)(F.lds + 16384);
    for (int u = F.bid; u < 512; u += F.G) {
        const int w = u >> 1, bh = w >> 2, sidx = w & 3, qb = ((u ^ (u / F.G)) & 1) ? 7 - sidx : sidx;
        const int b = bh >> 3, h = bh & 7;
        const int t = qb * 512 + F.tid; const size_t row = (size_t)b * SEQ + t;
        float q[64], o[64];
        { const v4u* qp = (const v4u*)(Qs + row * 512 + h * 64);
#pragma unroll
          for (int i = 0; i < 8; ++i) { const v4u x = qp[i]; q[8 * i] = bflo(x.x); q[8 * i + 1] = bfhi(x.x); q[8 * i + 2] = bflo(x.y); q[8 * i + 3] = bfhi(x.y); q[8 * i + 4] = bflo(x.z); q[8 * i + 5] = bfhi(x.z); q[8 * i + 6] = bflo(x.w); q[8 * i + 7] = bfhi(x.w); } }
#pragma unroll
        for (int d = 0; d < 64; ++d) o[d] = 0.f;
        float m = -INFINITY, l = 0.f;
        const int ntile = (qb * 512 + 512) / 64;
        const int wave_tmax = qb * 512 + F.wave * 64 + 63;
        for (int kt = 0; kt < ntile; ++kt) {
            __syncthreads();
            { const int kr = F.tid >> 3, ch = F.tid & 7; const size_t krow = (size_t)b * SEQ + kt * 64 + kr;
              *(LAS v4u*)(Kt + kr * 32 + ch * 4) = *(const v4u*)(Ks + krow * 512 + h * 64 + ch * 8);
              *(LAS v4u*)(Vt + kr * 32 + ch * 4) = *(const v4u*)(Vs + krow * 512 + h * 64 + ch * 8);
              if (F.tid < 64) Ft[F.tid] = Fc[(size_t)bh * SEQ + kt * 64 + F.tid] * LOG2E; }
            __syncthreads();
            if (kt * 64 > wave_tmax) continue;
#pragma nounroll
            for (int sl = 0; sl < 64; ++sl) {
                float acc = 0.f;
#pragma unroll
                for (int i = 0; i < 8; ++i) { const v4u kk = *(const LAS v4u*)(Kt + sl * 32 + i * 4);
                    acc += q[8 * i] * bflo(kk.x) + q[8 * i + 1] * bfhi(kk.x) + q[8 * i + 2] * bflo(kk.y) + q[8 * i + 3] * bfhi(kk.y) + q[8 * i + 4] * bflo(kk.z) + q[8 * i + 5] * bfhi(kk.z) + q[8 * i + 6] * bflo(kk.w) + q[8 * i + 7] * bfhi(kk.w); }
                const float x = (kt * 64 + sl <= t) ? acc - Ft[sl] : -INFINITY;
                if (x > m) { const float corr = fexp2(m - x); m = x; l *= corr;
#pragma unroll
                    for (int d = 0; d < 64; ++d) o[d] *= corr; }
                const float p = fexp2(x - m); l += p;
#pragma unroll
                for (int i = 0; i < 8; ++i) { const v4u vv = *(const LAS v4u*)(Vt + sl * 32 + i * 4);
                    o[8 * i] += p * bflo(vv.x); o[8 * i + 1] += p * bfhi(vv.x); o[8 * i + 2] += p * bflo(vv.y); o[8 * i + 3] += p * bfhi(vv.y); o[8 * i + 4] += p * bflo(vv.z); o[8 * i + 5] += p * bfhi(vv.z); o[8 * i + 6] += p * bflo(vv.w); o[8 * i + 7] += p * bfhi(vv.w); }
            }
        }
        const float rl = 1.f / l;
        { v4u* op = (v4u*)(Qs + row * 512 + h * 64);
#pragma unroll
          for (int i = 0; i < 8; ++i) { v4u x; x.x = pk2(o[8 * i] * rl, o[8 * i + 1] * rl); x.y = pk2(o[8 * i + 2] * rl, o[8 * i + 3] * rl); x.z = pk2(o[8 * i + 4] * rl, o[8 * i + 5] * rl); x.w = pk2(o[8 * i + 6] * rl, o[8 * i + 7] * rl); op[i] = x; } }
    }
    __syncthreads();
}

__device__ __forceinline__ void sgu_naive(const Frame& F, const Args& args, int l) {
    bf16* SU = seg(F, S_SU); const bf16* SV = seg(F, S_SV);
    const float* lng = inptr(F, 6) + (size_t)l * 512; const float* lnb = inptr(F, 7) + (size_t)l * 512;
    const float* sw = inptr(F, 8) + (size_t)l * 4 * 128 * 128; const float* sb = inptr(F, 9) + (size_t)l * 4 * 128;
    LAS float* vh = (LAS float*)F.lds; LAS float* Wt = (LAS float*)(F.lds + 65536);
    LAS float* st = (LAS float*)(F.lds + XTRA_OFF);
    for (int it = F.bid; it < 256; it += F.G) {
        const size_t row0 = (size_t)it * 128;
        __syncthreads();
        for (int i = 0; i < 16; ++i) { const int tok = F.wave * 16 + i;
            const v4u x = *(const v4u*)(SV + (row0 + tok) * 512 + F.lane * 8);
            const float a0 = bflo(x.x), a1 = bfhi(x.x), a2 = bflo(x.y), a3 = bfhi(x.y), a4 = bflo(x.z), a5 = bfhi(x.z), a6 = bflo(x.w), a7 = bfhi(x.w);
            const float mean = wave_sum(((a0 + a1) + (a2 + a3)) + ((a4 + a5) + (a6 + a7))) * (1.f / 512.f);
            const float d0 = a0 - mean, d1 = a1 - mean, d2 = a2 - mean, d3 = a3 - mean, d4 = a4 - mean, d5 = a5 - mean, d6 = a6 - mean, d7 = a7 - mean;
            const float var = wave_sum(((d0 * d0 + d1 * d1) + (d2 * d2 + d3 * d3)) + ((d4 * d4 + d5 * d5) + (d6 * d6 + d7 * d7))) * (1.f / 512.f);
            if (F.lane == 0) { st[2 * tok] = mean; st[2 * tok + 1] = 1.f / sqrtf(var + LN_EPS); } }
        for (int g = 0; g < 4; ++g) {
            __syncthreads();
            for (int i = 0; i < 32; ++i) { const int e = F.tid + 512 * i, s = e >> 7, c = e & 127;
                vh[s * 128 + c] = (bf2f(SV[(row0 + s) * 512 + g * 128 + c]) - st[2 * s]) * st[2 * s + 1] * lng[g * 128 + c] + lnb[g * 128 + c];
                const int t = e >> 7, s2 = e & 127;
                Wt[s2 * 128 + t] = (s2 <= t) ? sw[(size_t)g * 16384 + t * 128 + s2] : 0.f; }
            __syncthreads();
            const int c = F.tid & 127, tq = F.tid >> 7;
            float z[32];
#pragma unroll
            for (int j = 0; j < 32; ++j) z[j] = 0.f;
            for (int s = 0; s < 128; ++s) { const float v = vh[s * 128 + c];
#pragma unroll
                for (int j = 0; j < 8; ++j) { const f32x4 w = *(const LAS f32x4*)(Wt + s * 128 + tq * 32 + 4 * j); z[4 * j] += w.x * v; z[4 * j + 1] += w.y * v; z[4 * j + 2] += w.z * v; z[4 * j + 3] += w.w * v; } }
#pragma unroll
            for (int j = 0; j < 32; ++j) { const int t = tq * 32 + j; const size_t o = (row0 + t) * 512 + g * 128 + c;
                SU[o] = (bf16)f2bf(bf2f(SU[o]) * (z[j] + sb[g * 128 + t])); }
        }
    }
    __syncthreads();
}

__device__ __forceinline__ float conv_silu(const bf16* srcseg, size_t rowb, int tt, int col, const float* cw  ) {
    float a = 0.f;
#pragma unroll
    for (int j = 0; j < 4; ++j) { const int ts = tt - 3 + j; if (ts >= 0) a += cw[j * 1024] * bf2f(srcseg[(rowb + ts) * 512 + col]); }
    return siluf_(a);
}

__device__ __forceinline__ void mlstm_m1_naive(const Frame& F, const Args& args, int l) {
    const bf16* MLK = seg(F, S_MLK); const bf16* MLV = seg(F, S_MLV);
    const float* cw = inptr(F, 5) + (size_t)l * 4 * 1024;
    const float* mli = (const float*)(F.ws + WS_MLI); const float* mlf = (const float*)(F.ws + WS_MLF);
    float* UC = F.XF; float* NV = (float*)(F.ws + WS_NV); float* MST = (float*)(F.ws + WS_MST);
    LAS float* kh = (LAS float*)F.lds; LAS float* vv = (LAS float*)(F.lds + 65536);
    LAS float* sg = (LAS float*)(F.lds + XTRA_OFF);
    for (int it = F.bid; it < 1024; it += F.G) {
        const int bh4 = it >> 5, c = it & 31, b = bh4 >> 2, h = bh4 & 3;
        const size_t rowb = (size_t)b * SEQ, row0 = rowb + c * 128;
        __syncthreads();
        if (F.tid < 128) { sg[F.tid] = mlf[(row0 + F.tid) * 4 + h]; sg[128 + F.tid] = mli[(row0 + F.tid) * 4 + h]; }
        __syncthreads();
        float bc = 0.f, blast = 0.f;
        if (F.tid < 128) {
#pragma nounroll
            for (int i = 0; i < 128; ++i) { blast += sg[i]; if (i == F.tid) bc = blast; } }
        __syncthreads();
        if (F.tid < 128) { sg[F.tid] = bc; sg[128 + F.tid] = blast - bc + sg[128 + F.tid]; }
        __syncthreads();
        float mg = -INFINITY;
#pragma nounroll
        for (int i = 0; i < 128; ++i) mg = fmaxf(mg, sg[128 + i]);
        if (F.tid < 128) sg[256 + F.tid] = fexp(sg[128 + F.tid] - mg);
        __syncthreads();
        for (int i = 0; i < 32; ++i) { const int e = F.tid + 512 * i, s = e >> 7, d = e & 127;
            const float kv = conv_silu(MLK, rowb, c * 128 + s, h * 128 + d, cw + 512 + h * 128 + d) * 0.08838834764831845f;
            kh[s * 128 + d] = kv * sg[256 + s];
            vv[s * 128 + d] = bf2f(MLV[(row0 + s) * 512 + h * 128 + d]); }
        __syncthreads();
        { const int d0 = (F.tid >> 4) * 4, e0 = (F.tid & 15) * 8; float acc[4][8];
#pragma unroll
          for (int i = 0; i < 4; ++i)
#pragma unroll
              for (int j = 0; j < 8; ++j) acc[i][j] = 0.f;
          for (int s = 0; s < 128; ++s) { const f32x4 kd = *(const LAS f32x4*)(kh + s * 128 + d0); const f32x4 v0 = *(const LAS f32x4*)(vv + s * 128 + e0), v1 = *(const LAS f32x4*)(vv + s * 128 + e0 + 4);
#pragma unroll
              for (int i = 0; i < 4; ++i) { acc[i][0] += kd[i] * v0.x; acc[i][1] += kd[i] * v0.y; acc[i][2] += kd[i] * v0.z; acc[i][3] += kd[i] * v0.w; acc[i][4] += kd[i] * v1.x; acc[i][5] += kd[i] * v1.y; acc[i][6] += kd[i] * v1.z; acc[i][7] += kd[i] * v1.w; } }
          float* Uo = UC + (size_t)it * 16384;
#pragma unroll
          for (int i = 0; i < 4; ++i) { *(f32x4*)(Uo + (d0 + i) * 128 + e0) = (f32x4){acc[i][0], acc[i][1], acc[i][2], acc[i][3]}; *(f32x4*)(Uo + (d0 + i) * 128 + e0 + 4) = (f32x4){acc[i][4], acc[i][5], acc[i][6], acc[i][7]}; } }
        if (F.tid < 128) { float n = 0.f; for (int s = 0; s < 128; ++s) n += kh[s * 128 + F.tid]; NV[(size_t)it * 128 + F.tid] = n; }
        if (F.tid == 0) { MST[it * 4] = mg; MST[it * 4 + 1] = blast; }
    }
    __syncthreads();
}

__device__ __forceinline__ void mlstm_m2(const Frame& F) {
    float* UC = F.XF; float* NV = (float*)(F.ws + WS_NV); float* MST = (float*)(F.ws + WS_MST);
    for (int idx = F.bid * NTHR + F.tid; idx < 32 * 4096; idx += F.G * NTHR) {
        const int bh4 = idx >> 12, e4 = idx & 4095;
        f32x4 C = (f32x4){0.f, 0.f, 0.f, 0.f}; float m = 0.f;
#pragma nounroll
        for (int cb = 0; cb < 32; cb += 8) {
            v2u U[8];
#pragma unroll
            for (int c = 0; c < 8; ++c) U[c] = *((const v2u*)((const bf16*)UC + (size_t)(bh4 * 32 + cb + c) * 16384) + e4);
#pragma unroll
            for (int c = 0; c < 8; ++c) { const int it = bh4 * 32 + cb + c;
                const float mg = MST[it * 4], bl = MST[it * 4 + 1];
                { v2u cb_; cb_.x = pk2(C.x, C.y); cb_.y = pk2(C.z, C.w); *((v2u*)((bf16*)UC + (size_t)it * 16384) + e4) = cb_; }
                const float mn = fmaxf(bl + m, mg), dc = fexp(bl + m - mn), sc = fexp(mg - mn);
                C = C * dc + (f32x4){bflo(U[c].x), bfhi(U[c].x), bflo(U[c].y), bfhi(U[c].y)} * sc;
                if (e4 == 0) MST[it * 4 + 2] = m;
                m = mn; }
        }
        if (e4 < 32) { f32x4 N = (f32x4){0.f, 0.f, 0.f, 0.f}; m = 0.f;
#pragma nounroll
            for (int c = 0; c < 32; ++c) { const int it = bh4 * 32 + c; const float mg = MST[it * 4], bl = MST[it * 4 + 1];
                f32x4* np = (f32x4*)(NV + (size_t)it * 128) + e4; const f32x4 nn = *np; *np = N;
                const float mn = fmaxf(bl + m, mg), dc = fexp(bl + m - mn), sc = fexp(mg - mn); N = N * dc + nn * sc; m = mn; } }
    }
}

__device__ __forceinline__ void mlstm_m3_naive(const Frame& F, const Args& args, int l) {
    const bf16* MLQ = seg(F, S_MLQ); const bf16* MLK = seg(F, S_MLK); bf16* MLV = seg(F, S_MLV); const bf16* MLO = seg(F, S_MLO);
    const float* cw = inptr(F, 5) + (size_t)l * 4 * 1024;
    const float* mli = (const float*)(F.ws + WS_MLI); const float* mlf = (const float*)(F.ws + WS_MLF);
    const float* UC = (const float*)F.XF; const float* NV = (const float*)(F.ws + WS_NV); const float* MST = (const float*)(F.ws + WS_MST);
    constexpr int P = 129;
    LAS float* A0 = (LAS float*)F.lds;
    LAS float* A1 = (LAS float*)(F.lds + 128 * P * 4);
    LAS float* sg = (LAS float*)(F.lds + 2 * 128 * P * 4);
    for (int it = F.bid; it < 1024; it += F.G) {
        const int bh4 = it >> 5, c = it & 31, b = bh4 >> 2, h = bh4 & 3;
        const size_t rowb = (size_t)b * SEQ, row0 = rowb + c * 128;
        const float m_in = MST[it * 4 + 2];
        __syncthreads();
        if (F.tid < 128) { sg[F.tid] = mlf[(row0 + F.tid) * 4 + h]; sg[256 + F.tid] = mli[(row0 + F.tid) * 4 + h]; sg[384 + F.tid] = NV[(size_t)it * 128 + F.tid]; }
        __syncthreads();
        float bc = 0.f;
        if (F.tid < 128) { float r = 0.f;
#pragma nounroll
            for (int i = 0; i < 128; ++i) { r += sg[i]; if (i == F.tid) bc = r; } }
        __syncthreads();
        if (F.tid < 128) { sg[F.tid] = bc; sg[128 + F.tid] = sg[256 + F.tid] - bc; }
        for (int i = 0; i < 32; ++i) { const int e = F.tid + 512 * i, s = e >> 7, d = e & 127;
            A0[s * P + d] = conv_silu(MLQ, rowb, c * 128 + s, h * 128 + d, cw + h * 128 + d);
            A1[s * P + d] = conv_silu(MLK, rowb, c * 128 + s, h * 128 + d, cw + 512 + h * 128 + d) * 0.08838834764831845f; }
        __syncthreads();
        const int t = F.tid >> 2, eq = F.tid & 3;
        float pm = -INFINITY;
        for (int s = 0; s <= t; ++s) pm = fmaxf(pm, sg[128 + s]);
        const float bt = sg[t], inter = bt + m_in, mt = fmaxf(inter, bt + pm), w_inter = fexp(inter - mt);
        float sreg[32], acc2[32]; float qn = 0.f;
#pragma unroll
        for (int j = 0; j < 32; ++j) { sreg[j] = 0.f; acc2[j] = 0.f; }
        const float* Cg = UC + (size_t)it * 16384 + eq * 32;
#pragma nounroll
        for (int d = 0; d < 128; ++d) { const float qv = A0[t * P + d]; qn += qv * sg[384 + d];
#pragma unroll
            for (int j = 0; j < 32; ++j) sreg[j] += qv * A1[(4 * j + eq) * P + d]; }
#pragma nounroll
        for (int d = 0; d < 128; ++d) { const float qv = A0[t * P + d];
#pragma unroll
            for (int j = 0; j < 8; ++j) { const f32x4 cc = *(const f32x4*)(Cg + d * 128 + 4 * j); acc2[4 * j] += qv * cc.x; acc2[4 * j + 1] += qv * cc.y; acc2[4 * j + 2] += qv * cc.z; acc2[4 * j + 3] += qv * cc.w; } }
        __syncthreads();
#pragma unroll
        for (int j = 0; j < 32; ++j) { const int s = 4 * j + eq; A0[t * P + s] = (s <= t) ? sreg[j] * fexp(bt + sg[128 + s] - mt) : 0.f; }
        for (int i = 0; i < 32; ++i) { const int e = F.tid + 512 * i, s = e >> 7, d = e & 127; A1[s * 128 + d] = bf2f(MLV[(row0 + s) * 512 + h * 128 + d]); }
        __syncthreads();
        float num[32]; float den = 0.f;
#pragma unroll
        for (int j = 0; j < 32; ++j) num[j] = 0.f;
#pragma nounroll
        for (int s = 0; s < 128; ++s) { const float p = A0[t * P + s]; den += p;
#pragma unroll
            for (int j = 0; j < 8; ++j) { const f32x4 vv = *(const LAS f32x4*)(A1 + s * 128 + eq * 32 + 4 * j); num[4 * j] += p * vv.x; num[4 * j + 1] += p * vv.y; num[4 * j + 2] += p * vv.z; num[4 * j + 3] += p * vv.w; } }
        den += w_inter * qn;
        const float rden = 1.f / fmaxf(fabsf(den), fexp(-mt));
        { const size_t o = (row0 + t) * 512 + h * 128 + eq * 32;
#pragma unroll
          for (int j = 0; j < 4; ++j) { const v4u og = *(const v4u*)(MLO + o + 8 * j); float y[8];
#pragma unroll
              for (int i = 0; i < 8; ++i) y[i] = (num[8 * j + i] + w_inter * acc2[8 * j + i]) * rden;
              v4u r; r.x = pk2(bflo(og.x) * y[0], bfhi(og.x) * y[1]); r.y = pk2(bflo(og.y) * y[2], bfhi(og.y) * y[3]); r.z = pk2(bflo(og.z) * y[4], bfhi(og.z) * y[5]); r.w = pk2(bflo(og.w) * y[6], bfhi(og.w) * y[7]);
              *(v4u*)(MLV + o + 8 * j) = r; } }
    }
    __syncthreads();
}

__device__ __forceinline__ void ln1_route(const Frame& F, const Args& args, int l) {
    const float* lng = inptr(F, 12) + (size_t)l * D; const float* lnb = inptr(F, 13) + (size_t)l * D;
    const float* wgrp = inptr(F, 14) + (size_t)l * D * 4; const float* bgrp = inptr(F, 15) + (size_t)l * 4;
    const float* brt = inptr(F, 17) + (size_t)l * NEXP;
    float* tokg = (float*)(F.ws + WS_TOKG); int* ent2 = (int*)(F.ws + WS_ENT2);
    unsigned* cnt = (unsigned*)(F.ctl + CW_CNT + l * 64 + F.cpass);
    LAS float* wl = (LAS float*)F.lds;
    LAS unsigned* lcnt = (LAS unsigned*)(F.lds + XTRA_OFF);
    LAS int* rec = (LAS int*)(F.lds + XTRA_OFF + 256);
    { const f32x4* src = (const f32x4*)(F.ws + WS_WRT);
#pragma unroll
      for (int i = 0; i < 16; ++i) *(LAS f32x4*)(wl + 4 * (F.tid + NTHR * i)) = src[F.tid + NTHR * i]; }
    if (F.tid < 64) lcnt[F.tid] = 0u;
    const int gw = F.bid * NWAVES + F.wave, NGW = F.G * NWAVES;
    f32x4 gv[4], bv[4], wg[4][4];
#pragma unroll
    for (int j = 0; j < 4; ++j) { gv[j] = *(const f32x4*)(lng + 4 * F.lane + 256 * j); bv[j] = *(const f32x4*)(lnb + 4 * F.lane + 256 * j);
#pragma unroll
        for (int i = 0; i < 4; ++i) wg[j][i] = *(const f32x4*)(wgrp + (size_t)(4 * F.lane + 256 * j + i) * 4); }
    __syncthreads();
    v2u vn[4];
    if (gw < T) {
#pragma unroll
        for (int j = 0; j < 4; ++j) vn[j] = *(const v2u*)(F.XB + (size_t)gw * D + 4 * F.lane + 256 * j); }
    int it = 0;
#pragma nounroll
    for (int row = gw; row < T; row += NGW, ++it) {
        f32x4 v[4]; float s = 0.f; const size_t ro = (size_t)row * D + 4 * F.lane;
#pragma unroll
        for (int j = 0; j < 4; ++j) { v[j] = (f32x4){bflo(vn[j].x), bfhi(vn[j].x), bflo(vn[j].y), bfhi(vn[j].y)}; s += (v[j].x + v[j].y) + (v[j].z + v[j].w); }
        if (row + NGW < T) {
#pragma unroll
            for (int j = 0; j < 4; ++j) vn[j] = *(const v2u*)(F.XB + ro + (size_t)NGW * D + 256 * j); }
        const float mean = wave_sum(s) * (1.f / D); float s2 = 0.f;
#pragma unroll
        for (int j = 0; j < 4; ++j) { v[j] = v[j] - mean; s2 += (v[j].x * v[j].x + v[j].y * v[j].y) + (v[j].z * v[j].z + v[j].w * v[j].w); }
        const float rstd = 1.f / sqrtf(wave_sum(s2) * (1.f / D) + LN_EPS);
#pragma unroll
        for (int j = 0; j < 4; ++j) { v[j] = v[j] * rstd * gv[j] + bv[j];
            v2u o; o.x = pk2(v[j].x, v[j].y); o.y = pk2(v[j].z, v[j].w); *(v2u*)(F.XB + ro + 256 * j) = o;
            *(unsigned*)(F.ws + WS_XB8 + ro + 256 * j) = f8pk4(v[j].x, v[j].y, v[j].z, v[j].w); }
#if defined(EXPT) && EXPT == 1
        if (F.cpass == 0) continue;
#endif
        float lg[4] = {0.f, 0.f, 0.f, 0.f};
#pragma unroll
        for (int j = 0; j < 4; ++j)
#pragma unroll
            for (int i = 0; i < 4; ++i) { const f32x4 w = wg[j][i]; const float xv = v[j][i]; lg[0] += xv * w.x; lg[1] += xv * w.y; lg[2] += xv * w.z; lg[3] += xv * w.w; }
#pragma unroll
        for (int c = 0; c < 4; ++c) lg[c] = wave_sum(lg[c]) + bgrp[c];
        int gt = 0; float gm = lg[0];
#pragma unroll
        for (int c = 1; c < 4; ++c) if (lg[c] > gm) { gm = lg[c]; gt = c; }
        float gs = 0.f;
#pragma unroll
        for (int c = 0; c < 4; ++c) gs += fexp(lg[c] - gm);
        const float pgsel = frcp(gs);
        gt = __builtin_amdgcn_readfirstlane(gt);
        float le[8];
#pragma unroll
        for (int c = 0; c < 8; ++c) { float a = 0.f;
#pragma unroll
            for (int j = 0; j < 4; ++j) { const f32x4 w = *(const LAS f32x4*)(wl + (gt * 8 + c) * 1024 + 4 * F.lane + 256 * j); a += (v[j].x * w.x + v[j].y * w.y) + (v[j].z * w.z + v[j].w * w.w); }
            le[c] = wave_sum(a) + brt[gt * 8 + c]; if (c == 3) asm volatile("" ::: "memory"); }
        int i0 = 0; float m0 = le[0];
#pragma unroll
        for (int c = 1; c < 8; ++c) if (le[c] > m0) { m0 = le[c]; i0 = c; }
        int i1 = (i0 == 0) ? 1 : 0; float m1 = -INFINITY;
#pragma unroll
        for (int c = 0; c < 8; ++c) if (c != i0 && le[c] > m1) { m1 = le[c]; i1 = c; }
        float one_ = 1.f; asm volatile("" : "+v"(one_));
        const float e1 = fexp(m1 - m0), inv = frcp(one_ + e1);
        if (F.lane == 0) {
            const int ex0 = gt * 8 + i0, ex1 = gt * 8 + i1;
            const unsigned p0 = __hip_atomic_fetch_add(lcnt + ex0, 1u, __ATOMIC_RELAXED, __HIP_MEMORY_SCOPE_WORKGROUP), p1 = __hip_atomic_fetch_add(lcnt + ex1, 1u, __ATOMIC_RELAXED, __HIP_MEMORY_SCOPE_WORKGROUP);
            LAS int* r = rec + (F.wave * 16 + it) * 4; r[0] = row; r[1] = ex0 | (ex1 << 8); r[2] = (int)p0; r[3] = (int)p1;
            tokg[2 * row] = pgsel * inv; tokg[2 * row + 1] = pgsel * e1 * inv; }
    }
    __syncthreads();
    if (F.tid < 32) { const unsigned c = lcnt[F.tid]; lcnt[32 + F.tid] = c ? __hip_atomic_fetch_add(cnt + F.tid, c, RLX_AGENT) : 0u; }
    __syncthreads();
    if (F.lane < it) { const LAS int* r = rec + (F.wave * 16 + F.lane) * 4; const int row = r[0], ex0 = r[1] & 255, ex1 = r[1] >> 8;
        ent2[(size_t)ex0 * 32768 + lcnt[32 + ex0] + r[2]] = 2 * row; ent2[(size_t)ex1 * 32768 + lcnt[32 + ex1] + r[3]] = 2 * row + 1; }
    __syncthreads();
}

__device__ __forceinline__ void moe_tiles(const Frame& F, int l, LAS int* pst, LAS int* cntl, LAS int* tile_e) {
    __syncthreads();
    if (F.tid < NEXP) { const unsigned* cnt = (const unsigned*)(F.ctl + CW_CNT + l * 64 + F.cpass); cntl[F.tid] = (int)__hip_atomic_load(cnt + F.tid, RLX_AGENT); }
    __syncthreads();
    if (F.tid == 0) { int run = 0;
#pragma nounroll
        for (int e = 0; e < NEXP; ++e) { pst[e] = run; run += (cntl[e] + 255) >> 8; }
        pst[NEXP] = run; }
    __syncthreads();
    const int total = pst[NEXP];
    for (int t = F.tid; t < total; t += NTHR) { int e = 0;
#pragma nounroll
        for (int q = 1; q < NEXP; ++q) e += (pst[q] <= t) ? 1 : 0;
        tile_e[t] = e; }
    __syncthreads();
}

namespace mx {
typedef float f32x16 __attribute__((ext_vector_type(16)));
typedef short s16x4 __attribute__((ext_vector_type(4)));
typedef short v4i16_t __attribute__((ext_vector_type(4)));
constexpr int LP = 136;
constexpr int IMG = 128 * LP * 2;
#define MX_MFMA(a, b, c) __builtin_amdgcn_mfma_f32_32x32x16_bf16(a, b, c, 0, 0, 0)
__device__ __forceinline__ int crow(int r, int hi) { return (r & 3) + 8 * (r >> 2) + 4 * hi; }
__device__ __forceinline__ bf16x8 frag_row(const LAS bf16* img, int row0, int k0, int lane) { return *(const LAS bf16x8*)(img + (row0 + (lane & 31)) * LP + k0 + 8 * (lane >> 5)); }
__device__ __forceinline__ s16x4 tr4(const LAS bf16* p) { return __builtin_bit_cast(s16x4, __builtin_amdgcn_ds_read_tr16_b64_v4i16((LAS v4i16_t*)p)); }
__device__ __forceinline__ bf16x8 frag_tr(const LAS bf16* img, int k0, int n0, int lane) {
    const LAS bf16* p = img + (k0 + 8 * (lane >> 5) + ((lane & 15) >> 2)) * LP + n0 + 16 * ((lane >> 4) & 1) + 4 * (lane & 3);
    const s16x4 lo = tr4(p), hi = tr4(p + 4 * LP);
    return (bf16x8){lo[0], lo[1], lo[2], lo[3], hi[0], hi[1], hi[2], hi[3]};
}
__device__ __forceinline__ bf16x8 frag_tr_acc(const LAS bf16* img, int k16, int n0, int lane) {
    const LAS bf16* p = img + (k16 + 4 * (lane >> 5) + ((lane & 15) >> 2)) * LP + n0 + 16 * ((lane >> 4) & 1) + 4 * (lane & 3);
    const s16x4 lo = tr4(p), hi = tr4(p + 8 * LP);
    return (bf16x8){lo[0], lo[1], lo[2], lo[3], hi[0], hi[1], hi[2], hi[3]};
}
__device__ __forceinline__ bf16x8 pack8(const f32x16& x, int s) {
    v4u w; w.x = pg8::cvt_pk_bf16(x[8 * s], x[8 * s + 1]); w.y = pg8::cvt_pk_bf16(x[8 * s + 2], x[8 * s + 3]); w.z = pg8::cvt_pk_bf16(x[8 * s + 4], x[8 * s + 5]); w.w = pg8::cvt_pk_bf16(x[8 * s + 6], x[8 * s + 7]);
    return __builtin_bit_cast(bf16x8, w);
}
__device__ __forceinline__ float swap_add(float v) { auto rr = __builtin_amdgcn_permlane32_swap(__float_as_uint(v), __float_as_uint(v), false, false); return __uint_as_float(rr[0]) + __uint_as_float(rr[1]); }
}

__device__ __forceinline__ void sgu_mfma(const Frame& F, int l) {
    using namespace mx;
    constexpr int VP = 520;
    static_assert(128 * VP * 2 <= SCR_BYTES, "SGU LDS map");
    bf16* SU = seg(F, S_SU); const bf16* SV = seg(F, S_SV);
    const float* lng = inptr(F, 6) + (size_t)l * 512; const float* lnb = inptr(F, 7) + (size_t)l * 512;
    const float* sb = inptr(F, 9) + (size_t)l * 4 * 128;
    const bf16* Wm = (const bf16*)(F.ws + WS_SGUW);
    LAS bf16* Vl = (LAS bf16*)F.lds;
    const int tb = F.wave & 3, ch = F.wave >> 2;
    for (int it = F.bid; it < 256; it += F.G) {
        int lane = F.lane; asm volatile("" : "+v"(lane));
        const int hi = lane >> 5;
        const size_t row0 = (size_t)it * 128;
        const f32x4 g0 = *(const f32x4*)(lng + lane * 8), g1 = *(const f32x4*)(lng + lane * 8 + 4), b0 = *(const f32x4*)(lnb + lane * 8), b1 = *(const f32x4*)(lnb + lane * 8 + 4);
        __syncthreads();
        v4u xr[16];
#pragma unroll
        for (int i = 0; i < 16; ++i) xr[i] = *(const v4u*)(SV + (row0 + F.wave * 16 + i) * 512 + lane * 8);
#pragma unroll
        for (int i = 0; i < 16; ++i) { const v4u x = xr[i];
            const float a0 = bflo(x.x), a1 = bfhi(x.x), a2 = bflo(x.y), a3 = bfhi(x.y), a4 = bflo(x.z), a5 = bfhi(x.z), a6 = bflo(x.w), a7 = bfhi(x.w);
            const float mean = wave_sum(((a0 + a1) + (a2 + a3)) + ((a4 + a5) + (a6 + a7))) * (1.f / 512.f);
            const float d0 = a0 - mean, d1 = a1 - mean, d2 = a2 - mean, d3 = a3 - mean, d4 = a4 - mean, d5 = a5 - mean, d6 = a6 - mean, d7 = a7 - mean;
            const float var = wave_sum(((d0 * d0 + d1 * d1) + (d2 * d2 + d3 * d3)) + ((d4 * d4 + d5 * d5) + (d6 * d6 + d7 * d7))) * (1.f / 512.f);
            const float rstd = 1.f / sqrtf(var + LN_EPS);
            v4u o; o.x = pk2(d0 * rstd * g0.x + b0.x, d1 * rstd * g0.y + b0.y); o.y = pk2(d2 * rstd * g0.z + b0.z, d3 * rstd * g0.w + b0.w);
            o.z = pk2(d4 * rstd * g1.x + b1.x, d5 * rstd * g1.y + b1.y); o.w = pk2(d6 * rstd * g1.z + b1.z, d7 * rstd * g1.w + b1.w);
            *(LAS v4u*)(Vl + (F.wave * 16 + i) * VP + lane * 8) = o; }
        __syncthreads();
#pragma nounroll
        for (int g = 0; g < 4; ++g) {
            f32x16 z0 = {}, z1 = {};
            const bf16* wrow = Wm + (size_t)g * 16384 + (size_t)(32 * tb + (lane & 31)) * 128 + 8 * hi;
            const int lim = 2 * tb + 2;
            bf16x8 af[8];
#pragma unroll
            for (int ks = 0; ks < 8; ++ks) af[ks] = (ks < lim) ? *(const bf16x8*)(wrow + 16 * ks) : (bf16x8){0, 0, 0, 0, 0, 0, 0, 0};
#pragma unroll
            for (int ks = 0; ks < 8; ++ks) { if (ks < lim) {
                const LAS bf16* p = Vl + (16 * ks + 8 * hi + ((lane & 15) >> 2)) * VP + g * 128 + 64 * ch + 16 * ((lane >> 4) & 1) + 4 * (lane & 3);
                const s16x4 l0 = tr4(p), h0 = tr4(p + 4 * VP), l1 = tr4(p + 32), h1 = tr4(p + 4 * VP + 32);
                z0 = MX_MFMA(af[ks], ((bf16x8){l0[0], l0[1], l0[2], l0[3], h0[0], h0[1], h0[2], h0[3]}), z0);
                z1 = MX_MFMA(af[ks], ((bf16x8){l1[0], l1[1], l1[2], l1[3], h1[0], h1[1], h1[2], h1[3]}), z1); } }
#pragma unroll
            for (int r = 0; r < 16; ++r) { const int t = 32 * tb + crow(r, hi); const float bs = sb[g * 128 + t];
                const size_t o = (row0 + t) * 512 + g * 128 + 64 * ch + (lane & 31);
                SU[o] = (bf16)f2bf(bf2f(SU[o]) * (z0[r] + bs)); SU[o + 32] = (bf16)f2bf(bf2f(SU[o + 32]) * (z1[r] + bs)); }
        }
    }
    __syncthreads();
}

__device__ __forceinline__ float scan128_sum(float x, int tid, int lane, LAS float* tmp) {
    float v = x;
#pragma unroll
    for (int o = 1; o < 64; o <<= 1) { const float t = __shfl_up(v, o); if (lane >= o) v += t; }
    if (tid == 63) tmp[0] = v;
    __syncthreads();
    if (tid >= 64 && tid < 128) v += tmp[0];
    return v;
}
__device__ __forceinline__ float scan128_max(float x, int tid, int lane, LAS float* tmp) {
    float v = x;
#pragma unroll
    for (int o = 1; o < 64; o <<= 1) { const float t = __shfl_up(v, o); if (lane >= o) v = fmaxf(v, t); }
    if (tid == 63) tmp[0] = v;
    __syncthreads();
    if (tid >= 64 && tid < 128) v = fmaxf(v, tmp[0]);
    return v;
}
template <bool ROWSCALE>
__device__ __forceinline__ void stage_conv(const Frame& F, LAS bf16* img, const bf16* srcseg, size_t rowb, int c, int h, const float* cw  , float scale, const LAS float* rs) {
    const int c8 = (F.tid & 15) * 8, s0 = (F.tid >> 4) * 4, tt0 = c * 128 + s0;
    f32x4 w0[4], w1[4];
#pragma unroll
    for (int j = 0; j < 4; ++j) { w0[j] = *(const f32x4*)(cw + j * 1024 + c8); w1[j] = *(const f32x4*)(cw + j * 1024 + c8 + 4); }
    v4u x[7];
#pragma unroll
    for (int r = 0; r < 7; ++r) { const int ts = tt0 - 3 + r; x[r] = (ts >= 0) ? *(const v4u*)(srcseg + (rowb + ts) * 512 + h * 128 + c8) : (v4u){0u, 0u, 0u, 0u}; }
#pragma unroll
    for (int i = 0; i < 4; ++i) { float acc[8] = {0.f, 0.f, 0.f, 0.f, 0.f, 0.f, 0.f, 0.f};
#pragma unroll
        for (int j = 0; j < 4; ++j) { const v4u xv = x[i + j];
            acc[0] += w0[j].x * bflo(xv.x); acc[1] += w0[j].y * bfhi(xv.x); acc[2] += w0[j].z * bflo(xv.y); acc[3] += w0[j].w * bfhi(xv.y);
            acc[4] += w1[j].x * bflo(xv.z); acc[5] += w1[j].y * bfhi(xv.z); acc[6] += w1[j].z * bflo(xv.w); acc[7] += w1[j].w * bfhi(xv.w); }
        float sc = scale; if (ROWSCALE) sc *= rs[s0 + i];
        v4u o; o.x = pk2(siluf_(acc[0]) * sc, siluf_(acc[1]) * sc); o.y = pk2(siluf_(acc[2]) * sc, siluf_(acc[3]) * sc); o.z = pk2(siluf_(acc[4]) * sc, siluf_(acc[5]) * sc); o.w = pk2(siluf_(acc[6]) * sc, siluf_(acc[7]) * sc);
        *(LAS v4u*)(img + (s0 + i) * mx::LP + c8) = o; }
}
__device__ __forceinline__ void stage_copy(const Frame& F, LAS bf16* img, const bf16* srcseg, size_t row0, int h) {
#pragma unroll
    for (int i = 0; i < 4; ++i) { const int e = F.tid + NTHR * i, s = e >> 4, c8 = (e & 15) * 8;
        *(LAS v4u*)(img + s * mx::LP + c8) = *(const v4u*)(srcseg + (row0 + s) * 512 + h * 128 + c8); }
}

__device__ __forceinline__ void mlstm_m1_mfma(const Frame& F, int l) {
    using namespace mx;
    const bf16* MLK = seg(F, S_MLK); const bf16* MLV = seg(F, S_MLV);
    const float* cw = inptr(F, 5) + (size_t)l * 4 * 1024;
    const float* mli = (const float*)(F.ws + WS_MLI); const float* mlf = (const float*)(F.ws + WS_MLF);
    float* UC = F.XF; float* NV = (float*)(F.ws + WS_NV); float* MST = (float*)(F.ws + WS_MST);
    LAS bf16* Kl = (LAS bf16*)F.lds; LAS bf16* Vl = (LAS bf16*)(F.lds + IMG);
    LAS float* sg = (LAS float*)(F.lds + 2 * IMG);
    const int lane = F.lane, hi = lane >> 5, db = F.wave & 3, eh = F.wave >> 2;
    for (int it = F.bid; it < 1024; it += F.G) {
        const int bh4 = it >> 5, c = it & 31, b = bh4 >> 2, h = bh4 & 3;
        const size_t rowb = (size_t)b * SEQ, row0 = rowb + c * 128;
        __syncthreads();
        float mg, blast;
        { const bool act = F.tid < 128; const float lf = act ? mlf[(row0 + F.tid) * 4 + h] : 0.f, li = act ? mli[(row0 + F.tid) * 4 + h] : 0.f;
          const float bc = scan128_sum(lf, F.tid, F.lane, sg + 384);
          if (F.tid == 127) sg[385] = bc;
          __syncthreads();
          blast = sg[385];
          const float g = blast - bc + li;
          float gm = act ? g : -INFINITY; gm = wave_max(gm);
          if (F.lane == 0 && F.wave < 2) sg[386 + F.wave] = gm;
          __syncthreads();
          mg = fmaxf(sg[386], sg[387]);
          if (act) sg[256 + F.tid] = fexp(g - mg);
          __syncthreads(); }
        stage_conv<true>(F, Kl, MLK, rowb, c, h, cw + 512 + h * 128, 0.08838834764831845f, sg + 256);
        stage_copy(F, Vl, MLV, row0, h);
        __syncthreads();
        f32x16 u0 = {}, u1 = {};
#pragma unroll
        for (int ks = 0; ks < 8; ++ks) { const bf16x8 a = frag_tr(Kl, 16 * ks, 32 * db, lane);
            u0 = MX_MFMA(a, frag_tr(Vl, 16 * ks, 64 * eh, lane), u0); u1 = MX_MFMA(a, frag_tr(Vl, 16 * ks, 64 * eh + 32, lane), u1); }
        bf16* Uo = (bf16*)UC + (size_t)it * 16384;
#pragma unroll
        for (int r = 0; r < 16; ++r) { const int d = 32 * db + crow(r, hi); Uo[d * 128 + 64 * eh + (lane & 31)] = (bf16)f2bf(u0[r]); Uo[d * 128 + 64 * eh + 32 + (lane & 31)] = (bf16)f2bf(u1[r]); }
        if (F.tid < 128) { float n = 0.f;
#pragma nounroll
            for (int s = 0; s < 128; ++s) n += bf2f(Kl[s * LP + F.tid]); NV[(size_t)it * 128 + F.tid] = n; }
        if (F.tid == 0) { MST[it * 4] = mg; MST[it * 4 + 1] = blast; }
    }
    __syncthreads();
}

__device__ __forceinline__ void mlstm_m3_mfma(const Frame& F, int l) {
    using namespace mx;
    const bf16* MLQ = seg(F, S_MLQ); const bf16* MLK = seg(F, S_MLK); bf16* MLV = seg(F, S_MLV); const bf16* MLO = seg(F, S_MLO);
    const float* cw = inptr(F, 5) + (size_t)l * 4 * 1024;
    const float* mli = (const float*)(F.ws + WS_MLI); const float* mlf = (const float*)(F.ws + WS_MLF);
    const float* UC = (const float*)F.XF; const float* NV = (const float*)(F.ws + WS_NV); const float* MST = (const float*)(F.ws + WS_MST);
    LAS bf16* Ql = (LAS bf16*)F.lds; LAS bf16* Kl = (LAS bf16*)(F.lds + IMG); LAS bf16* Vl = (LAS bf16*)(F.lds + 2 * IMG); LAS bf16* Cl = (LAS bf16*)(F.lds + 3 * IMG);
    LAS float* sg = (LAS float*)(F.lds + 4 * IMG);
    static_assert(4 * IMG + (768 + 256) * 4 <= SCR_BYTES, "M3 LDS map");
    const int qb = F.wave & 3, eh = F.wave >> 2;
    for (int it = F.bid; it < 1024; it += F.G) {
        int lane = F.lane; asm volatile("" : "+v"(lane));
        const int hi = lane >> 5, r32 = lane & 31;
        const int bh4 = it >> 5, c = it & 31, b = bh4 >> 2, h = bh4 & 3;
        const size_t rowb = (size_t)b * SEQ, row0 = rowb + c * 128;
        const float m_in = MST[it * 4 + 2];
        __syncthreads();
#if defined(EXPT) && EXPT == 6
        if (F.cpass != 0)
#endif
        { const bool act = F.tid < 128; const float lf = act ? mlf[(row0 + F.tid) * 4 + h] : 0.f, li = act ? mli[(row0 + F.tid) * 4 + h] : 0.f;
          if (act) sg[512 + F.tid] = NV[(size_t)it * 128 + F.tid];
          const float bc = scan128_sum(lf, F.tid, F.lane, sg + 640);
          const float a = li - bc;
          const float pm = scan128_max(act ? a : -INFINITY, F.tid, F.lane, sg + 641);
          if (act) { const float inter = bc + m_in, mt = fmaxf(inter, bc + pm);
              sg[128 + F.tid] = a; sg[256 + F.tid] = fexp(inter - mt); sg[384 + F.tid] = fexp(-mt); sg[F.tid] = bc - mt; } }
#if defined(EXPT) && EXPT == 7
        if (F.cpass != 0)
#endif
        { stage_conv<false>(F, Ql, MLQ, rowb, c, h, cw + h * 128, 1.f, nullptr);
        stage_conv<false>(F, Kl, MLK, rowb, c, h, cw + 512 + h * 128, 0.08838834764831845f, nullptr); }
        stage_copy(F, Vl, MLV, row0, h);
        { const bf16* Cg = (const bf16*)UC + (size_t)it * 16384;
#pragma unroll
          for (int i = 0; i < 4; ++i) { const int e = F.tid + NTHR * i, d = e >> 4, c8 = (e & 15) * 8; *(LAS v4u*)(Cl + d * LP + c8) = *(const v4u*)(Cg + d * 128 + c8); } }
        __syncthreads();
        const int t = 32 * qb + r32;
        const float btl = sg[t];
        f32x16 o0 = {}, o1 = {}; float den = 0.f;
#pragma nounroll
        for (int j = 0; j <= qb; ++j) {
            f32x16 s = {};
#pragma unroll
            for (int ks = 0; ks < 8; ++ks) s = MX_MFMA(frag_row(Kl, 32 * j, 16 * ks, lane), frag_row(Ql, 32 * qb, 16 * ks, lane), s);
#pragma unroll
            for (int g = 0; g < 4; ++g) { const f32x4 av = *(const LAS f32x4*)(sg + 128 + 32 * j + 8 * g + 4 * hi);
#pragma unroll
                for (int i = 0; i < 4; ++i) { const int kv = 32 * j + 8 * g + 4 * hi + i; const float p = (kv <= t) ? s[4 * g + i] * fexp(btl + av[i]) : 0.f; s[4 * g + i] = p; den += p; } }
#pragma unroll
            for (int k2 = 0; k2 < 2; ++k2) { const bf16x8 pa = pack8(s, k2);
                o0 = MX_MFMA(pa, frag_tr_acc(Vl, 32 * j + 16 * k2, 64 * eh, lane), o0); o1 = MX_MFMA(pa, frag_tr_acc(Vl, 32 * j + 16 * k2, 64 * eh + 32, lane), o1); }
        }
        f32x16 c0 = {}, c1 = {};
#pragma unroll
        for (int ks = 0; ks < 8; ++ks) { const bf16x8 a = frag_row(Ql, 32 * qb, 16 * ks, lane);
            c0 = MX_MFMA(a, frag_tr(Cl, 16 * ks, 64 * eh, lane), c0); c1 = MX_MFMA(a, frag_tr(Cl, 16 * ks, 64 * eh + 32, lane), c1); }
        float qn = 0.f;
#pragma unroll
        for (int i = 0; i < 8; ++i) { const v4u qv = *(const LAS v4u*)(Ql + t * LP + 64 * hi + 8 * i); const LAS float* np = sg + 512 + 64 * hi + 8 * i;
            qn += bflo(qv.x) * np[0] + bfhi(qv.x) * np[1] + bflo(qv.y) * np[2] + bfhi(qv.y) * np[3] + bflo(qv.z) * np[4] + bfhi(qv.z) * np[5] + bflo(qv.w) * np[6] + bfhi(qv.w) * np[7]; }
        den = swap_add(den); qn = swap_add(qn);
        const float dtot = den + sg[256 + t] * qn;
        LAS float* wd = sg + 768 + F.wave * 32;
        if (hi == 0) wd[r32] = 1.f / fmaxf(fabsf(dtot), sg[384 + t]);
        asm volatile("s_waitcnt lgkmcnt(0)" ::: "memory");
#if defined(EXPT) && EXPT == 5
        if (F.cpass != 0)
#endif
#pragma unroll
        for (int r = 0; r < 16; ++r) { const int tl = crow(r, hi), tq = 32 * qb + tl; const float wi = sg[256 + tq], rd = wd[tl];
            const size_t o = (row0 + tq) * 512 + h * 128 + 64 * eh + r32;
            MLV[o] = (bf16)f2bf(bf2f(MLO[o]) * (o0[r] + wi * c0[r]) * rd); MLV[o + 32] = (bf16)f2bf(bf2f(MLO[o + 32]) * (o1[r] + wi * c1[r]) * rd); }
    }
    __syncthreads();
}


using pg8::Unit;
template <int K, int nM, int nN, int RB, int CB> struct SchedPlain {
    static_assert(RB * CB == 32 && nM % RB == 0 && nN % CB == 0, "block shape"); static constexpr bool GATHER = false;
    __device__ __forceinline__ unsigned rowoff(const Unit&, int) const { return 0u; }
    const char* A; const char* B; int G, c;
    __device__ __forceinline__ int ktiles() const { return K / 64; }
    __device__ __forceinline__ int lda() const { return K; }
    __device__ __forceinline__ int ldb() const { return K; }
    __device__ __forceinline__ bool next(int i, Unit& u) const {
        u.ex = 0;
        if (G == 256) { const int x = c & 7, j = c >> 3, bi = 8 * i + x; constexpr int nrb = nM / RB, ncb = nN / CB; if (bi >= nrb * ncb) return false;
            u.pm = (bi % nrb) * RB + (j % RB); u.pn = (bi / nrb) * CB + (j / RB); return true; }
        const int L = i * G + c; if (L >= nM * nN) return false; u.pm = L % nM; u.pn = L / nM; return true; }
    __device__ __forceinline__ const char* aptr(const Unit& u, int t) const { return A + ((size_t)u.pm * 256 * K + (size_t)t * 64) * 2; }
    __device__ __forceinline__ const char* bptr(const Unit& u, int t) const { return B + ((size_t)u.pn * 256 * K + (size_t)t * 64) * 2; }
};
struct SchedInProj {
    static constexpr bool GATHER = false;
    const char* A; const char* B; int G, c;
    __device__ __forceinline__ unsigned rowoff(const Unit&, int) const { return 0u; }
    __device__ __forceinline__ int ktiles() const { return 8; }
    __device__ __forceinline__ int lda() const { return 512; }
    __device__ __forceinline__ int ldb() const { return 512; }
    __device__ __forceinline__ bool next(int i, Unit& u) const {
        u.ex = 0; u.nv = 256;
        if (G == 256) { const int x = c & 7, j = c >> 3; if (i >= 15) return false;
            if (i < 14) { const int bi = 8 * i + x; u.pm = (bi & 15) * 8 + (j & 7); u.pn = (bi >> 4) * 4 + (j >> 3); }
            else { u.pm = x * 16 + (j & 15); u.pn = 28 + (j >> 4); }
            return true; }
        const int L = i * G + c; if (L >= 128 * 30) return false; u.pm = L % 128; u.pn = L / 128; return true; }
    __device__ __forceinline__ const char* aptr(const Unit& u, int t) const { return A + (size_t)u.pm * 256 * 1024 + (size_t)t * 128; }
    __device__ __forceinline__ const char* bptr(const Unit& u, int t) const { return B + (size_t)u.pn * 256 * 1024 + (size_t)t * 128; }
};
struct SchedMerge {
    static constexpr bool GATHER = false;
    __device__ __forceinline__ unsigned rowoff(const Unit&, int) const { return 0u; }
    const char* H0; const char* B; int G, c;
    __device__ __forceinline__ int ktiles() const { return 24; }
    __device__ __forceinline__ int lda() const { return 512; }
    __device__ __forceinline__ int ldb() const { return 1536; }
    __device__ __forceinline__ bool next(int i, Unit& u) const { u.ex = 0;
        if (G == 256) { const int x = c & 7, j = c >> 3, bi = 8 * i + x; if (bi >= 16) return false; u.pm = bi * 8 + (j & 7); u.pn = j >> 3; return true; }
        const int L = i * G + c; if (L >= 128 * 4) return false; u.pm = L >> 2; u.pn = L & 3; return true; }
    __device__ __forceinline__ const char* aptr(const Unit& u, int t) const { const int s = t >> 3; return H0 + ((size_t)(5 * s - 3 * (s >> 1)) * SEGE + (size_t)u.pm * 256 * 512 + (size_t)(t & 7) * 64) * 2; }
    __device__ __forceinline__ const char* bptr(const Unit& u, int t) const { return B + ((size_t)u.pn * 256 * 1536 + (size_t)t * 64) * 2; }
};
constexpr int MOE_CAP = 32768;
template <int K, int ROWB, bool BYTOK> struct SchedMoe {
    static constexpr bool GATHER = true;
    const char* A; const char* B; const int* ent2; int ntiles; const LAS int* tile_e; const LAS int* pst; const LAS int* cntl; int G, c;
    __device__ __forceinline__ int ktiles() const { return K / 64; }
    __device__ __forceinline__ int lda() const { return K; }
    __device__ __forceinline__ int ldb() const { return K; }
    __device__ __forceinline__ bool next(int i, Unit& u) const {
        int gt;
        if (G == 256) { const int x = c & 7, j = c >> 3; gt = (8 * i + x) * 8 + (j & 7); u.pn = j >> 3; if ((8 * i + x) * 8 >= ntiles) return false; if (gt >= ntiles) gt = ntiles - 1; }
        else { const int L = i * G + c; if (L >= ntiles * 4) return false; gt = L >> 2; u.pn = L & 3; }
        u.gt = gt; u.ex = __builtin_amdgcn_readfirstlane(tile_e[gt]); u.pm = gt - __builtin_amdgcn_readfirstlane(pst[u.ex]);
        const int left = __builtin_amdgcn_readfirstlane(cntl[u.ex]) - 256 * u.pm; u.nv = left < 256 ? left : 256; return true; }
    __device__ __forceinline__ const char* aptr(const Unit&, int t) const { return A + (size_t)t * 128; }
    __device__ __forceinline__ const char* bptr(const Unit& u, int t) const { return B + (((size_t)u.ex * 1024 + (size_t)u.pn * 256) * K + (size_t)t * 64) * 2; }
    __device__ __forceinline__ unsigned rowoff(const Unit& u, int r) const {
        const int rc = r < u.nv ? r : u.nv - 1;
        const int slot = ent2[(size_t)u.ex * MOE_CAP + 256 * u.pm + rc]; return (unsigned)(BYTOK ? (slot >> 1) : slot) * (unsigned)ROWB; }
};

struct SchedMoe1 {
    static constexpr bool GATHER = true;
    const char* A; const char* B; const int* ent2; int ntiles; const LAS int* tile_e; const LAS int* pst; const LAS int* cntl; int G, c;
    __device__ __forceinline__ int ktiles() const { return 8; }
    __device__ __forceinline__ int lda() const { return 512; }
    __device__ __forceinline__ int ldb() const { return 512; }
    __device__ __forceinline__ bool next(int i, Unit& u) const {
        int gt;
        if (G == 256) { const int x = c & 7, j = c >> 3; gt = (8 * i + x) * 8 + (j & 7); u.pn = j >> 3; if ((8 * i + x) * 8 >= ntiles) return false; if (gt >= ntiles) gt = ntiles - 1; }
        else { const int L = i * G + c; if (L >= ntiles * 4) return false; gt = L >> 2; u.pn = L & 3; }
        u.gt = gt; u.ex = __builtin_amdgcn_readfirstlane(tile_e[gt]); u.pm = gt - __builtin_amdgcn_readfirstlane(pst[u.ex]);
        const int left = __builtin_amdgcn_readfirstlane(cntl[u.ex]) - 256 * u.pm; u.nv = left < 256 ? left : 256; return true; }
    __device__ __forceinline__ const char* aptr(const Unit&, int t) const { return A + (size_t)t * 128; }
    __device__ __forceinline__ const char* bptr(const Unit& u, int t) const { return B + ((size_t)u.ex * 1024 + (size_t)u.pn * 256) * 1024 + (size_t)t * 128; }
    __device__ __forceinline__ unsigned rowoff(const Unit& u, int r) const {
        const int rc = r < u.nv ? r : u.nv - 1;
        const int slot = ent2[(size_t)u.ex * MOE_CAP + 256 * u.pm + rc]; return (unsigned)(slot >> 1) * 1024u; }
};
struct SchedMoe2 {
    static constexpr bool GATHER = false;
    const char* A; const char* B; int ntiles; const LAS int* tile_e; const LAS int* pst; const LAS int* cntl; int G, c;
    __device__ __forceinline__ unsigned rowoff(const Unit&, int) const { return 0u; }
    __device__ __forceinline__ int ktiles() const { return 4; }
    __device__ __forceinline__ int lda() const { return 256; }
    __device__ __forceinline__ int ldb() const { return 256; }
    __device__ __forceinline__ bool next(int i, Unit& u) const {
        int gt;
        if (G == 256) { const int x = c & 7, j = c >> 3; gt = (8 * i + x) * 8 + (j & 7); u.pn = j >> 3; if ((8 * i + x) * 8 >= ntiles) return false; if (gt >= ntiles) gt = ntiles - 1; }
        else { const int L = i * G + c; if (L >= ntiles * 4) return false; gt = L >> 2; u.pn = L & 3; }
        u.gt = gt; u.ex = __builtin_amdgcn_readfirstlane(tile_e[gt]); u.pm = gt - __builtin_amdgcn_readfirstlane(pst[u.ex]);
        const int left = __builtin_amdgcn_readfirstlane(cntl[u.ex]) - 256 * u.pm; u.nv = left < 256 ? left : 256; return true; }
    __device__ __forceinline__ const char* aptr(const Unit& u, int t) const { return A + (size_t)u.gt * 256 * 512 + (size_t)t * 128; }
    __device__ __forceinline__ const char* bptr(const Unit& u, int t) const { return B + ((size_t)u.ex * 1024 + (size_t)u.pn * 256) * 512 + (size_t)t * 128; }
};

typedef pg8::f32x4 (AccT)[2][2][4][2];
__device__ __forceinline__ void st16_wt(void* p, v4u v) { asm volatile("global_store_dwordx4 %0, %1, off sc1\n\ts_nop 1" :: "v"(p), "v"(v) : "memory"); }
__device__ __forceinline__ void st8_wt(void* p, v2u v) { asm volatile("global_store_dwordx2 %0, %1, off sc1\n\ts_nop 1" :: "v"(p), "v"(v) : "memory"); }
__device__ __forceinline__ unsigned char* gate_tile(bf16* H, int pm, int gt) { return (unsigned char*)(H + (size_t)S_G0 * SEGE) + ((size_t)(gt >> 2) * 128 * 4 + (size_t)pm * 4 + (gt & 3)) * 65536; }
__device__ __forceinline__ unsigned gate_q(float g) { const float q = fmaxf(__builtin_rintf(g * 255.f), 1.f); return (unsigned)q; }
struct EpiInProj {
    static constexpr bool PERM = true, HAS_MID = false, F8 = false, I8 = true; static constexpr int SEG = 0;
    bf16* H; const float* bias; const float* sA; const unsigned* cmax;
    __device__ __forceinline__ void mid(AccT&, const Unit&, int, int, int, int, int) const {}
    __device__ __forceinline__ void operator()(AccT& acc, const Unit& u, int wr, int wc, int fr, int fq) const {
        asm volatile("" : "+v"(fr), "+v"(fq));
        const int sg = u.pn >> 1; bf16* base = H + (size_t)sg * SEGE;
        const int act = (sg == S_Q) ? 1 : ((sg == S_MLO || sg >= S_G0) ? 2 : ((sg == S_SU || sg == S_SV) ? 3 : 0));
        const int row0 = u.pm * 256 + wr * 64 + fr, col0 = (u.pn & 1) * 256 + wc * 32 + 8 * fq, bcol0 = u.pn * 256 + wc * 32 + 8 * fq;
        const int tid8 = (((wr * 4 + wc) * 64) + fq * 16 + fr) * 8;
        f32x4 bv[2][2], sw[2][2];
#pragma unroll
        for (int bj = 0; bj < 2; ++bj)
#pragma unroll
            for (int n = 0; n < 2; ++n) { bv[bj][n] = *(const f32x4*)(bias + bcol0 + bj * 128 + 4 * n); { const float c0 = __builtin_bit_cast(float, cmax[(bcol0 + bj * 128) >> 5]) * (1.f / 127.f); sw[bj][n] = (f32x4){c0, c0, c0, c0}; }
            }
#pragma unroll
        for (int ai = 0; ai < 2; ++ai)
#pragma unroll
            for (int m = 0; m < 4; ++m) { const int row = row0 + ai * 128 + m * 16; bf16* rowp = base + (size_t)row * 512 + col0; const float sa = sA[row];
#pragma unroll
                for (int bj = 0; bj < 2; ++bj) { const pg8::i32x4 i0 = __builtin_bit_cast(pg8::i32x4, acc[ai][bj][m][0]), i1 = __builtin_bit_cast(pg8::i32x4, acc[ai][bj][m][1]); f32x4 v0, v1;
#pragma unroll
                    for (int i = 0; i < 4; ++i) { v0[i] = (float)i0[i] * (sa * sw[bj][0][i]) + bv[bj][0][i]; v1[i] = (float)i1[i] * (sa * sw[bj][1][i]) + bv[bj][1][i]; }
                    if (act == 1) { v0 = v0 * QSCALE; v1 = v1 * QSCALE; }
                    else if (act == 2) {
#pragma unroll
                        for (int i = 0; i < 4; ++i) { v0[i] = sigmoidf_(v0[i]); v1[i] = sigmoidf_(v1[i]); } }
                    else if (act == 3) {
#pragma unroll
                        for (int i = 0; i < 4; ++i) { v0[i] = gelu_tanh(v0[i]); v1[i] = gelu_tanh(v1[i]); } }
                    v4u w; w.x = pg8::cvt_pk_bf16(v0[0], v0[1]); w.y = pg8::cvt_pk_bf16(v0[2], v0[3]); w.z = pg8::cvt_pk_bf16(v1[0], v1[1]); w.w = pg8::cvt_pk_bf16(v1[2], v1[3]);
                    if (sg >= S_G0) { v2u q; q.x = gate_q(v0[0]) | (gate_q(v0[1]) << 8) | (gate_q(v0[2]) << 16) | (gate_q(v0[3]) << 24); q.y = gate_q(v1[0]) | (gate_q(v1[1]) << 8) | (gate_q(v1[2]) << 16) | (gate_q(v1[3]) << 24);
                        st8_wt(gate_tile(H, u.pm, u.pn - 2 * S_G0) + (size_t)(((ai * 4 + m) * 2 + bj) * 4096 + tid8), q); }
                    else st16_wt(rowp + bj * 128, w); } }
    }
};
struct EpiMerge {
    static constexpr bool PERM = true, HAS_MID = true, F8 = false, I8 = false;
    bf16* Hb;
    bf16* O;
    template <int MODE>
    __device__ __forceinline__ void scale(AccT& acc, const Unit& u, int n, int wr, int wc, int fr, int fq) const {
        const int tid8 = (((wr * 4 + wc) * 64) + fq * 16 + fr) * 8;
        const unsigned char* g0 = gate_tile(Hb, u.pm, n * 4 + u.pn) + tid8; const unsigned char* g1 = gate_tile(Hb, u.pm, (MODE == 0 ? n + 1 : n) * 4 + u.pn) + tid8;
#pragma unroll
        for (int ai = 0; ai < 2; ++ai)
#pragma unroll
            for (int m = 0; m < 4; ++m) {
#pragma unroll
                for (int bj = 0; bj < 2; ++bj) { const int fo = ((ai * 4 + m) * 2 + bj) * 4096; const v2u a = *(const v2u*)(g0 + fo);
                    float r[8] = {(float)(a.x & 255u), (float)((a.x >> 8) & 255u), (float)((a.x >> 16) & 255u), (float)(a.x >> 24), (float)(a.y & 255u), (float)((a.y >> 8) & 255u), (float)((a.y >> 16) & 255u), (float)(a.y >> 24)};
                    if (MODE == 0) { const v2u b = *(const v2u*)(g1 + fo);
                        const float d[8] = {(float)(b.x & 255u), (float)((b.x >> 8) & 255u), (float)((b.x >> 16) & 255u), (float)(b.x >> 24), (float)(b.y & 255u), (float)((b.y >> 8) & 255u), (float)((b.y >> 16) & 255u), (float)(b.y >> 24)};
#pragma unroll
                        for (int i = 0; i < 8; ++i) r[i] = r[i] * frcp(fmaxf(d[i], 1.f)); }
                    else {
#pragma unroll
                        for (int i = 0; i < 8; ++i) r[i] *= (1.f / 255.f); }
#pragma unroll
                    for (int i = 0; i < 4; ++i) { acc[ai][bj][m][0][i] *= r[i]; acc[ai][bj][m][1][i] *= r[4 + i]; } } }
    }
    static constexpr int SEG = 8;
    __device__ __forceinline__ void mid(AccT& acc, const Unit& u, int t, int wr, int wc, int fr, int fq) const { scale<0>(acc, u, (t >> 3) - 1, wr, wc, fr, fq); }
    __device__ __forceinline__ void operator()(AccT& acc, const Unit& u, int wr, int wc, int fr, int fq) const {
        scale<1>(acc, u, 2, wr, wc, fr, fq);
        const int row0 = u.pm * 256 + wr * 64 + fr, col0 = u.pn * 256 + wc * 32 + 8 * fq;
#pragma unroll
        for (int ai = 0; ai < 2; ++ai)
#pragma unroll
            for (int m = 0; m < 4; ++m) { bf16* rowp = O + (size_t)(row0 + ai * 128 + m * 16) * 1024 + col0;
#pragma unroll
                for (int bj = 0; bj < 2; ++bj) { const f32x4 v0 = acc[ai][bj][m][0], v1 = acc[ai][bj][m][1];
                    v4u w; w.x = pg8::cvt_pk_bf16(v0[0], v0[1]); w.y = pg8::cvt_pk_bf16(v0[2], v0[3]); w.z = pg8::cvt_pk_bf16(v1[0], v1[1]); w.w = pg8::cvt_pk_bf16(v1[2], v1[3]);
                    *(v4u*)(rowp + bj * 128) = w; } }
    }
};
struct EpiWout {
    static constexpr bool PERM = true, HAS_MID = false, F8 = false, I8 = false; static constexpr int SEG = 0;
    bf16* XB;
    __device__ __forceinline__ void mid(AccT&, const Unit&, int, int, int, int, int) const {}
    __device__ __forceinline__ void operator()(AccT& acc, const Unit& u, int wr, int wc, int fr, int fq) const {
        const int row0 = u.pm * 256 + wr * 64 + fr, col0 = u.pn * 256 + wc * 32 + 8 * fq;
#pragma unroll
        for (int ai = 0; ai < 2; ++ai)
#pragma unroll
            for (int m = 0; m < 4; ++m) { bf16* rowp = XB + (size_t)(row0 + ai * 128 + m * 16) * 1024 + col0;
#pragma unroll
                for (int bj = 0; bj < 2; ++bj) { const v4u x = *(const v4u*)(rowp + bj * 128); const f32x4 v0 = acc[ai][bj][m][0], v1 = acc[ai][bj][m][1];
                    v4u w; w.x = pg8::cvt_pk_bf16(ALPHA * bflo(x.x) + v0[0], ALPHA * bfhi(x.x) + v0[1]); w.y = pg8::cvt_pk_bf16(ALPHA * bflo(x.y) + v0[2], ALPHA * bfhi(x.y) + v0[3]);
                    w.z = pg8::cvt_pk_bf16(ALPHA * bflo(x.z) + v1[0], ALPHA * bfhi(x.z) + v1[1]); w.w = pg8::cvt_pk_bf16(ALPHA * bflo(x.w) + v1[2], ALPHA * bfhi(x.w) + v1[3]);
                    *(v4u*)(rowp + bj * 128) = w; } }
    }
};
constexpr float HSCALE = 8.f;
__device__ __forceinline__ unsigned f8pk4s(float a, float b, float c, float d, float sc) { int w = 0; w = __builtin_amdgcn_cvt_pk_fp8_f32(f8clamp(a * sc), f8clamp(b * sc), w, false); w = __builtin_amdgcn_cvt_pk_fp8_f32(f8clamp(c * sc), f8clamp(d * sc), w, true); return (unsigned)w; }
struct EpiMoe1 {
    static constexpr bool PERM = true, HAS_MID = false, F8 = true, I8 = false; static constexpr int SEG = 0;
    unsigned char* HID;
    __device__ __forceinline__ void mid(AccT&, const Unit&, int, int, int, int, int) const {}
    __device__ __forceinline__ void operator()(AccT& acc, const Unit& u, int wr, int wc, int fr, int fq) const {
        asm volatile("" : "+v"(fr), "+v"(fq));
        const int r0 = wr * 64 + fr, col0 = u.pn * 128 + wc * 32 + 8 * fq; unsigned char* tp = HID + (size_t)u.gt * 256 * 512 + col0;
#pragma unroll
        for (int ai = 0; ai < 2; ++ai)
#pragma unroll
            for (int m = 0; m < 4; ++m) { const int r = r0 + ai * 128 + m * 16;
                if (r < u.nv) { float h[8];
#pragma unroll
                    for (int i = 0; i < 4; ++i) { h[i] = siluf_(acc[ai][0][m][0][i] * W8INV) * acc[ai][1][m][0][i]; h[4 + i] = siluf_(acc[ai][0][m][1][i] * W8INV) * acc[ai][1][m][1][i]; }
                    v2u w; w.x = f8pk4s(h[0], h[1], h[2], h[3], W8INV * HSCALE); w.y = f8pk4s(h[4], h[5], h[6], h[7], W8INV * HSCALE);
                    *(v2u*)(tp + (size_t)r * 512) = w; }
                asm volatile("" ::: "memory"); }
    }
};
constexpr float YSCALE = 16.f, YINV = 1.f / 16.f;
struct EpiMoe2 {
    static constexpr bool PERM = true, HAS_MID = false, F8 = true, I8 = false; static constexpr int SEG = 0;
    unsigned char* Y; const int* ent2;
    __device__ __forceinline__ void mid(AccT&, const Unit&, int, int, int, int, int) const {}
    __device__ __forceinline__ void operator()(AccT& acc, const Unit& u, int wr, int wc, int fr, int fq) const {
        asm volatile("" : "+v"(fr), "+v"(fq));
        const int r0 = wr * 64 + fr, col0 = u.pn * 256 + wc * 32 + 8 * fq; const int* ep = ent2 + (size_t)u.ex * MOE_CAP + 256 * u.pm;
        constexpr float sc = YSCALE / (W8SCALE * HSCALE);
#pragma unroll
        for (int ai = 0; ai < 2; ++ai)
#pragma unroll
            for (int m = 0; m < 4; ++m) { const int r = r0 + ai * 128 + m * 16;
                if (r < u.nv) { unsigned char* rowp = Y + (size_t)ep[r] * 1024 + col0;
#pragma unroll
                    for (int bj = 0; bj < 2; ++bj) { const f32x4 v0 = acc[ai][bj][m][0], v1 = acc[ai][bj][m][1];
                        v2u w; w.x = f8pk4s(v0[0], v0[1], v0[2], v0[3], sc); w.y = f8pk4s(v1[0], v1[1], v1[2], v1[3], sc);
                        *(v2u*)(rowp + bj * 128) = w; } }
                asm volatile("" ::: "memory"); }
    }
};

#include <hip/hip_bf16.h>
#include <cmath>
namespace attn_body {
using bf16=__hip_bfloat16;
using bf16x8=__attribute__((ext_vector_type(8)))short;
using s16x4=__attribute__((ext_vector_type(4)))short;
using f32x16=__attribute__((ext_vector_type(16)))float;
using u32x4=__attribute__((ext_vector_type(4)))unsigned;
constexpr int BATCH=8,NHEAD=8,SEQ=4096,D=64,DM=NHEAD*D;
constexpr int NW=8,QBLK=32,QB=QBLK*NW,KVBLK=64,NQB=SEQ/QB;
constexpr int ATTN_PITCH=DM, ATTN_UNIT_ROWS=QB;
__device__ __forceinline__ int crow(int r,int hi){return (r&3)+8*(r>>2)+4*hi;}
#define SBAR() __builtin_amdgcn_sched_barrier(0)
__device__ __forceinline__ void cmask(f32x16&p0,f32x16&p1,int jb,int qrel,int hi){
  const float NEG=-INFINITY; int kb=64*jb+4*hi;
  #pragma unroll
  for(int r=0;r<16;++r){int kv=kb+(r&3)+8*(r>>2); if(kv>qrel)p0[r]=NEG; if(kv+32>qrel)p1[r]=NEG;}
}

constexpr int NSLOT=3, SLOTB=8192;
constexpr int LDS_K=0, LDS_V=NSLOT*SLOTB, LDS_WS=2*NSLOT*SLOTB, LDS_OST=LDS_WS+NW*64*4, LDS_BYTES=LDS_OST+NW*4096;
constexpr float C2=0.125f*1.4426950408889634f;
__device__ __forceinline__ void glds16(const void*gsrc,unsigned lds_dst){unsigned keep;
  asm volatile("s_mov_b32 %0, m0\n\ts_mov_b32 m0, %2\n\ts_nop 0\n\tglobal_load_lds_dwordx4 %1, off\n\ts_mov_b32 m0, %0":"=&s"(keep):"v"(gsrc),"s"(lds_dst):"memory");}
__device__ __forceinline__ float max3f(float a,float b,float c){float r;asm("v_max3_f32 %0, %1, %2, %3":"=v"(r):"v"(a),"v"(b),"v"(c));return r;}
__device__ __forceinline__ float max2f(float a,float b){float r;asm("v_max_f32_e32 %0, %1, %2":"=v"(r):"v"(a),"v"(b));return r;}
__device__ __forceinline__ float fadd_s(float a,float b){float r;asm("v_add_f32_e32 %0, %1, %2":"=v"(r):"v"(a),"v"(b));return r;}
__device__ __forceinline__ float fsub_s(float a,float b){float r;asm("v_sub_f32_e32 %0, %1, %2":"=v"(r):"v"(a),"v"(b));return r;}
typedef float f32x2_t __attribute__((ext_vector_type(2))); typedef float f32x4_t __attribute__((ext_vector_type(4))); typedef __bf16 bf16x2_t __attribute__((ext_vector_type(2)));
__device__ __forceinline__ unsigned cvtpk_s(float lo,float hi){f32x2_t v={lo,hi};bf16x2_t b=__builtin_convertvector(v,bf16x2_t);return __builtin_bit_cast(unsigned,b);}
#define WAIT_BAR(N) asm volatile("s_waitcnt vmcnt(" #N ") lgkmcnt(0)\n\ts_barrier":::"memory")

__device__ __forceinline__ void qkt(f32x16&p0,f32x16&p1,const char*Kslot,const bf16x8*qr,int r32,int hi){
  const char*kb=Kslot+hi*1024+r32*16;
  #pragma unroll
  for(int d0=0;d0<4;++d0){
    const bf16x8 b0=*reinterpret_cast<const bf16x8*>(kb+d0*2048);
    const bf16x8 b1=*reinterpret_cast<const bf16x8*>(kb+d0*2048+512);
    p0=__builtin_amdgcn_mfma_f32_32x32x16_bf16(b0,qr[d0],p0,0,0,0);p1=__builtin_amdgcn_mfma_f32_32x32x16_bf16(b1,qr[d0],p1,0,0,0);}
}
typedef __attribute__((address_space(3))) const char* lds_cptr;
typedef short v4i16_t __attribute__((ext_vector_type(4)));
__device__ __forceinline__ void kload8(bf16x8*kf,lds_cptr kp){
  kf[0]=*(const __attribute__((address_space(3))) bf16x8*)(kp);      kf[1]=*(const __attribute__((address_space(3))) bf16x8*)(kp+512);
  kf[2]=*(const __attribute__((address_space(3))) bf16x8*)(kp+2048); kf[3]=*(const __attribute__((address_space(3))) bf16x8*)(kp+2560);
  kf[4]=*(const __attribute__((address_space(3))) bf16x8*)(kp+4096); kf[5]=*(const __attribute__((address_space(3))) bf16x8*)(kp+4608);
  kf[6]=*(const __attribute__((address_space(3))) bf16x8*)(kp+6144); kf[7]=*(const __attribute__((address_space(3))) bf16x8*)(kp+6656);
}
__device__ __forceinline__ void kload2(bf16x8*kf,lds_cptr kp,int j){ kf[2*j]=*(const __attribute__((address_space(3))) bf16x8*)(kp+j*2048); kf[2*j+1]=*(const __attribute__((address_space(3))) bf16x8*)(kp+j*2048+512); }
__device__ __forceinline__ s16x4 vtr(lds_cptr p){ return __builtin_bit_cast(s16x4,__builtin_amdgcn_ds_read_tr16_b64_v4i16((__attribute__((address_space(3))) v4i16_t*)p)); }
__device__ __forceinline__ float rowmax(const f32x16&p0,const f32x16&p1){
  float a=max3f(p0[0],p0[1],p1[0]),b=max3f(p0[2],p0[3],p1[1]);a=max3f(a,p1[2],p1[3]);
  #pragma unroll
  for(int r=4;r<16;r+=4){a=max3f(a,p0[r],p0[r+1]);b=max3f(b,p0[r+2],p0[r+3]);a=max3f(a,p1[r],p1[r+1]);b=max3f(b,p1[r+2],p1[r+3]);}
  const float m=max2f(a,b);
  auto rr=__builtin_amdgcn_permlane32_swap(__float_as_uint(m),__float_as_uint(m),false,false);
  return max2f(__uint_as_float(rr[0]),__uint_as_float(rr[1]));
}
__device__ __forceinline__ void pv(f32x16*o,int vb,bf16x8 pa0,bf16x8 pa1,bf16x8 pa2,bf16x8 pa3){
  #pragma unroll
  for(int d0=0;d0<2;++d0){s16x4 lo[4],hi[4];
    #pragma unroll
    for(int ks=0;ks<4;++ks){
      asm volatile("ds_read_b64_tr_b16 %0,%1 offset:%c2":"=&v"(lo[ks]):"v"(vb),"i"(d0*4096+ks*1024):"memory");
      asm volatile("ds_read_b64_tr_b16 %0,%1 offset:%c2":"=&v"(hi[ks]):"v"(vb),"i"(d0*4096+ks*1024+512):"memory");}
    asm volatile("s_waitcnt lgkmcnt(0)":::"memory");SBAR();
    #define PK(k) (bf16x8){lo[k][0],lo[k][1],lo[k][2],lo[k][3],hi[k][0],hi[k][1],hi[k][2],hi[k][3]}
    o[d0]=__builtin_amdgcn_mfma_f32_32x32x16_bf16(pa0,PK(0),o[d0],0,0,0);
    o[d0]=__builtin_amdgcn_mfma_f32_32x32x16_bf16(pa1,PK(1),o[d0],0,0,0);
    o[d0]=__builtin_amdgcn_mfma_f32_32x32x16_bf16(pa2,PK(2),o[d0],0,0,0);
    o[d0]=__builtin_amdgcn_mfma_f32_32x32x16_bf16(pa3,PK(3),o[d0],0,0,0);
    #undef PK
  }
}

#ifndef ATTN_STORE16
#define ATTN_STORE16(p,v) asm volatile("global_store_dwordx4 %0, %1, off sc1\n\ts_nop 1" :: "v"(p), "v"(v) : "memory")
#endif
template<int THRL> __device__ __forceinline__ void attn_unit(int tid,int b,int h,int qb,const bf16*Q,const bf16*__restrict__ K,const bf16*__restrict__ V,bf16*O,char*shm,const __attribute__((address_space(3))) float*Fl){
  const int lane=tid&63,r32=lane&31,hi=lane>>5; const int wid=__builtin_amdgcn_readfirstlane(tid>>6);
  const long rowbase=(long)b*SEQ; const int q0=qb*QB;
  const bf16*Qw=Q+(rowbase+q0+wid*QBLK)*DM+h*D;
  const bf16*Kh=K+rowbase*DM+h*D,*Vh=V+rowbase*DM+h*D;
  const unsigned lds0=(unsigned)(uintptr_t)shm;
  float*wsf=(float*)(shm+LDS_WS)+wid*64;
  const bf16*ksrc=Kh+(long)lane*DM+wid*8;
  const bf16*vsrc=Vh+(long)(16*(wid&3)+(lane>>2))*DM+(wid>>2)*32+(lane&3)*8;
  const unsigned kdst=lds0+LDS_K+wid*1024, vdst=lds0+LDS_V+wid*1024;
  #define DMA_K(t,slot) glds16(ksrc+(long)(t)*KVBLK*DM,(unsigned)__builtin_amdgcn_readfirstlane(kdst+(slot)))
  #define DMA_V(t,slot) glds16(vsrc+(long)(t)*KVBLK*DM,(unsigned)__builtin_amdgcn_readfirstlane(vdst+(slot)))
  const int vb0=(int)(lds0+LDS_V)+((lane>>4)&1)*32+(lane&3)*8+(4*hi+((lane&15)>>2))*64;
  const char*Kbase=shm+LDS_K; bf16x8 kf[8];
  const lds_cptr shm3=(lds_cptr)shm; const lds_cptr kp0=shm3+LDS_K+hi*1024+r32*16; const lds_cptr vp0=shm3+LDS_V+((lane>>4)&1)*32+(lane&3)*8+(4*hi+((lane&15)>>2))*64;
  const int NT=(q0+QB)/KVBLK;
  DMA_K(0,0);DMA_V(0,0);DMA_K(1,SLOTB);
  bf16x8 qr[4];
  #pragma unroll
  for(int d0=0;d0<4;++d0)qr[d0]=*reinterpret_cast<const bf16x8*>(&Qw[(long)r32*DM+d0*16+hi*8]);
  const float ftq=Fl[q0+wid*QBLK+r32];
  float mhat=0.f,nm=ftq,l_reg=0.f;f32x16 o[2];o[0]=f32x16{};o[1]=f32x16{};
  #define CINIT(C0,C1,t) do{ const __attribute__((address_space(3))) float*fp_=Fl+(t)*64+4*hi; _Pragma("unroll") for(int g_=0;g_<4;++g_){ const f32x4_t a_=*(const __attribute__((address_space(3))) f32x4_t*)(fp_+8*g_),b_=*(const __attribute__((address_space(3))) f32x4_t*)(fp_+32+8*g_); _Pragma("unroll") for(int i_=0;i_<4;++i_){C0[4*g_+i_]=nm-a_[i_];C1[4*g_+i_]=nm-b_[i_];} } }while(0)
  const int qrel=wid*QBLK+r32;
  #define CMASK(P0,P1,t) do{int jb_=(t)-(NT-4); if(jb_>=0)cmask(P0,P1,jb_,qrel,hi);}while(0)
  bool resc=false;
  #define START(P0,P1) do{ const float rm=rowmax(P0,P1); resc=false; \
    { const float dl=rm; mhat=fadd_s(mhat,dl); \
      _Pragma("unroll") for(int r=0;r<16;++r){P0[r]=fsub_s(P0[r],dl);P1[r]=fsub_s(P1[r],dl);} \
      nm=ftq-mhat; } \
    _Pragma("unroll") for(int r=0;r<16;++r)P0[r]=__builtin_amdgcn_exp2f(P0[r]); }while(0)
  #define RESC() do{ if(resc){ asm volatile("s_waitcnt lgkmcnt(0)":::"memory"); \
      _Pragma("unroll") for(int d_=0;d_<2;++d_) _Pragma("unroll") for(int r=0;r<16;++r)o[d_][r]*=wsf[crow(r,hi)]; } }while(0)
  f32x16 pA0,pA1,pB0,pB1;
  int sl_prev=0,sl_cur=0,sl_next=SLOTB;
  #define ROT() do{sl_prev=sl_cur;sl_cur=sl_next;sl_next=(sl_next==(NSLOT-1)*SLOTB)?0:sl_next+SLOTB;}while(0)
  DMA_K(2,2*SLOTB);
  WAIT_BAR(3);
  CINIT(pA0,pA1,0); qkt(pA0,pA1,Kbase,qr,r32,hi);asm volatile("s_nop 15\n\ts_nop 7":"+v"(pA0),"+v"(pA1));CMASK(pA0,pA1,0);
  START(pA0,pA1);
  _Pragma("unroll") for(int r=0;r<16;++r)pA1[r]=__builtin_amdgcn_exp2f(pA1[r]);
  WAIT_BAR(0);
  DMA_K(3,0);DMA_V(1,SLOTB);
  ROT();
  kload8(kf,kp0+sl_cur);
  WAIT_BAR(2);
  s16x4 vlo[8],vhi[8]; u32x4 pw0,pw1,pw2,pw3;
  #define PKW(P,B) cvtpk_s(P[B],P[B+1])
  #define PAF(k) __builtin_bit_cast(bf16x8,pw##k)
  #define VFR(i) (bf16x8){vlo[i][0],vlo[i][1],vlo[i][2],vlo[i][3],vhi[i][0],vhi[i][1],vhi[i][2],vhi[i][3]}
  #define PIN(x) asm volatile("":"+v"(x))
  #define MX3(a,b,c) __builtin_fmaxf(__builtin_fmaxf((a),(b)),(c))
  #define GAPA(MF,A0,A1,A2,A3,W0,W1,PW) do{ MF; sacc+=A0; sacc+=A1; sacc+=A2; sacc+=A3; PIN(sacc); W0; W1; PIN(PW); SBAR(); }while(0)
  #define EX(v) __builtin_amdgcn_exp2f(v)
  #define GAPB(MF,X,B) do{ MF; X[B]=EX(X[B]); X[B+1]=EX(X[B+1]); X[B+2]=EX(X[B+2]); X[B+3]=EX(X[B+3]); PIN(X); SBAR(); }while(0)
  #define VRD(i) do{ vlo[i]=vtr(vp_+(((i)>>2)*4096+((i)&3)*1024)); vhi[i]=vtr(vp_+(((i)>>2)*4096+((i)&3)*1024+512)); }while(0)
  #define KRD(G,j) do{ if(G){ kload2(kf,kp0+sl_next,j); SBAR(); } }while(0)
  #define STEP(C0,C1,P0,P1,t,GK,GV,GL) do{ SBAR(); \
    const lds_cptr vp_=vp0+sl_prev; \
    CINIT(C0,C1,t); SBAR(); \
    VRD(0); SBAR(); float sacc=(P0[0]+P0[1]); \
    GAPA(C0=__builtin_amdgcn_mfma_f32_32x32x16_bf16(kf[0],qr[0],C0,0,0,0), P0[2],P0[3],P0[4],P0[5],     pw0[0]=PKW(P0,0), pw0[1]=PKW(P0,2), pw0); \
    VRD(4); SBAR(); GAPA(C1=__builtin_amdgcn_mfma_f32_32x32x16_bf16(kf[1],qr[0],C1,0,0,0), P0[6],P0[7],P0[8],P0[9],     pw0[2]=PKW(P0,4), pw0[3]=PKW(P0,6), pw0); \
    VRD(1); SBAR(); GAPA(C0=__builtin_amdgcn_mfma_f32_32x32x16_bf16(kf[2],qr[1],C0,0,0,0),   P0[10],P0[11],P0[12],P0[13], pw1[0]=PKW(P0,8), pw1[1]=PKW(P0,10), pw1); \
    VRD(5); SBAR(); GAPA(C1=__builtin_amdgcn_mfma_f32_32x32x16_bf16(kf[3],qr[1],C1,0,0,0),   P0[14],P0[15],P1[0],P1[1],   pw1[2]=PKW(P0,12),pw1[3]=PKW(P0,14), pw1); \
    VRD(2); SBAR(); GAPA(C0=__builtin_amdgcn_mfma_f32_32x32x16_bf16(kf[4],qr[2],C0,0,0,0),   P1[2],P1[3],P1[4],P1[5],     pw2[0]=PKW(P1,0), pw2[1]=PKW(P1,2), pw2); \
    VRD(6); SBAR(); GAPA(C1=__builtin_amdgcn_mfma_f32_32x32x16_bf16(kf[5],qr[2],C1,0,0,0),   P1[6],P1[7],P1[8],P1[9],     pw2[2]=PKW(P1,4), pw2[3]=PKW(P1,6), pw2); \
    VRD(3); SBAR(); GAPA(C0=__builtin_amdgcn_mfma_f32_32x32x16_bf16(kf[6],qr[3],C0,0,0,0),   P1[10],P1[11],P1[12],P1[13], pw3[0]=PKW(P1,8), pw3[1]=PKW(P1,10), pw3); \
    VRD(7); SBAR(); GAPA(C1=__builtin_amdgcn_mfma_f32_32x32x16_bf16(kf[7],qr[3],C1,0,0,0),   P1[14],P1[15],0.f,0.f,       pw3[2]=PKW(P1,12),pw3[3]=PKW(P1,14), pw3); \
    l_reg+=sacc; \
    if(GK){DMA_K((t)+3,sl_cur);} if(GV){DMA_V((t)+1,sl_next);} \
    CMASK(C0,C1,t); \
    { float a=MX3(C0[0],C0[1],C1[0]),b=MX3(C0[2],C0[3],C1[1]); a=MX3(a,C1[2],C1[3]); \
      _Pragma("unroll") for(int r=4;r<16;r+=4){a=MX3(a,C0[r],C0[r+1]);b=MX3(b,C0[r+2],C0[r+3]);a=MX3(a,C1[r],C1[r+1]);b=MX3(b,C1[r+2],C1[r+3]);} \
      float rm=__builtin_fmaxf(a,b); { auto rr=__builtin_amdgcn_permlane32_swap(__float_as_uint(rm),__float_as_uint(rm),false,false); rm=__builtin_fmaxf(__uint_as_float(rr[0]),__uint_as_float(rr[1])); } \
      resc=false; \
      if(__builtin_expect(__any(rm>(float)THRL),0)){ const float dl=__builtin_fmaxf(rm,0.f); mhat+=dl; \
        _Pragma("unroll") for(int r=0;r<16;++r){C0[r]-=dl;C1[r]-=dl;} \
        nm=ftq-mhat; \
        const float f=__builtin_amdgcn_exp2f(-dl); l_reg*=f; if(hi==0)wsf[r32]=f; resc=true; } } \
    SBAR(); \
    GAPB(o[0]=__builtin_amdgcn_mfma_f32_32x32x16_bf16(PAF(0),VFR(0),o[0],0,0,0), C0,0); \
    GAPB(o[1]=__builtin_amdgcn_mfma_f32_32x32x16_bf16(PAF(0),VFR(4),o[1],0,0,0), C0,4); \
    KRD(GL,0); GAPB(o[0]=__builtin_amdgcn_mfma_f32_32x32x16_bf16(PAF(1),VFR(1),o[0],0,0,0), C0,8); \
    KRD(GL,1); GAPB(o[1]=__builtin_amdgcn_mfma_f32_32x32x16_bf16(PAF(1),VFR(5),o[1],0,0,0), C0,12); \
    KRD(GL,2); GAPB(o[0]=__builtin_amdgcn_mfma_f32_32x32x16_bf16(PAF(2),VFR(2),o[0],0,0,0), C1,0); \
    KRD(GL,3); GAPB(o[1]=__builtin_amdgcn_mfma_f32_32x32x16_bf16(PAF(2),VFR(6),o[1],0,0,0), C1,4); \
    GAPB(o[0]=__builtin_amdgcn_mfma_f32_32x32x16_bf16(PAF(3),VFR(3),o[0],0,0,0), C1,8); \
    GAPB(o[1]=__builtin_amdgcn_mfma_f32_32x32x16_bf16(PAF(3),VFR(7),o[1],0,0,0), C1,12); \
    }while(0)
  int t=1;
  #undef CMASK
  #define CMASK(P0,P1,t) do{}while(0)
  for(;t+5<NT;t+=2){
    STEP(pB0,pB1,pA0,pA1,t,true,true,true);     WAIT_BAR(2); RESC(); ROT();
    STEP(pA0,pA1,pB0,pB1,t+1,true,true,true);   WAIT_BAR(2); RESC(); ROT();
  }
  #undef CMASK
  #define CMASK(P0,P1,t) do{int jb_=(t)-(NT-4); if(jb_>=0)cmask(P0,P1,jb_,qrel,hi);}while(0)
  #define ENDW(tt) do{ if((tt)+3<NT){WAIT_BAR(2);} else if((tt)+2<NT){WAIT_BAR(1);} else {WAIT_BAR(0);} }while(0)
  for(;t+1<NT;t+=2){
    STEP(pB0,pB1,pA0,pA1,t,(t+3<NT),(t+1<NT),(t+1<NT));       ENDW(t);   RESC(); ROT();
    STEP(pA0,pA1,pB0,pB1,t+1,(t+4<NT),(t+2<NT),(t+2<NT));     ENDW(t+1); RESC(); ROT();
  }
  STEP(pB0,pB1,pA0,pA1,NT-1,false,false,false); RESC();
  { float sacc=pB0[0]+pB0[1]; _Pragma("unroll") for(int r=2;r<16;++r)sacc+=pB0[r]; _Pragma("unroll") for(int r=0;r<16;++r)sacc+=pB1[r]; l_reg+=sacc;
    pw0=(u32x4){PKW(pB0,0),PKW(pB0,2),PKW(pB0,4),PKW(pB0,6)};pw1=(u32x4){PKW(pB0,8),PKW(pB0,10),PKW(pB0,12),PKW(pB0,14)};pw2=(u32x4){PKW(pB1,0),PKW(pB1,2),PKW(pB1,4),PKW(pB1,6)};pw3=(u32x4){PKW(pB1,8),PKW(pB1,10),PKW(pB1,12),PKW(pB1,14)};
    SBAR(); pv(o,vb0+sl_cur,PAF(0),PAF(1),PAF(2),PAF(3)); }
  #undef PKW
  #undef PAF
  #undef VFR
  #undef PIN
  #undef MX3
  #undef GAPA
  #undef GAPB
  #undef EX
  #undef VRD
  #undef KRD
  #undef STEP
  #undef ENDW
  {auto rr=__builtin_amdgcn_permlane32_swap(__float_as_uint(l_reg),__float_as_uint(l_reg),false,false);l_reg=__uint_as_float(rr[0])+__uint_as_float(rr[1]);}
  if(hi==0)wsf[32+r32]=l_reg;asm volatile("s_waitcnt lgkmcnt(0)":::"memory");
  float rli[16];
  #pragma unroll
  for(int r=0;r<16;++r)rli[r]=__builtin_amdgcn_rcpf(wsf[32+crow(r,hi)]);
  bf16*Ow=O+(rowbase+q0+wid*QBLK)*DM+h*D;
  { bf16*stg=(bf16*)(shm+LDS_OST)+wid*2048;
    #pragma unroll
    for(int r=0;r<16;++r){const int orow=crow(r,hi);
      #pragma unroll
      for(int d0=0;d0<2;++d0)stg[orow*64+d0*32+r32]=__float2bfloat16(o[d0][r]*rli[r]);}
    asm volatile("s_waitcnt lgkmcnt(0)":::"memory");
    #pragma unroll
    for(int i=0;i<4;++i){const int row=i*8+(lane>>3),ch=lane&7; const u32x4 v=*(const u32x4*)(stg+row*64+ch*8); ATTN_STORE16(Ow+(long)row*DM+ch*8,v);} }
  asm volatile("s_waitcnt lgkmcnt(0)\n\ts_barrier":::"memory");
  #undef DMA_K
  #undef DMA_V
  #undef CMASK
  #undef CINIT
  #undef START
  #undef RESC
  #undef ROT
}
constexpr int ATTN_LDS_BYTES=LDS_BYTES;
#undef SBAR
#undef WAIT_BAR
}

constexpr int ATT_FL_OFF = 86016;
__device__ __forceinline__ void attn_phase(const Frame& F) {
    static_assert(attn_body::ATTN_LDS_BYTES <= ATT_FL_OFF && ATT_FL_OFF + 16384 <= RING_BYTES, "attention LDS map");
    const attn_body::bf16* Q = (const attn_body::bf16*)seg(F, S_Q); const attn_body::bf16* K = (const attn_body::bf16*)seg(F, S_K); const attn_body::bf16* V = (const attn_body::bf16*)seg(F, S_V);
    const float* Fc = (const float*)(F.ws + WS_FC);
    LAS float* Fl = (LAS float*)(F.lds + ATT_FL_OFF);
    const int v0 = (F.G % 8 == 0) ? (F.bid % 8) * (F.G / 8) + F.bid / 8 : F.bid;
#pragma nounroll
    for (int v = v0; v < 256; v += F.G) {
        const int bh = v >> 2, s = v & 3, b = bh >> 3, h = bh & 7;
        __syncthreads();
        for (int i = F.tid; i < 1024; i += NTHR) { const f32x4 x = *(const f32x4*)(Fc + (size_t)bh * SEQ + 4 * i); *(LAS f32x4*)(Fl + 4 * i) = x * LOG2E; }
        asm volatile("s_waitcnt vmcnt(0) lgkmcnt(0)" ::: "memory");
        __syncthreads();
#pragma nounroll
        for (int i = 0; i < 4; ++i) { const int qb = (i >> 1) * 8 + ((i & 1) ? 7 - s : s);
            int t2 = F.tid; asm volatile("" : "+v"(t2));
            attn_body::attn_unit<8>(t2, b, h, qb, Q, K, V, (attn_body::bf16*)Q, (char*)F.lds, Fl); }
    }
}
constexpr int PPL = 13, NPH = 1 + PPL * DEPTH;
__device__ __forceinline__ void make_frame(Frame& F, const Args& args, unsigned char* lds) {
    GAS unsigned char* w_ = (GAS unsigned char*)args.ws; GAS float* o_ = (GAS float*)args.out; int b_ = blockIdx.x, g_ = gridDim.x;
    asm volatile("" : "+s"(w_), "+s"(o_), "+s"(b_), "+s"(g_));
    F.lds = (LAS unsigned char*)lds; F.MISC = (volatile LAS unsigned*)(F.lds + MISC_OFF);
    unsigned z_ = 0u; asm volatile("" : "+v"(z_)); int ln_ = __builtin_amdgcn_mbcnt_hi(~0u, __builtin_amdgcn_mbcnt_lo(~0u, z_));
    unsigned tk_ = ((volatile LAS unsigned*)(F.lds + TICKET_OFF))[(unsigned)__builtin_amdgcn_s_getreg(63492) & 63u];
    tk_ = __builtin_amdgcn_readfirstlane(tk_) & 7u; asm volatile("" : "+v"(ln_));
    F.lane = ln_; F.wave = (int)tk_; F.tid = (int)tk_ * 64 + ln_; F.G = g_; F.bid = b_; F.cpass = 0;
    F.ws = (unsigned char*)w_; F.ctl = (gu32*)(F.ws + WS_CTL); F.XF = (float*)o_; F.XB = (bf16*)(F.ws + WS_XB); F.H = (bf16*)(F.ws + WS_H);
}
struct FillSpec { int l, kind, k; };
__host__ __device__ constexpr FillSpec fill_spec(int PH) {
    if (PH == 0) return {0, 0, 0};
    const int l = (PH - 1) / 13, p = (PH - 1) % 13;
    if (l == 0) { switch (p) { case 0: return {0, 0, 1}; case 3: return {0, 0, 2}; case 4: return {0, 0, 3}; case 5: return {0, 0, 4}; case 6: return {0, 0, 5};
                               case 7: return {0, 1, 0}; case 9: return {0, 1, 1}; case 11: return {1, 0, 0}; case 12: return {1, 0, 1}; default: return {0, -1, 0}; } }
    switch (p) { case 0: return {1, 0, 2}; case 3: return {1, 0, 3}; case 4: return {1, 0, 4}; case 5: return {1, 0, 5}; case 6: return {1, 0, 6};
                 case 7: return {1, 1, 0}; case 9: return {1, 1, 1}; default: return {1, -1, 0}; }
}
constexpr int FILLW = 4;
__host__ __device__ constexpr int fill_done(int l, int kind) { return FILLW * (kind == 0 ? (l == 0 ? 6 : 7) : 2); }
struct NoFill { __device__ __forceinline__ void operator()() const {} };
struct ExpertFill {
    const Frame& B; int l, kind, k; bool on;
    __device__ __forceinline__ void operator()() const {
        if (!on || B.wave == 0 || B.wave > FILLW) return;
        const int i = FILLW * k + (B.wave - 1);
        expert_item(B, l, kind, B.bid + 256 * i, (LAS float*)(B.lds + B.wave * 16384));
    }
};
template <int PH, int MASK>
__device__ __forceinline__ void run_phase(const Args& args, unsigned char* lds, int lo, int hi, int pass, int npass, unsigned xcc) {
    if (!(PH >= lo && PH < hi)) return;
    constexpr int l = PH == 0 ? 0 : (PH - 1) / PPL, p = PH == 0 ? 13 : (PH - 1) % PPL;
    Frame F; make_frame(F, args, lds); F.cpass = pass * 128;
    const bool fill_on = (lo == 0 && hi == NPH && F.G == 256);
    LAS int* pst = (LAS int*)(F.lds + XTRA_OFF); LAS int* cntl = (LAS int*)(F.lds + XTRA_OFF + 256); LAS int* tile_e = (LAS int*)(F.lds + XTRA_OFF + 512); (void)pst; (void)cntl; (void)tile_e;
    constexpr int probe_ = SKIP_PH >= 0 ? SKIP_PH : SOLO_PH;
    const bool skip_ = (pass + 1 < npass) && ((SKIP_PH >= 0) ? (p == probe_) : (p != probe_));
    if (!skip_) {
        if constexpr (((MASK >> p) & 1) != 0) {
            if constexpr (p == 13) {
                convert_small(F, args, 0);
                __syncthreads();
                ln_rows<0>(F, args, inptr(F, 1), inptr(F, 2), 0);
            } else if constexpr (p == 0) {
                fox_scan(F);
                SchedInProj S{(const char*)(F.ws + WS_XB8), (const char*)(F.ws + WS_WIN), F.G, F.bid};
                EpiInProj E{F.H, (const float*)(F.ws + WS_BIAS), (const float*)(F.ws + WS_SA), (const unsigned*)(F.ctl + CW_CMAX) + l * (NH / 32)};
                pg8::gemm_phase(F.lds, F.tid, S, E);
            } else if constexpr (p == 1) { attn_phase(F);
            } else if constexpr (p == 2) { sgu_mfma(F, l);
            } else if constexpr (p == 3) { mlstm_m1_mfma(F, l);
            } else if constexpr (p == 4) { mlstm_m2(F);
            } else if constexpr (p == 5) { mlstm_m3_mfma(F, l);
            } else if constexpr (p == 6) {
                SchedMerge S{(const char*)F.H, (const char*)(F.ws + WS_WBR), F.G, F.bid};
                EpiMerge E{F.H, (bf16*)(F.ws + WS_MERGED)};
                pg8::gemm_phase(F.lds, F.tid, S, E);
            } else if constexpr (p == 7) {
                SchedPlain<1024, T / 256, 4, 8, 4> S{(const char*)(F.ws + WS_MERGED), (const char*)(F.ws + WS_WOUT), F.G, F.bid};
                EpiWout E{F.XB};
                pg8::gemm_phase(F.lds, F.tid, S, E);
            } else if constexpr (p == 8) {
                ln1_route(F, args, l);
            } else if constexpr (p == 9) { convert_experts(F, l, fill_on ? fill_done(l, 0) : 0, fill_on ? fill_done(l, 1) : 0);
            } else if constexpr (p == 10) {
                moe_tiles(F, l, pst, cntl, tile_e);
                SchedMoe1 S{(const char*)(F.ws + WS_XB8), (const char*)wgu_ptr(F), (const int*)(F.ws + WS_ENT2), __builtin_amdgcn_readfirstlane(pst[NEXP]), tile_e, pst, cntl, F.G, F.bid};
                EpiMoe1 E{(unsigned char*)(F.ws + WS_HID)};
                pg8::gemm_phase(F.lds, F.tid, S, E);
            } else if constexpr (p == 11) {
                moe_tiles(F, l, pst, cntl, tile_e);
                SchedMoe2 S{(const char*)(F.ws + WS_HID), (const char*)(F.ws + WS_WD), __builtin_amdgcn_readfirstlane(pst[NEXP]), tile_e, pst, cntl, F.G, F.bid};
                EpiMoe2 E{(unsigned char*)(F.ws + WS_YBUF), (const int*)(F.ws + WS_ENT2)};
                pg8::gemm_phase(F.lds, F.tid, S, E);
            } else {
                constexpr bool more = (l + 1 < DEPTH);
                ln_rows<2>(F, args, inptr(F, 21) + (size_t)l * D, inptr(F, 22) + (size_t)l * D, more ? l + 1 : -1);
                if constexpr (more) convert_small(F, args, l + 1);
            }
        }
    }
    constexpr bool nobar = (p == 1 || p == 2 || p == 8);
    if ((PH + 1 < hi || pass + 1 < npass) && !nobar) {
        Frame B; make_frame(B, args, lds);
        XcdBarrier bar; bar.bar = (unsigned*)(B.ctl + CW_BAR); bar.x = xcc; bar.st = B.MISC + 8;
        constexpr FillSpec fs = fill_spec(PH);
        if constexpr (fs.kind >= 0) xcd_barrier(bar, B.tid == 0, ExpertFill{B, fs.l, fs.kind, fs.k, fill_on});
        else xcd_barrier(bar, B.tid == 0, NoFill{});
    }
}
template <int MASK, int... PHS>
__device__ __forceinline__ void run_all(const Args& args, unsigned char* lds, int lo, int hi, int pass, int npass, unsigned xcc, std::integer_sequence<int, PHS...>) {
    (run_phase<PHS, MASK>(args, lds, lo, hi, pass, npass, xcc), ...);
}
template <int MASK> __global__ void __launch_bounds__(NTHR, 2) fwd_kernel(Args args) {
    extern __shared__ __attribute__((aligned(16))) unsigned char lds[];
    { LAS unsigned char* l3 = (LAS unsigned char*)lds; const int tid0 = threadIdx.x;
      for (int u = tid0; u < (LDS_BYTES - LDSCTL_OFF) / 4; u += NTHR) ((LAS unsigned*)(l3 + LDSCTL_OFF))[u] = 0u;
      __syncthreads();
      if (tid0 < 23) ((LAS unsigned long long*)(l3 + INTBL_OFF))[tid0] = (unsigned long long)args.in[tid0];
      if ((tid0 & 63) == 0) ((LAS unsigned*)(l3 + TICKET_OFF))[(unsigned)__builtin_amdgcn_s_getreg(63492) & 63u] = (unsigned)(tid0 >> 6);
      __syncthreads(); }
    const int lo = args.ph_lo, hi = args.ph_hi;
    unsigned xcc = 0;
    if (hi - lo > 1) { const XcdBarrier b0 = xcd_barrier_post((unsigned*)((gu32*)(args.ws + WS_CTL) + CW_BAR), (volatile LAS unsigned*)((LAS unsigned char*)lds + MISC_OFF) + 8); xcc = b0.x; }
    constexpr int NPASS = (SKIP_PH >= 0 || SOLO_PH >= 0) ? 2 : 1;
    if constexpr (NPASS == 2) run_all<MASK>(args, lds, lo, hi, 0, NPASS, xcc, std::make_integer_sequence<int, NPH>{});
    run_all<MASK>(args, lds, lo, hi, NPASS - 1, NPASS, xcc, std::make_integer_sequence<int, NPH>{});
}

#ifdef ONLY_MASK
template __global__ void fwd_kernel<ONLY_MASK>(Args);
#else
#if PROBE_PH >= 0
__global__ void probe_fill_kernel(float* out, const unsigned long long* ts) {
    unsigned long long dt = 0;
    if (PROBE_PH == 13) dt = ts[1] - ts[0]; else if (PROBE_PH == 14) dt = ts[NPH] - ts[0]; else { for (int l = 0; l < DEPTH; ++l) dt += ts[2 + l * PPL + PROBE_PH] - ts[1 + l * PPL + PROBE_PH]; }
    const float c = sqrtf((float)dt * 0.001f);
    for (size_t i = (size_t)blockIdx.x * blockDim.x + threadIdx.x; i < (size_t)T * D; i += (size_t)gridDim.x * blockDim.x) out[i] = c;
}
#endif
__global__ void fill_kernel(float* out, int n, float c) { for (int i = blockIdx.x * blockDim.x + threadIdx.x; i < n; i += gridDim.x * blockDim.x) out[i] = c; }

#ifndef N_LAUNCH_MODE
#define N_LAUNCH_MODE 1
#endif
extern "C" void kernel_launch(void* const* d_in, const int* in_sizes, int n_in, void* d_out, int out_size, void* d_ws, size_t ws_size, hipStream_t stream) {
    static int grid = 0;
    if (grid == 0) {
        int dev = 0, cus = 0;
        if (hipGetDevice(&dev) != hipSuccess || hipDeviceGetAttribute(&cus, hipDeviceAttributeMultiprocessorCount, dev) != hipSuccess) { grid = -1; return; }
        if (hipFuncSetAttribute((const void*)fwd_kernel<0x3fff>, hipFuncAttributeMaxDynamicSharedMemorySize, LDS_BYTES) != hipSuccess) { grid = -1; return; }
        int per_cu = 0;
        if (hipOccupancyMaxActiveBlocksPerMultiprocessor(&per_cu, (const void*)fwd_kernel<0x3fff>, NTHR, LDS_BYTES) != hipSuccess || per_cu < 1) { (void)hipGetLastError(); grid = -2; }
        else { (void)hipGetLastError(); grid = cus; }
#if N_LAUNCH_MODE != 1
#define SCASE(Q) (void)hipFuncSetAttribute((const void*)fwd_kernel<(1 << Q)>, hipFuncAttributeMaxDynamicSharedMemorySize, LDS_BYTES);
        SCASE(0) SCASE(1) SCASE(2) SCASE(3) SCASE(4) SCASE(5) SCASE(6) SCASE(7) SCASE(8) SCASE(9) SCASE(10) SCASE(11) SCASE(12) SCASE(13)
#undef SCASE
#endif
    }
    if (grid == -2) { hipLaunchKernelGGL(fill_kernel, dim3(1024), dim3(256), 0, stream, (float*)d_out, out_size, 7.0f); return; }
    if (grid < 0) return;
    if (n_in != 23 || out_size != T * D || ws_size < WS_END) {
        hipLaunchKernelGGL(fill_kernel, dim3(1024), dim3(256), 0, stream, (float*)d_out, out_size, (n_in != 23 || out_size != T * D) ? 5.0f : 3.0f);
        return;
    }
    (void)hipMemsetAsync((char*)d_ws + WS_CTL, 0, CTL_ZERO_BYTES, stream);
    Args a{};
    for (int i = 0; i < 23; ++i) a.in[i] = (const float*)d_in[i];
    a.out = (float*)d_out; a.ws = (unsigned char*)d_ws;
#if N_LAUNCH_MODE == 1
    a.ph_lo = 0; a.ph_hi = NPH;
    hipLaunchKernelGGL(fwd_kernel<0x3fff>, dim3(grid), dim3(NTHR), LDS_BYTES, stream, a);
#if PROBE_PH >= 0
    hipLaunchKernelGGL(probe_fill_kernel, dim3(2048), dim3(256), 0, stream, (float*)d_out, (const unsigned long long*)((char*)d_ws + WS_SM + 6 * MiB));
#endif
#else
    for (int p = 0; p < NPH; ++p) { a.ph_lo = p; a.ph_hi = p + 1; const int q = p == 0 ? 13 : (p - 1) % PPL;
        switch (q) {
#define LCASE(Q) case Q: hipLaunchKernelGGL(fwd_kernel<(1 << Q)>, dim3(grid), dim3(NTHR), LDS_BYTES, stream, a); break;
            LCASE(0) LCASE(1) LCASE(2) LCASE(3) LCASE(4) LCASE(5) LCASE(6) LCASE(7) LCASE(8) LCASE(9) LCASE(10) LCASE(11) LCASE(12) LCASE(13)
#undef LCASE
        } }
#endif
}
#endif
```

```cpp
#include <hip/hip_runtime.h>
#ifndef PROBE_PH
#define PROBE_PH -1
#endif
#ifndef SOLO_PH
#define SOLO_PH -1
#endif
#ifndef SKIP_PH
#define SKIP_PH -1
#endif
#include <cstdio>
#include <cstdint>
#include <utility>

namespace pg8 {
#define PG8_LAS __attribute__((address_space(3)))
typedef unsigned short bf16_t;
typedef short bf16x8 __attribute__((ext_vector_type(8)));
typedef float f32x4 __attribute__((ext_vector_type(4)));
typedef float f32x2 __attribute__((ext_vector_type(2)));
typedef unsigned u32x4 __attribute__((ext_vector_type(4)));
typedef int i32x4 __attribute__((ext_vector_type(4)));
typedef int i32x8 __attribute__((ext_vector_type(8)));
constexpr int BM = 256, BK = 64, HALF = 128, HTB = HALF * BK * 2  , STAGE_BYTES = 8 * HTB;

__host__ __device__ __forceinline__ int lds_byte(int r, int c) { const int st = (r >> 4) * 2 + (c >> 5), rr = r & 15, cc = c & 31, ob = rr * 64 + cc * 2; return st * 1024 + (ob ^ (((ob >> 9) & 1) << 5)); }
__host__ __device__ __forceinline__ void stage_rc(int b, int& R, int& C) { const int st = b / 1024, sb = b % 1024, swz = sb ^ (((sb >> 9) & 1) << 5); R = (st >> 1) * 16 + swz / 64; C = (st & 1) * 32 + (swz % 64) / 2; }
__host__ __device__ __forceinline__ int perm32(int rho) { const int n = rho >> 4, i = rho & 15; return 8 * (i >> 2) + 4 * n + (i & 3); }

struct Unit { int pm, pn, ex, nv, gt; };

__device__ __forceinline__ unsigned cvt_pk_bf16(float lo, float hi) { unsigned r; asm volatile("v_cvt_pk_bf16_f32 %0, %1, %2" : "=v"(r) : "v"(lo), "v"(hi)); return r; }

template <class Epi, class Sched>
__device__ __forceinline__ void gemm_phase(PG8_LAS unsigned char* lds, int tid_, const Sched& S, const Epi& E) {
    asm volatile("" : "+v"(tid_));
    const int tid = tid_, wid = __builtin_amdgcn_readfirstlane(tid >> 6), lane = tid & 63, wr = wid >> 2, wc = wid & 3, fr = lane & 15, fq = lane >> 4;
    const int nt = S.ktiles();
    const int lda = S.lda(), ldb = S.ldb();
    unsigned voffA[2][2], voffAn[2][2], voffB[2]; int Rl[2], Cl[2];
#pragma unroll
    for (int i = 0; i < 2; ++i) { stage_rc(tid * 16 + i * 8192, Rl[i], Cl[i]); const int Rb = Epi::PERM ? ((Rl[i] & ~31) + perm32(Rl[i] & 31)) : Rl[i];
        voffB[i] = (unsigned)(Rb * ldb + Cl[i]) * 2u; }
#define PG8_SETA(vo, u) do { int t_ = tid; asm volatile("" : "+v"(t_)); _Pragma("unroll") for (int i_ = 0; i_ < 2; ++i_) { int R_, C_; stage_rc(t_ * 16 + i_ * 8192, R_, C_);     \
        _Pragma("unroll") for (int h_ = 0; h_ < 2; ++h_) { \
        if constexpr (Sched::GATHER) vo[h_][i_] = S.rowoff(u, h_ * HALF + R_) + (unsigned)C_ * 2u; else vo[h_][i_] = (unsigned)((h_ * HALF + R_) * lda + C_) * 2u; } } } while (0)
    const size_t kstep = (size_t)(BK * 2);
    const size_t hstepB = (size_t)HALF * ldb * 2;
    const unsigned ldsw = (unsigned)wid * 1024u;
    constexpr bool F8 = Epi::F8, I8 = Epi::I8; constexpr int KOFF = F8 ? 16 : 1024;
    const int aoff = lds_byte(wr * 64 + fr, F8 ? fq * 16 : fq * 8), boff = lds_byte(wc * 32 + fr, F8 ? fq * 16 : fq * 8);
#define PG8_SA(b, h) (((b) * 2 + (h)) * HTB)
#define PG8_SB(b, h) ((4 + (b) * 2 + (h)) * HTB)
#define PG8_STAGE(bufoff, gbase, voff) do { const char* gb_ = (const char*)(gbase); asm volatile("" : "+s"(gb_)); _Pragma("unroll") for (int _i = 0; _i < 2; ++_i) { \
        unsigned vo_ = (voff)[_i]; asm volatile("" : "+v"(vo_));     \
        __builtin_amdgcn_global_load_lds((const unsigned*)(gb_ + vo_), (PG8_LAS unsigned*)(lds + (bufoff) + ldsw + _i * 8192), 16, 0, 0); } } while (0)
#define PG8_LDA(dst, b, h) do { _Pragma("unroll") for (int m = 0; m < 4; ++m) _Pragma("unroll") for (int k = 0; k < 2; ++k) dst[m][k] = *(const PG8_LAS bf16x8*)(lds + PG8_SA(b, h) + aoff + m * 2048 + k * KOFF); } while (0)
#define PG8_LDB(dst, b, h) do { _Pragma("unroll") for (int n = 0; n < 2; ++n) _Pragma("unroll") for (int k = 0; k < 2; ++k) dst[n][k] = *(const PG8_LAS bf16x8*)(lds + PG8_SB(b, h) + boff + n * 2048 + k * KOFF); } while (0)
#define PG8_CAT(X) __builtin_shufflevector(__builtin_bit_cast(i32x4, X[0]), __builtin_bit_cast(i32x4, X[1]), 0, 1, 2, 3, 4, 5, 6, 7)
#define PG8_MMA(ai, bj, At, Bt) do { __builtin_amdgcn_s_setprio(1); _Pragma("unroll") for (int m = 0; m < 4; ++m) _Pragma("unroll") for (int n = 0; n < 2; ++n) { \
        if constexpr (F8) acc[ai][bj][m][n] = __builtin_amdgcn_mfma_scale_f32_16x16x128_f8f6f4(PG8_CAT(Bt[n]), PG8_CAT(At[m]), acc[ai][bj][m][n], 0, 0, 0, 0x7f7f7f7f, 0, 0x7f7f7f7f); \
        else if constexpr (I8) { _Pragma("unroll") for (int k = 0; k < 2; ++k) acc[ai][bj][m][n] = __builtin_bit_cast(f32x4, __builtin_amdgcn_mfma_i32_16x16x64_i8(__builtin_bit_cast(i32x4, Bt[n][k]), __builtin_bit_cast(i32x4, At[m][k]), __builtin_bit_cast(i32x4, acc[ai][bj][m][n]), 0, 0, 0)); } \
        else { _Pragma("unroll") for (int k = 0; k < 2; ++k) acc[ai][bj][m][n] = __builtin_amdgcn_mfma_f32_16x16x32_bf16(Bt[n][k], At[m][k], acc[ai][bj][m][n], 0, 0, 0); } } __builtin_amdgcn_s_setprio(0); } while (0)
#define PG8_WAIT_V(n) asm volatile("s_waitcnt vmcnt(" #n ")" ::: "memory")
#define PG8_WAIT_L(n) asm volatile("s_waitcnt lgkmcnt(" #n ")" ::: "memory")
#define PG8_BAR __builtin_amdgcn_s_barrier()
#define PG8_SCHED __builtin_amdgcn_sched_barrier(0)
    Unit cur, nxt; int ui = 0;
    if (!S.next(0, cur)) return;
    PG8_SETA(voffA, cur);
    f32x4 acc[2][2][4][2];
#pragma unroll
    for (int a = 0; a < 2; ++a)
#pragma unroll
        for (int b = 0; b < 2; ++b)
#pragma unroll
            for (int m = 0; m < 4; ++m)
#pragma unroll
                for (int n = 0; n < 2; ++n) acc[a][b][m][n] = (f32x4){0.f, 0.f, 0.f, 0.f};
    bf16x8 At[4][2], B0[2][2], B1[2][2];
    {
        const char* cA = S.aptr(cur, 0); const char* cB = S.bptr(cur, 0); const char* cA1 = S.aptr(cur, 1); const char* cB1 = S.bptr(cur, 1);
        PG8_STAGE(PG8_SB(0, 0), cB, voffB); PG8_STAGE(PG8_SB(0, 1), cB + hstepB, voffB); PG8_STAGE(PG8_SA(0, 0), cA, voffA[0]); PG8_STAGE(PG8_SA(0, 1), cA, voffA[1]);
        if (wr == 1) PG8_BAR;
        PG8_WAIT_V(2); PG8_BAR;
        PG8_STAGE(PG8_SB(1, 0), cB1, voffB); PG8_STAGE(PG8_SA(1, 0), cA1, voffA[0]); PG8_STAGE(PG8_SB(1, 1), cB1 + hstepB, voffB);
        PG8_WAIT_V(6); PG8_BAR;
    }
    for (;;) {
        const bool has_next = S.next(ui + 1, nxt);
        const Unit& nu = has_next ? nxt : cur;
        if constexpr (Sched::GATHER) { if (has_next) PG8_SETA(voffAn, nxt); else { _Pragma("unroll") for (int h_ = 0; h_ < 2; ++h_) _Pragma("unroll") for (int i_ = 0; i_ < 2; ++i_) voffAn[h_][i_] = voffA[h_][i_]; } }
        const int seglen = Epi::HAS_MID ? Epi::SEG : nt;
        _Pragma("nounroll") for (int tb = 0; tb < nt; tb += seglen) {
        if constexpr (Epi::HAS_MID) { if (tb > 0) E.mid(acc, cur, tb, wr, wc, fr, fq); }
        _Pragma("nounroll") for (int t = tb; t < tb + seglen; t += 2) {
            const bool last = (t == nt - 2);
            const char* a1 = S.aptr(cur, t + 1);
            const char* a2 = last ? S.aptr(nu, 0) : S.aptr(cur, t + 2); const char* b2 = last ? S.bptr(nu, 0) : S.bptr(cur, t + 2);
            const char* a3 = last ? S.aptr(nu, 1) : S.aptr(cur, t + 3); const char* b3 = last ? S.bptr(nu, 1) : S.bptr(cur, t + 3);
            const unsigned lmask_ = last ? 0xffffffffu : 0u;
            PG8_LDB(B0, 0, 0); PG8_LDB(B1, 0, 1); PG8_SCHED; PG8_LDA(At, 0, 0); PG8_STAGE(PG8_SA(1, 1), a1, voffA[1]);
            if constexpr (Sched::GATHER) { _Pragma("unroll") for (int h_ = 0; h_ < 2; ++h_) _Pragma("unroll") for (int i_ = 0; i_ < 2; ++i_) voffA[h_][i_] ^= (voffA[h_][i_] ^ voffAn[h_][i_]) & lmask_; }
            PG8_WAIT_V(8); PG8_WAIT_L(0); PG8_BAR; PG8_MMA(0, 0, At, B0); PG8_MMA(0, 1, At, B1); PG8_BAR; PG8_SCHED;
            PG8_LDA(At, 0, 1); PG8_STAGE(PG8_SB(0, 0), b2, voffB); PG8_STAGE(PG8_SB(0, 1), b2 + hstepB, voffB); PG8_STAGE(PG8_SA(0, 0), a2, voffA[0]);
            PG8_WAIT_V(8); PG8_WAIT_L(0); PG8_BAR; PG8_MMA(1, 0, At, B0); PG8_MMA(1, 1, At, B1); PG8_BAR; PG8_SCHED;
            PG8_LDB(B0, 1, 0); PG8_LDB(B1, 1, 1); PG8_SCHED; PG8_LDA(At, 1, 0); PG8_STAGE(PG8_SA(0, 1), a2, voffA[1]);
            PG8_WAIT_V(8); PG8_WAIT_L(0); PG8_BAR; PG8_MMA(0, 0, At, B0); PG8_MMA(0, 1, At, B1); PG8_BAR; PG8_SCHED;
            PG8_LDA(At, 1, 1); PG8_STAGE(PG8_SB(1, 0), b3, voffB); PG8_STAGE(PG8_SB(1, 1), b3 + hstepB, voffB); PG8_STAGE(PG8_SA(1, 0), a3, voffA[0]);
            PG8_WAIT_V(8); PG8_WAIT_L(0); PG8_BAR; PG8_MMA(1, 0, At, B0); PG8_MMA(1, 1, At, B1); PG8_BAR; PG8_SCHED;
        }
        }
        if (wr == 0) PG8_BAR;
        { int t_ = tid; asm volatile("" : "+v"(t_)); E(acc, cur, wr, wc, t_ & 15, (t_ & 63) >> 4); }
        if (!has_next) break;
#pragma unroll
        for (int a = 0; a < 2; ++a)
#pragma unroll
            for (int b = 0; b < 2; ++b)
#pragma unroll
                for (int m = 0; m < 4; ++m)
#pragma unroll
                    for (int n = 0; n < 2; ++n) acc[a][b][m][n] = (f32x4){0.f, 0.f, 0.f, 0.f};
        cur = nxt; ++ui;
        if constexpr (Sched::GATHER) { _Pragma("unroll") for (int h_ = 0; h_ < 2; ++h_) _Pragma("unroll") for (int i_ = 0; i_ < 2; ++i_) voffA[h_][i_] = voffAn[h_][i_]; }
        if (wr == 1) PG8_BAR;
    }
    PG8_WAIT_V(0);
    PG8_BAR;
#undef PG8_SETA
#undef PG8_SA
#undef PG8_SB
#undef PG8_STAGE
#undef PG8_LDA
#undef PG8_LDB
#undef PG8_MMA
#undef PG8_CAT
#undef PG8_WAIT_V
#undef PG8_WAIT_L
#undef PG8_BAR
#undef PG8_SCHED
}
}


constexpr int NWAVES = 8, NTHR = 512;
constexpr int D = 1024, BATCH = 8, SEQ = 4096, T = BATCH * SEQ, DEPTH = 2;
constexpr int DIN = 7696, NH = 7680;
constexpr int NEXP = 32, DEXP = 512;
constexpr float ALPHA = 1.41421356237309515f;
constexpr float LN_EPS = 1e-5f;
constexpr float LOG2E = 1.4426950408889634f;
constexpr float QSCALE = 0.125f * LOG2E;
constexpr int MAXROWS = 73728, MAXTILES = MAXROWS / 256;

constexpr size_t MiB = 1u << 20;
constexpr size_t WS_CTL = 0, CTL_ZERO_BYTES = 1 * MiB;
constexpr size_t WS_BIAS = 1 * MiB;
constexpr size_t WS_WIN = 2 * MiB, WS_WBR = 18 * MiB, WS_WOUT = 21 * MiB;
constexpr size_t WS_XB = 24 * MiB;
constexpr size_t WS_SM = 88 * MiB;
constexpr size_t WS_LFOX = WS_SM;
constexpr size_t WS_FC = WS_SM + 1 * MiB;
constexpr size_t WS_MLI = WS_SM + 2 * MiB;
constexpr size_t WS_MLF = WS_SM + 2 * MiB + 512 * 1024;
constexpr size_t WS_MST = WS_SM + 3 * MiB;
constexpr size_t WS_NV = WS_SM + 3 * MiB + 64 * 1024;
constexpr size_t WS_TOKE = WS_SM + 4 * MiB;
constexpr size_t WS_TOKP = WS_SM + 4 * MiB + 256 * 1024;
constexpr size_t WS_TOKG = WS_SM + 4 * MiB + 512 * 1024;
constexpr size_t WS_ENT = WS_SM + 5 * MiB;
constexpr size_t WS_SGUW = WS_SM + 7 * MiB;
constexpr size_t WS_WRT = WS_SM + 7 * MiB + 256 * 1024;
constexpr size_t WS_H = 96 * MiB, SEGB = 32 * MiB;
constexpr size_t SEGE = (size_t)T * 512;
enum Seg { S_Q = 0, S_K = 1, S_V = 2, S_MLQ = 3, S_MLK = 4, S_MLV = 5, S_MLO = 6, S_SU = 7, S_SV = 8, S_G0 = 9 };
constexpr size_t WS_MERGED = WS_H + 1 * SEGB;
constexpr size_t WS_ENT2 = WS_H;
constexpr size_t WS_HID = WS_H + 144 * MiB;
constexpr size_t WS_YBUF = WS_H + 216 * MiB;
constexpr size_t WS_WD = WS_H + 448 * MiB;
constexpr size_t WS_XB8 = WS_H + 384 * MiB;
constexpr size_t WS_SA = WS_SM + 6 * MiB;
constexpr size_t WS_END = WS_H + 480 * MiB;
constexpr int CW_BAR = 4096;
constexpr int CW_CNT = 16384;
constexpr int CW_CMAX = 32768;

constexpr int RING_BYTES = 131072;
constexpr int LDS_BYTES = 147456;
constexpr int LDSCTL_OFF = LDS_BYTES - 1024, MISC_OFF = LDSCTL_OFF + 320;
constexpr int XTRA_OFF = RING_BYTES;
constexpr int SCR_BYTES = LDSCTL_OFF;

#define GAS __attribute__((address_space(1)))
#define LAS __attribute__((address_space(3)))
typedef unsigned short bf16;
typedef unsigned v4u __attribute__((ext_vector_type(4)));
typedef unsigned v2u __attribute__((ext_vector_type(2)));
typedef float f32x4 __attribute__((ext_vector_type(4)));
typedef float f32x2 __attribute__((ext_vector_type(2)));
typedef short bf16x8 __attribute__((ext_vector_type(8)));
typedef GAS unsigned gu32;
#define RLX_AGENT __ATOMIC_RELAXED, __HIP_MEMORY_SCOPE_AGENT
#define LDS_WAIT() asm volatile("s_waitcnt lgkmcnt(0)" ::: "memory")
#define VM_WAIT() asm volatile("s_waitcnt vmcnt(0)" ::: "memory")
__device__ __forceinline__ unsigned f2bf(float f) { unsigned u = __builtin_bit_cast(unsigned, f); return (u + 0x7fffu + ((u >> 16) & 1u)) >> 16; }
__device__ __forceinline__ unsigned pk2(float lo, float hi) { return f2bf(lo) | (f2bf(hi) << 16); }
__device__ __forceinline__ float bf2f(unsigned h) { return __builtin_bit_cast(float, h << 16); }
__device__ __forceinline__ float bflo(unsigned w) { return __builtin_bit_cast(float, w << 16); }
__device__ __forceinline__ float bfhi(unsigned w) { return __builtin_bit_cast(float, w & 0xffff0000u); }
__device__ __forceinline__ float fexp2(float x) { return __builtin_amdgcn_exp2f(x); }
__device__ __forceinline__ float fexp(float x) { return __builtin_amdgcn_exp2f(x * LOG2E); }
__device__ __forceinline__ float frcp(float x) { return __builtin_amdgcn_rcpf(x); }
__device__ __forceinline__ float sigmoidf_(float x) { return frcp(1.f + fexp(-x)); }
__device__ __forceinline__ float siluf_(float x) { return x * sigmoidf_(x); }
__device__ __forceinline__ float gelu_tanh(float x) { const float y = 0.7978845608028654f * (x + 0.044715f * x * x * x); return x * sigmoidf_(2.f * y); }
__device__ __forceinline__ float log_sigmoid(float x) { return fminf(x, 0.f) - 0.6931471805599453f * __builtin_amdgcn_logf(1.f + fexp(-fabsf(x))); }
template <int CTRL> __device__ __forceinline__ float dpp_f(float v) { return __builtin_bit_cast(float, __builtin_amdgcn_update_dpp(0, __builtin_bit_cast(int, v), CTRL, 0xF, 0xF, true)); }
__device__ __forceinline__ float wave_sum(float v) {
    v += dpp_f<0xB1>(v);
    v += dpp_f<0x4E>(v);
    v += dpp_f<0x141>(v);
    v += dpp_f<0x140>(v);
    { auto r = __builtin_amdgcn_permlane16_swap(__float_as_uint(v), __float_as_uint(v), false, false); v = __uint_as_float(r[0]) + __uint_as_float(r[1]); }
    { auto r = __builtin_amdgcn_permlane32_swap(__float_as_uint(v), __float_as_uint(v), false, false); v = __uint_as_float(r[0]) + __uint_as_float(r[1]); }
    return v;
}
__device__ __forceinline__ float wave_max(float v) {
    v = fmaxf(v, dpp_f<0xB1>(v)); v = fmaxf(v, dpp_f<0x4E>(v)); v = fmaxf(v, dpp_f<0x141>(v)); v = fmaxf(v, dpp_f<0x140>(v));
    { auto r = __builtin_amdgcn_permlane16_swap(__float_as_uint(v), __float_as_uint(v), false, false); v = fmaxf(__uint_as_float(r[0]), __uint_as_float(r[1])); }
    { auto r = __builtin_amdgcn_permlane32_swap(__float_as_uint(v), __float_as_uint(v), false, false); v = fmaxf(__uint_as_float(r[0]), __uint_as_float(r[1])); }
    return v;
}

#define XB_TMO      128
#define XB_XCNT(j)  (256  + 64 * (j))
#define XB_XSUB(j)  (1280 + 64 * (j))
#define XB_XGEN(j)  (2304 + 64 * (j))
#define XB_TOP      3328
#define XB_TOPGEN   3392
#define XCD_BAR_WORDS 3456
#define XB_SPIN_CAP (1u << 22)
__device__ __forceinline__ unsigned xb_ld(unsigned* p)              { return __hip_atomic_load(p, __ATOMIC_RELAXED, __HIP_MEMORY_SCOPE_AGENT); }
__device__ __forceinline__ unsigned xb_add(unsigned* p, unsigned v) { return __hip_atomic_fetch_add(p, v, __ATOMIC_RELAXED, __HIP_MEMORY_SCOPE_AGENT); }
__device__ __forceinline__ unsigned xb_xcc_id() { return (unsigned)__builtin_amdgcn_s_getreg((3 << 11) | 20) & 0xFu; }
#define XB_SPIN(cond, bar) do { unsigned _sp = 0; while (cond) { __builtin_amdgcn_s_sleep(1); \
    if ((++_sp & 255u) == 0u) { if (xb_ld(&(bar)[XB_TMO])) break; if (_sp > XB_SPIN_CAP) { atomicAdd(&(bar)[XB_TMO], 1u); break; } } } } while (0)
struct XcdBarrier { unsigned* bar; unsigned x; volatile LAS unsigned* st; };
__device__ __forceinline__ XcdBarrier xcd_barrier_post(unsigned* bar, volatile LAS unsigned* st) {
    XcdBarrier b; b.bar = bar; b.x = xb_xcc_id(); b.st = st;
    if (threadIdx.x == 0) (void)xb_add(&bar[XB_XCNT(b.x)], 1u);
    return b;
}
__device__ __forceinline__ void xcd_barrier_complete(unsigned* bar, unsigned x, unsigned& nloc, unsigned& nx) {
    const unsigned G = gridDim.x * gridDim.y * gridDim.z;
    unsigned sum, cnt, mine, sp = 0u;
    for (;;) {
        sum = 0u; cnt = 0u; mine = 0u;
#pragma nounroll
        for (unsigned j = 0; j < 16; ++j) { const unsigned c = xb_ld(&bar[XB_XCNT(j)]); sum += c; cnt += (c > 0u) ? 1u : 0u; mine = (j == x) ? c : mine; }
        if (sum == G) break;
        __builtin_amdgcn_s_sleep(1);
        if ((++sp & 255u) == 0u) { if (xb_ld(&bar[XB_TMO])) break; if (sp > XB_SPIN_CAP) { atomicAdd(&bar[XB_TMO], 1u); break; } }
    }
    nloc = mine > 0u ? mine : 1u; nx = cnt > 0u ? cnt : 1u;
}
template <class Fill>
__device__ __forceinline__ void xcd_barrier(const XcdBarrier& b, bool leader, const Fill& fill) {
    asm volatile("s_waitcnt vmcnt(0)" ::: "memory");
    __syncthreads();
    fill();
    if (leader) {
        unsigned* bar = b.bar;
        __builtin_amdgcn_s_waitcnt(0);
        unsigned nloc = b.st[0], nx = b.st[1];
        if (nloc == 0u) { xcd_barrier_complete(bar, b.x, nloc, nx); b.st[0] = nloc; b.st[1] = nx; }
        const unsigned old = xb_add(&bar[XB_XSUB(b.x)], 1u);
        const unsigned gen = old / nloc;
        if (old + 1u == (gen + 1u) * nloc) {
            __builtin_amdgcn_fence(__ATOMIC_RELEASE, "agent");
            asm volatile("s_waitcnt vmcnt(0)" ::: "memory");
            const unsigned og = xb_add(&bar[XB_TOP], 1u);
            const unsigned tg = og / nx;
            if (og + 1u == (tg + 1u) * nx) xb_add(&bar[XB_TOPGEN], 1u);
            else XB_SPIN(xb_ld(&bar[XB_TOPGEN]) == tg, bar);
            __builtin_amdgcn_fence(__ATOMIC_ACQUIRE, "agent");
            xb_add(&bar[XB_XGEN(b.x)], 1u);
            asm volatile("s_waitcnt vmcnt(0)" ::: "memory");
        } else {
            XB_SPIN(xb_ld(&bar[XB_XGEN(b.x)]) == gen, bar);
            __builtin_amdgcn_fence(__ATOMIC_ACQUIRE, "agent");
            asm volatile("s_waitcnt vmcnt(0)" ::: "memory");
        }
    }
    __syncthreads();
}

struct Args { const float* in[23]; float* out; unsigned char* ws; int ph_lo, ph_hi; };
struct Frame {
    LAS unsigned char* lds;
    volatile LAS unsigned* MISC;
    gu32* ctl;
    int tid, lane, wave, G, bid, cpass;
    unsigned char* ws;
    float* XF;
    bf16* XB;
    bf16* H;
};
__device__ __forceinline__ bf16* seg(const Frame& F, int s) { return F.H + (size_t)s * SEGE; }
constexpr int INTBL_OFF = LDSCTL_OFF + 512, TICKET_OFF = LDSCTL_OFF + 768;
__device__ __forceinline__ const float* inptr(const Frame& F, int k) {
    const LAS unsigned* t = (const LAS unsigned*)(F.lds + INTBL_OFF) + 2 * k;
    const unsigned lo = __builtin_amdgcn_readfirstlane(t[0]), hi = __builtin_amdgcn_readfirstlane(t[1]);
    return (const float*)(((unsigned long long)hi << 32) | lo);
}

__device__ __forceinline__ void transpose_item(const float* src, int src_pitch, int k0, int n0, bf16* dst, int dst_pitch, int dst_row0, int dst_k0, LAS float* scr, int lane) {
    float tv[32];
#pragma unroll
    for (int i = 0; i < 32; ++i) tv[i] = __builtin_nontemporal_load(src + (size_t)(k0 + 2 * i + (lane >> 5)) * src_pitch + n0 + (lane & 31));
#pragma unroll
    for (int i = 0; i < 32; ++i) scr[(2 * i + (lane >> 5)) * 33 + (lane & 31)] = tv[i];
    LDS_WAIT(); asm volatile("" ::: "memory");
    const int c = lane & 7;
#pragma unroll
    for (int j = 0; j < 4; ++j) { const int n = (lane >> 3) + 8 * j; const LAS float* s = scr + (8 * c) * 33 + n;
        v4u o; o.x = pk2(s[0 * 33], s[1 * 33]); o.y = pk2(s[2 * 33], s[3 * 33]); o.z = pk2(s[4 * 33], s[5 * 33]); o.w = pk2(s[6 * 33], s[7 * 33]);
        asm volatile("global_store_dwordx4 %0, %1, off sc1\n\ts_nop 1" :: "v"(dst + (size_t)(dst_row0 + n) * dst_pitch + dst_k0 + k0 + 8 * c), "v"(o) : "memory"); }
    LDS_WAIT(); asm volatile("" ::: "memory");
}
__device__ __forceinline__ unsigned f8pk4(float a, float b, float c, float d) { int w = 0; w = __builtin_amdgcn_cvt_pk_fp8_f32(a, b, w, false); w = __builtin_amdgcn_cvt_pk_fp8_f32(c, d, w, true); return (unsigned)w; }
__device__ __forceinline__ unsigned i8pk4(float a, float b, float c, float d) {
    unsigned w = 0u; w = __builtin_amdgcn_cvt_pk_u8_f32(a + 128.f, 0u, w); w = __builtin_amdgcn_cvt_pk_u8_f32(b + 128.f, 1u, w); w = __builtin_amdgcn_cvt_pk_u8_f32(c + 128.f, 2u, w); w = __builtin_amdgcn_cvt_pk_u8_f32(d + 128.f, 3u, w);
    return w ^ 0x80808080u; }
#define I8_LOAD(tv, k0_) do { _Pragma("unroll") for (int i = 0; i < 32; ++i) tv[i] = __builtin_nontemporal_load(src + (size_t)((k0_) + 2 * i + (lane >> 5)) * src_pitch + n0 + (lane & 31)); } while (0)
#define I8_EMIT(tv, k0_) do { _Pragma("unroll") for (int i = 0; i < 32; ++i) scr[(2 * i + (lane >> 5)) * 33 + (lane & 31)] = tv[i]; \
        LDS_WAIT(); asm volatile("" ::: "memory"); \
        _Pragma("unroll") for (int j = 0; j < 4; ++j) { const int n = (lane >> 3) + 8 * j; const LAS float* s_ = scr + (8 * c) * 33 + n; \
            v2u o; o.x = i8pk4(__builtin_rintf(s_[0 * 33] * sc), __builtin_rintf(s_[1 * 33] * sc), __builtin_rintf(s_[2 * 33] * sc), __builtin_rintf(s_[3 * 33] * sc)); \
            o.y = i8pk4(__builtin_rintf(s_[4 * 33] * sc), __builtin_rintf(s_[5 * 33] * sc), __builtin_rintf(s_[6 * 33] * sc), __builtin_rintf(s_[7 * 33] * sc)); \
            asm volatile("global_store_dwordx2 %0, %1, off sc1\n\ts_nop 1" :: "v"(dst + (size_t)(dst_row0 + n) * dst_pitch + (k0_) + 8 * c), "v"(o) : "memory"); } \
        LDS_WAIT(); asm volatile("" ::: "memory"); } while (0)
__device__ __forceinline__ void strip_i8(const float* src, int src_pitch, int n0, unsigned char* dst, int dst_pitch, int dst_row0, unsigned* cmax1, LAS float* scr, LAS float* red, int wave, int lane) {
    float ta[32], tb[32];
    I8_LOAD(ta, wave * 64); I8_LOAD(tb, (wave + 8) * 64);
    float m = 0.f;
#pragma unroll
    for (int i = 0; i < 32; ++i) m = fmaxf(m, fmaxf(fabsf(ta[i]), fabsf(tb[i])));
    m = wave_max(m);
    if (lane == 0) red[wave] = m;
    __syncthreads();
    float mm = red[0];
#pragma unroll
    for (int w = 1; w < NWAVES; ++w) mm = fmaxf(mm, red[w]);
    if (wave == 0 && lane == 0) *cmax1 = __float_as_uint(mm);
    const float sc = 127.f * frcp(fmaxf(mm, 1e-30f)); const int c = lane & 7;
    I8_EMIT(ta, wave * 64); I8_EMIT(tb, (wave + 8) * 64);
    __syncthreads();
}
#undef I8_LOAD
#undef I8_EMIT
__device__ __forceinline__ float f8clamp(float x) { return __builtin_amdgcn_fmed3f(x, -448.f, 448.f); }
__device__ __forceinline__ void transpose_item8(const float* src, int src_pitch, int k0, int n0, unsigned char* dst, int dst_pitch, int dst_row0, int dst_k0, float scale, LAS float* scr, int lane) {
    float tv[32];
#pragma unroll
    for (int i = 0; i < 32; ++i) tv[i] = __builtin_nontemporal_load(src + (size_t)(k0 + 2 * i + (lane >> 5)) * src_pitch + n0 + (lane & 31));
#pragma unroll
    for (int i = 0; i < 32; ++i) scr[(2 * i + (lane >> 5)) * 33 + (lane & 31)] = tv[i];
    LDS_WAIT(); asm volatile("" ::: "memory");
    const int c = lane & 7;
#pragma unroll
    for (int j = 0; j < 4; ++j) { const int n = (lane >> 3) + 8 * j; const LAS float* s = scr + (8 * c) * 33 + n;
        v2u o; o.x = f8pk4(f8clamp(s[0 * 33] * scale), f8clamp(s[1 * 33] * scale), f8clamp(s[2 * 33] * scale), f8clamp(s[3 * 33] * scale));
        o.y = f8pk4(f8clamp(s[4 * 33] * scale), f8clamp(s[5 * 33] * scale), f8clamp(s[6 * 33] * scale), f8clamp(s[7 * 33] * scale));
        asm volatile("global_store_dwordx2 %0, %1, off sc1\n\ts_nop 1" :: "v"(dst + (size_t)(dst_row0 + n) * dst_pitch + dst_k0 + k0 + 8 * c), "v"(o) : "memory"); }
    LDS_WAIT(); asm volatile("" ::: "memory");
}
__device__ __forceinline__ int orig_col(int n) { return n < 1536 ? n : (n < 3584 ? n + 8 : n + 16); }

__device__ __forceinline__ void convert_small(const Frame& F, const Args& args, int l) {
    LAS float* scr = (LAS float*)(F.lds + F.wave * 16384);
    const int gw = F.bid * NWAVES + F.wave, NGW = F.G * NWAVES;
    const float* w_in = inptr(F, 3) + (size_t)l * D * DIN;
    const float* w_br = inptr(F, 10) + (size_t)l * 3 * 512 * D;
    const float* w_out = inptr(F, 11) + (size_t)l * D * D;
    bf16* Wbr_t = (bf16*)(F.ws + WS_WBR); bf16* Wout_t = (bf16*)(F.ws + WS_WOUT);
    constexpr int I_BR = 3 * (512 / 64) * (D / 32), I_OUT = (D / 64) * (D / 32);
    for (int strip = F.bid; strip < NH / 32; strip += F.G) { const int n0 = strip * 32;
        strip_i8(w_in, DIN, orig_col(n0), (unsigned char*)(F.ws + WS_WIN), D, n0, (unsigned*)(F.ctl + CW_CMAX) + l * (NH / 32) + strip, scr, (LAS float*)(F.lds + XTRA_OFF), F.wave, F.lane); }
    for (int it = gw; it < I_BR + I_OUT; it += NGW) {
        int r = it;
        if (r < I_BR) { const int n = r / ((512 / 64) * (D / 32)), q = r % ((512 / 64) * (D / 32)); const int kb = q / (D / 32), nb = q % (D / 32);
            transpose_item(w_br + (size_t)n * 512 * D, D, kb * 64, nb * 32, Wbr_t, 1536, nb * 32, n * 512, scr, F.lane); continue; }
        r -= I_BR;
        { const int kb = r / (D / 32), nb = r % (D / 32); transpose_item(w_out, D, kb * 64, nb * 32, Wout_t, D, nb * 32, 0, scr, F.lane); }
    }
    float* bias_p = (float*)(F.ws + WS_BIAS); const float* b_in = inptr(F, 4) + (size_t)l * DIN;
    for (int i = F.bid * NTHR + F.tid; i < NH; i += F.G * NTHR) bias_p[i] = b_in[orig_col(i)];
    { const float* wrt = inptr(F, 16) + (size_t)l * D * NEXP; float* wrT = (float*)(F.ws + WS_WRT);
      for (int i = F.bid * NTHR + F.tid; i < NEXP * D; i += F.G * NTHR) wrT[i] = wrt[(size_t)(i & 1023) * NEXP + (i >> 10)]; }
    { const float* sw = inptr(F, 8) + (size_t)l * 4 * 128 * 128; bf16* Wm = (bf16*)(F.ws + WS_SGUW);
      for (int i = F.bid * NTHR + F.tid; i < 4 * 128 * 128; i += F.G * NTHR) { const int t = (i >> 7) & 127, s = i & 127; Wm[i] = (bf16)((s <= t) ? f2bf(sw[i]) : 0u); } }
}

__device__ __forceinline__ unsigned char* wgu_ptr(const Frame& F) { return (unsigned char*)(F.XF + (size_t)16 * 1024 * 1024); }
constexpr float W8SCALE = 64.f, W8INV = 1.f / 64.f;
__device__ __forceinline__ void expert_item(const Frame& F, int l, int kind, int idx, LAS float* scr) {
    if (kind == 0) { const int e = idx >> 9, which = (idx >> 8) & 1, q = idx & 255, kb = q >> 4, n0 = (q & 15) * 32;
        const float* w = inptr(F, which ? 19 : 18) + ((size_t)l * NEXP + e) * D * DEXP;
        transpose_item8(w, DEXP, kb * 64, n0, wgu_ptr(F) + (size_t)e * 1024 * 1024, 1024, 256 * (n0 >> 7) + (n0 & 127) + which * 128, 0, W8SCALE, scr, F.lane); }
    else { const int e = idx >> 8, q = idx & 255, kb = q >> 5, nb = q & 31;
        const float* w = inptr(F, 20) + ((size_t)l * NEXP + e) * DEXP * D;
        transpose_item8(w, D, kb * 64, nb * 32, (unsigned char*)(F.ws + WS_WD) + (size_t)e * 1024 * 512, 512, nb * 32, 0, W8SCALE, scr, F.lane); }
}
__device__ __forceinline__ void convert_experts(const Frame& F, int l, int iu0, int id0) {
    LAS float* scr = (LAS float*)(F.lds + F.wave * 16384);
    if (F.G == 256) {
        const int nu = 64 - iu0, nd = 32 - id0;
#pragma nounroll
        for (int j = F.wave; j < nu + nd; j += NWAVES) { if (j < nu) expert_item(F, l, 0, F.bid + 256 * (iu0 + j), scr); else expert_item(F, l, 1, F.bid + 256 * (id0 + j - nu), scr); }
    } else {
        const int gw = F.bid * NWAVES + F.wave, NGW = F.G * NWAVES;
#pragma nounroll
        for (int it = gw; it < 16384 + 8192; it += NGW) { if (it < 16384) expert_item(F, l, 0, it, scr); else expert_item(F, l, 1, it - 16384, scr); }
    }
}

#if defined(EXPT) && EXPT == 3
#define EXPT3 1
#else
#define EXPT3 0
#endif
template <int MODE>
__device__ __forceinline__ void ln_rows(const Frame& F, const Args& args, const float* lng, const float* lnb, int gl) {
    constexpr int WP = 1032;
    LAS bf16* wt = (LAS bf16*)F.lds;
    if (gl >= 0) {
        const float* w_in = inptr(F, 3) + (size_t)gl * D * DIN;
        for (int k = F.tid; k < D; k += NTHR) {
#pragma unroll
            for (int c = 0; c < 16; ++c) wt[c * WP + k] = (bf16)f2bf(w_in[(size_t)k * DIN + (c < 8 ? 1536 + c : 3592 + (c - 8))]);
        }
        __syncthreads();
    }
    const int gw = F.bid * NWAVES + F.wave, NGW = F.G * NWAVES;
    const float* xin = inptr(F, 0);
    const unsigned char* ybuf = (const unsigned char*)(F.ws + WS_YBUF); const float* tokg = (const float*)(F.ws + WS_TOKG);
    float* lfox = (float*)(F.ws + WS_LFOX); float* mli = (float*)(F.ws + WS_MLI); float* mlf = (float*)(F.ws + WS_MLF);
    unsigned char* xb8 = F.ws + WS_XB8; float* sa = (float*)(F.ws + WS_SA);
    f32x4 gv[4], bv[4];
#pragma unroll
    for (int j = 0; j < 4; ++j) { gv[j] = *(const f32x4*)(lng + 4 * F.lane + 256 * j); bv[j] = *(const f32x4*)(lnb + 4 * F.lane + 256 * j); }
    f32x4 vn[4]; unsigned yan[4], ybn[4]; float g0n = 0.f, g1n = 0.f;
#define LNR_LOAD(rw) do { const size_t ro_ = (size_t)(rw) * D + 4 * F.lane; \
        if (MODE == 0) { _Pragma("unroll") for (int j = 0; j < 4; ++j) vn[j] = __builtin_nontemporal_load((const f32x4*)(xin + ro_ + 256 * j)); } \
        else { _Pragma("unroll") for (int j = 0; j < 4; ++j) { const v2u x_ = *(const v2u*)(F.XB + ro_ + 256 * j); vn[j] = (f32x4){bflo(x_.x), bfhi(x_.x), bflo(x_.y), bfhi(x_.y)}; } } \
        if (MODE == 2 && !(EXPT3 && F.cpass == 0)) { g0n = tokg[2 * (rw)]; g1n = tokg[2 * (rw) + 1]; \
            _Pragma("unroll") for (int j = 0; j < 4; ++j) { yan[j] = *(const unsigned*)(ybuf + (size_t)(2 * (rw)) * D + 4 * F.lane + 256 * j); ybn[j] = *(const unsigned*)(ybuf + (size_t)(2 * (rw) + 1) * D + 4 * F.lane + 256 * j); } } } while (0)
    if (gw < T) LNR_LOAD(gw);
#pragma nounroll
    for (int row = gw; row < T; row += NGW) {
        f32x4 v[4]; float s = 0.f;
        const size_t ro = (size_t)row * D + 4 * F.lane;
#pragma unroll
        for (int j = 0; j < 4; ++j) v[j] = vn[j];
        if (MODE == 2) {
#pragma unroll
            for (int j = 0; j < 4; ++j) { const int a = (int)yan[j], b = (int)ybn[j]; const float ga = g0n * (1.f / 16.f), gb = g1n * (1.f / 16.f);
                v[j].x = ALPHA * v[j].x + ga * __builtin_amdgcn_cvt_f32_fp8(a, 0) + gb * __builtin_amdgcn_cvt_f32_fp8(b, 0); v[j].y = ALPHA * v[j].y + ga * __builtin_amdgcn_cvt_f32_fp8(a, 1) + gb * __builtin_amdgcn_cvt_f32_fp8(b, 1);
                v[j].z = ALPHA * v[j].z + ga * __builtin_amdgcn_cvt_f32_fp8(a, 2) + gb * __builtin_amdgcn_cvt_f32_fp8(b, 2); v[j].w = ALPHA * v[j].w + ga * __builtin_amdgcn_cvt_f32_fp8(a, 3) + gb * __builtin_amdgcn_cvt_f32_fp8(b, 3); } }
        if (row + NGW < T) LNR_LOAD(row + NGW);
#pragma unroll
        for (int j = 0; j < 4; ++j) s += (v[j].x + v[j].y) + (v[j].z + v[j].w);
        const float mean = wave_sum(s) * (1.f / D); float s2 = 0.f;
#pragma unroll
        for (int j = 0; j < 4; ++j) { v[j] = v[j] - mean; s2 += (v[j].x * v[j].x + v[j].y * v[j].y) + (v[j].z * v[j].z + v[j].w * v[j].w); }
        const float rstd = 1.f / sqrtf(wave_sum(s2) * (1.f / D) + LN_EPS);
#pragma unroll
        for (int j = 0; j < 4; ++j) { v[j] = v[j] * rstd * gv[j] + bv[j];
            if (MODE == 2 && gl < 0) __builtin_nontemporal_store(v[j], (f32x4*)(F.XF + ro + 256 * j));
            else { v2u o; o.x = pk2(v[j].x, v[j].y); o.y = pk2(v[j].z, v[j].w); *(v2u*)(F.XB + ro + 256 * j) = o; } }
        if (gl >= 0) {
            float am = 0.f;
#pragma unroll
            for (int j = 0; j < 4; ++j) am = fmaxf(fmaxf(am, fmaxf(fabsf(v[j].x), fabsf(v[j].y))), fmaxf(fabsf(v[j].z), fabsf(v[j].w)));
            am = fmaxf(wave_max(am), 1e-30f); const float qs = 127.f * frcp(am);
#pragma unroll
            for (int j = 0; j < 4; ++j) *(unsigned*)(xb8 + ro + 256 * j) = i8pk4(__builtin_rintf(v[j].x * qs), __builtin_rintf(v[j].y * qs), __builtin_rintf(v[j].z * qs), __builtin_rintf(v[j].w * qs));
            if (F.lane == 0) sa[row] = am * (1.f / 127.f); }
    }
    if (gl >= 0) {
        typedef float f32x4m __attribute__((ext_vector_type(4)));
        asm volatile("s_waitcnt vmcnt(0)" ::: "memory");
        __builtin_amdgcn_fence(__ATOMIC_ACQUIRE, "agent");
        const int r16 = F.lane & 15, kq = F.lane >> 4;
        const int arow = gw + r16 * NGW;
        bf16x8 af[32];
#pragma unroll
        for (int ks = 0; ks < 32; ++ks) af[ks] = (arow < T) ? *(const bf16x8*)(F.XB + (size_t)arow * D + 32 * ks + 8 * kq) : (bf16x8){0, 0, 0, 0, 0, 0, 0, 0};
        f32x4m acc = {0.f, 0.f, 0.f, 0.f};
#pragma unroll
        for (int ks = 0; ks < 32; ++ks) acc = __builtin_amdgcn_mfma_f32_16x16x32_bf16(af[ks], *(const LAS bf16x8*)(wt + r16 * WP + 32 * ks + 8 * kq), acc, 0, 0, 0);
        const int c = r16; const float* b_in = inptr(F, 4) + (size_t)gl * DIN; const float bias = b_in[c < 8 ? 1536 + c : 3592 + (c - 8)];
#pragma unroll
        for (int i = 0; i < 4; ++i) { const int row = gw + (4 * kq + i) * NGW; if (row < T) { const float logit = acc[i] + bias;
            if (c < 8) lfox[(size_t)row * 8 + c] = log_sigmoid(logit);
            else if (c < 12) mli[(size_t)row * 4 + (c - 8)] = logit;
            else mlf[(size_t)row * 4 + (c - 12)] = log_sigmoid(logit); } }
    }
#undef LNR_LOAD
    __syncthreads();
}

__device__ __forceinline__ void fox_scan(const Frame& F) {
    if (F.bid >= 64) return;
    const float* lfox = (const float*)(F.ws + WS_LFOX); float* Fc = (float*)(F.ws + WS_FC);
    LAS float* wt = (LAS float*)(F.lds + XTRA_OFF);
    for (int bh = F.bid; bh < 64; bh += F.G) {
        const int b = bh >> 3, h = bh & 7; const int s0 = F.tid * 8;
        float v[8]; float run = 0.f;
#pragma unroll
        for (int i = 0; i < 8; ++i) { run += lfox[((size_t)b * SEQ + s0 + i) * 8 + h]; v[i] = run; }
        float inc = run;
#pragma unroll
        for (int o = 1; o < 64; o <<= 1) { const float t = __shfl_up(inc, o); if (F.lane >= o) inc += t; }
        if (F.lane == 63) wt[F.wave] = inc;
        __syncthreads();
        float base = inc - run;
        for (int w = 0; w < F.wave; ++w) base += wt[w];
#pragma unroll
        for (int i = 0; i < 8; ++i) Fc[(size_t)bh * SEQ + s0 + i] = base + v[i];
        __syncthreads();
    }
}

__device__ __forceinline__ void attn_naive(const Frame& F) {
    bf16* Qs = seg(F, S_Q); const bf16* Ks = seg(F, S_K); const bf16* Vs = seg(F, S_V);
    const float* Fc = (const float*)(F.ws + WS_FC);
    LAS unsigned* Kt = (LAS unsigned*)F.lds;
    LAS unsigned* Vt = (LAS unsigned*)(F.lds + 8192);
    LAS float* Ft = (LAS float*)(F.lds + 16384);
    for (int u = F.bid; u < 512; u += F.G) {
        const int w = u >> 1, bh = w >> 2, sidx = w & 3, qb = ((u ^ (u / F.G)) & 1) ? 7 - sidx : sidx;
        const int b = bh >> 3, h = bh & 7;
        const int t = qb * 512 + F.tid; const size_t row = (size_t)b * SEQ + t;
        float q[64], o[64];
        { const v4u* qp = (const v4u*)(Qs + row * 512 + h * 64);
#pragma unroll
          for (int i = 0; i < 8; ++i) { const v4u x = qp[i]; q[8 * i] = bflo(x.x); q[8 * i + 1] = bfhi(x.x); q[8 * i + 2] = bflo(x.y); q[8 * i + 3] = bfhi(x.y); q[8 * i + 4] = bflo(x.z); q[8 * i + 5] = bfhi(x.z); q[8 * i + 6] = bflo(x.w); q[8 * i + 7] = bfhi(x.w); } }
#pragma unroll
        for (int d = 0; d < 64; ++d) o[d] = 0.f;
        float m = -INFINITY, l = 0.f;
        const int ntile = (qb * 512 + 512) / 64;
        const int wave_tmax = qb * 512 + F.wave * 64 + 63;
        for (int kt = 0; kt < ntile; ++kt) {
            __syncthreads();
            { const int kr = F.tid >> 3, ch = F.tid & 7; const size_t krow = (size_t)b * SEQ + kt * 64 + kr;
              *(LAS v4u*)(Kt + kr * 32 + ch * 4) = *(const v4u*)(Ks + krow * 512 + h * 64 + ch * 8);
              *(LAS v4u*)(Vt + kr * 32 + ch * 4) = *(const v4u*)(Vs + krow * 512 + h * 64 + ch * 8);
              if (F.tid < 64) Ft[F.tid] = Fc[(size_t)bh * SEQ + kt * 64 + F.tid] * LOG2E; }
            __syncthreads();
            if (kt * 64 > wave_tmax) continue;
#pragma nounroll
            for (int sl = 0; sl < 64; ++sl) {
                float acc = 0.f;
#pragma unroll
                for (int i = 0; i < 8; ++i) { const v4u kk = *(const LAS v4u*)(Kt + sl * 32 + i * 4);
                    acc += q[8 * i] * bflo(kk.x) + q[8 * i + 1] * bfhi(kk.x) + q[8 * i + 2] * bflo(kk.y) + q[8 * i + 3] * bfhi(kk.y) + q[8 * i + 4] * bflo(kk.z) + q[8 * i + 5] * bfhi(kk.z) + q[8 * i + 6] * bflo(kk.w) + q[8 * i + 7] * bfhi(kk.w); }
                const float x = (kt * 64 + sl <= t) ? acc - Ft[sl] : -INFINITY;
                if (x > m) { const float corr = fexp2(m - x); m = x; l *= corr;
#pragma unroll
                    for (int d = 0; d < 64; ++d) o[d] *= corr; }
                const float p = fexp2(x - m); l += p;
#pragma unroll
                for (int i = 0; i < 8; ++i) { const v4u vv = *(const LAS v4u*)(Vt + sl * 32 + i * 4);
                    o[8 * i] += p * bflo(vv.x); o[8 * i + 1] += p * bfhi(vv.x); o[8 * i + 2] += p * bflo(vv.y); o[8 * i + 3] += p * bfhi(vv.y); o[8 * i + 4] += p * bflo(vv.z); o[8 * i + 5] += p * bfhi(vv.z); o[8 * i + 6] += p * bflo(vv.w); o[8 * i + 7] += p * bfhi(vv.w); }
            }
        }
        const float rl = 1.f / l;
        { v4u* op = (v4u*)(Qs + row * 512 + h * 64);
#pragma unroll
          for (int i = 0; i < 8; ++i) { v4u x; x.x = pk2(o[8 * i] * rl, o[8 * i + 1] * rl); x.y = pk2(o[8 * i + 2] * rl, o[8 * i + 3] * rl); x.z = pk2(o[8 * i + 4] * rl, o[8 * i + 5] * rl); x.w = pk2(o[8 * i + 6] * rl, o[8 * i + 7] * rl); op[i] = x; } }
    }
    __syncthreads();
}

__device__ __forceinline__ void sgu_naive(const Frame& F, const Args& args, int l) {
    bf16* SU = seg(F, S_SU); const bf16* SV = seg(F, S_SV);
    const float* lng = inptr(F, 6) + (size_t)l * 512; const float* lnb = inptr(F, 7) + (size_t)l * 512;
    const float* sw = inptr(F, 8) + (size_t)l * 4 * 128 * 128; const float* sb = inptr(F, 9) + (size_t)l * 4 * 128;
    LAS float* vh = (LAS float*)F.lds; LAS float* Wt = (LAS float*)(F.lds + 65536);
    LAS float* st = (LAS float*)(F.lds + XTRA_OFF);
    for (int it = F.bid; it < 256; it += F.G) {
        const size_t row0 = (size_t)it * 128;
        __syncthreads();
        for (int i = 0; i < 16; ++i) { const int tok = F.wave * 16 + i;
            const v4u x = *(const v4u*)(SV + (row0 + tok) * 512 + F.lane * 8);
            const float a0 = bflo(x.x), a1 = bfhi(x.x), a2 = bflo(x.y), a3 = bfhi(x.y), a4 = bflo(x.z), a5 = bfhi(x.z), a6 = bflo(x.w), a7 = bfhi(x.w);
            const float mean = wave_sum(((a0 + a1) + (a2 + a3)) + ((a4 + a5) + (a6 + a7))) * (1.f / 512.f);
            const float d0 = a0 - mean, d1 = a1 - mean, d2 = a2 - mean, d3 = a3 - mean, d4 = a4 - mean, d5 = a5 - mean, d6 = a6 - mean, d7 = a7 - mean;
            const float var = wave_sum(((d0 * d0 + d1 * d1) + (d2 * d2 + d3 * d3)) + ((d4 * d4 + d5 * d5) + (d6 * d6 + d7 * d7))) * (1.f / 512.f);
            if (F.lane == 0) { st[2 * tok] = mean; st[2 * tok + 1] = 1.f / sqrtf(var + LN_EPS); } }
        for (int g = 0; g < 4; ++g) {
            __syncthreads();
            for (int i = 0; i < 32; ++i) { const int e = F.tid + 512 * i, s = e >> 7, c = e & 127;
                vh[s * 128 + c] = (bf2f(SV[(row0 + s) * 512 + g * 128 + c]) - st[2 * s]) * st[2 * s + 1] * lng[g * 128 + c] + lnb[g * 128 + c];
                const int t = e >> 7, s2 = e & 127;
                Wt[s2 * 128 + t] = (s2 <= t) ? sw[(size_t)g * 16384 + t * 128 + s2] : 0.f; }
            __syncthreads();
            const int c = F.tid & 127, tq = F.tid >> 7;
            float z[32];
#pragma unroll
            for (int j = 0; j < 32; ++j) z[j] = 0.f;
            for (int s = 0; s < 128; ++s) { const float v = vh[s * 128 + c];
#pragma unroll
                for (int j = 0; j < 8; ++j) { const f32x4 w = *(const LAS f32x4*)(Wt + s * 128 + tq * 32 + 4 * j); z[4 * j] += w.x * v; z[4 * j + 1] += w.y * v; z[4 * j + 2] += w.z * v; z[4 * j + 3] += w.w * v; } }
#pragma unroll
            for (int j = 0; j < 32; ++j) { const int t = tq * 32 + j; const size_t o = (row0 + t) * 512 + g * 128 + c;
                SU[o] = (bf16)f2bf(bf2f(SU[o]) * (z[j] + sb[g * 128 + t])); }
        }
    }
    __syncthreads();
}

__device__ __forceinline__ float conv_silu(const bf16* srcseg, size_t rowb, int tt, int col, const float* cw  ) {
    float a = 0.f;
#pragma unroll
    for (int j = 0; j < 4; ++j) { const int ts = tt - 3 + j; if (ts >= 0) a += cw[j * 1024] * bf2f(srcseg[(rowb + ts) * 512 + col]); }
    return siluf_(a);
}

__device__ __forceinline__ void mlstm_m1_naive(const Frame& F, const Args& args, int l) {
    const bf16* MLK = seg(F, S_MLK); const bf16* MLV = seg(F, S_MLV);
    const float* cw = inptr(F, 5) + (size_t)l * 4 * 1024;
    const float* mli = (const float*)(F.ws + WS_MLI); const float* mlf = (const float*)(F.ws + WS_MLF);
    float* UC = F.XF; float* NV = (float*)(F.ws + WS_NV); float* MST = (float*)(F.ws + WS_MST);
    LAS float* kh = (LAS float*)F.lds; LAS float* vv = (LAS float*)(F.lds + 65536);
    LAS float* sg = (LAS float*)(F.lds + XTRA_OFF);
    for (int it = F.bid; it < 1024; it += F.G) {
        const int bh4 = it >> 5, c = it & 31, b = bh4 >> 2, h = bh4 & 3;
        const size_t rowb = (size_t)b * SEQ, row0 = rowb + c * 128;
        __syncthreads();
        if (F.tid < 128) { sg[F.tid] = mlf[(row0 + F.tid) * 4 + h]; sg[128 + F.tid] = mli[(row0 + F.tid) * 4 + h]; }
        __syncthreads();
        float bc = 0.f, blast = 0.f;
        if (F.tid < 128) {
#pragma nounroll
            for (int i = 0; i < 128; ++i) { blast += sg[i]; if (i == F.tid) bc = blast; } }
        __syncthreads();
        if (F.tid < 128) { sg[F.tid] = bc; sg[128 + F.tid] = blast - bc + sg[128 + F.tid]; }
        __syncthreads();
        float mg = -INFINITY;
#pragma nounroll
        for (int i = 0; i < 128; ++i) mg = fmaxf(mg, sg[128 + i]);
        if (F.tid < 128) sg[256 + F.tid] = fexp(sg[128 + F.tid] - mg);
        __syncthreads();
        for (int i = 0; i < 32; ++i) { const int e = F.tid + 512 * i, s = e >> 7, d = e & 127;
            const float kv = conv_silu(MLK, rowb, c * 128 + s, h * 128 + d, cw + 512 + h * 128 + d) * 0.08838834764831845f;
            kh[s * 128 + d] = kv * sg[256 + s];
            vv[s * 128 + d] = bf2f(MLV[(row0 + s) * 512 + h * 128 + d]); }
        __syncthreads();
        { const int d0 = (F.tid >> 4) * 4, e0 = (F.tid & 15) * 8; float acc[4][8];
#pragma unroll
          for (int i = 0; i < 4; ++i)
#pragma unroll
              for (int j = 0; j < 8; ++j) acc[i][j] = 0.f;
          for (int s = 0; s < 128; ++s) { const f32x4 kd = *(const LAS f32x4*)(kh + s * 128 + d0); const f32x4 v0 = *(const LAS f32x4*)(vv + s * 128 + e0), v1 = *(const LAS f32x4*)(vv + s * 128 + e0 + 4);
#pragma unroll
              for (int i = 0; i < 4; ++i) { acc[i][0] += kd[i] * v0.x; acc[i][1] += kd[i] * v0.y; acc[i][2] += kd[i] * v0.z; acc[i][3] += kd[i] * v0.w; acc[i][4] += kd[i] * v1.x; acc[i][5] += kd[i] * v1.y; acc[i][6] += kd[i] * v1.z; acc[i][7] += kd[i] * v1.w; } }
          float* Uo = UC + (size_t)it * 16384;
#pragma unroll
          for (int i = 0; i < 4; ++i) { *(f32x4*)(Uo + (d0 + i) * 128 + e0) = (f32x4){acc[i][0], acc[i][1], acc[i][2], acc[i][3]}; *(f32x4*)(Uo + (d0 + i) * 128 + e0 + 4) = (f32x4){acc[i][4], acc[i][5], acc[i][6], acc[i][7]}; } }
        if (F.tid < 128) { float n = 0.f; for (int s = 0; s < 128; ++s) n += kh[s * 128 + F.tid]; NV[(size_t)it * 128 + F.tid] = n; }
        if (F.tid == 0) { MST[it * 4] = mg; MST[it * 4 + 1] = blast; }
    }
    __syncthreads();
}

__device__ __forceinline__ void mlstm_m2(const Frame& F) {
    float* UC = F.XF; float* NV = (float*)(F.ws + WS_NV); float* MST = (float*)(F.ws + WS_MST);
    for (int idx = F.bid * NTHR + F.tid; idx < 32 * 4096; idx += F.G * NTHR) {
        const int bh4 = idx >> 12, e4 = idx & 4095;
        f32x4 C = (f32x4){0.f, 0.f, 0.f, 0.f}; float m = 0.f;
#pragma nounroll
        for (int cb = 0; cb < 32; cb += 8) {
            v2u U[8];
#pragma unroll
            for (int c = 0; c < 8; ++c) U[c] = *((const v2u*)((const bf16*)UC + (size_t)(bh4 * 32 + cb + c) * 16384) + e4);
#pragma unroll
            for (int c = 0; c < 8; ++c) { const int it = bh4 * 32 + cb + c;
                const float mg = MST[it * 4], bl = MST[it * 4 + 1];
                { v2u cb_; cb_.x = pk2(C.x, C.y); cb_.y = pk2(C.z, C.w); *((v2u*)((bf16*)UC + (size_t)it * 16384) + e4) = cb_; }
                const float mn = fmaxf(bl + m, mg), dc = fexp(bl + m - mn), sc = fexp(mg - mn);
                C = C * dc + (f32x4){bflo(U[c].x), bfhi(U[c].x), bflo(U[c].y), bfhi(U[c].y)} * sc;
                if (e4 == 0) MST[it * 4 + 2] = m;
                m = mn; }
        }
        if (e4 < 32) { f32x4 N = (f32x4){0.f, 0.f, 0.f, 0.f}; m = 0.f;
#pragma nounroll
            for (int c = 0; c < 32; ++c) { const int it = bh4 * 32 + c; const float mg = MST[it * 4], bl = MST[it * 4 + 1];
                f32x4* np = (f32x4*)(NV + (size_t)it * 128) + e4; const f32x4 nn = *np; *np = N;
                const float mn = fmaxf(bl + m, mg), dc = fexp(bl + m - mn), sc = fexp(mg - mn); N = N * dc + nn * sc; m = mn; } }
    }
}

__device__ __forceinline__ void mlstm_m3_naive(const Frame& F, const Args& args, int l) {
    const bf16* MLQ = seg(F, S_MLQ); const bf16* MLK = seg(F, S_MLK); bf16* MLV = seg(F, S_MLV); const bf16* MLO = seg(F, S_MLO);
    const float* cw = inptr(F, 5) + (size_t)l * 4 * 1024;
    const float* mli = (const float*)(F.ws + WS_MLI); const float* mlf = (const float*)(F.ws + WS_MLF);
    const float* UC = (const float*)F.XF; const float* NV = (const float*)(F.ws + WS_NV); const float* MST = (const float*)(F.ws + WS_MST);
    constexpr int P = 129;
    LAS float* A0 = (LAS float*)F.lds;
    LAS float* A1 = (LAS float*)(F.lds + 128 * P * 4);
    LAS float* sg = (LAS float*)(F.lds + 2 * 128 * P * 4);
    for (int it = F.bid; it < 1024; it += F.G) {
        const int bh4 = it >> 5, c = it & 31, b = bh4 >> 2, h = bh4 & 3;
        const size_t rowb = (size_t)b * SEQ, row0 = rowb + c * 128;
        const float m_in = MST[it * 4 + 2];
        __syncthreads();
        if (F.tid < 128) { sg[F.tid] = mlf[(row0 + F.tid) * 4 + h]; sg[256 + F.tid] = mli[(row0 + F.tid) * 4 + h]; sg[384 + F.tid] = NV[(size_t)it * 128 + F.tid]; }
        __syncthreads();
        float bc = 0.f;
        if (F.tid < 128) { float r = 0.f;
#pragma nounroll
            for (int i = 0; i < 128; ++i) { r += sg[i]; if (i == F.tid) bc = r; } }
        __syncthreads();
        if (F.tid < 128) { sg[F.tid] = bc; sg[128 + F.tid] = sg[256 + F.tid] - bc; }
        for (int i = 0; i < 32; ++i) { const int e = F.tid + 512 * i, s = e >> 7, d = e & 127;
            A0[s * P + d] = conv_silu(MLQ, rowb, c * 128 + s, h * 128 + d, cw + h * 128 + d);
            A1[s * P + d] = conv_silu(MLK, rowb, c * 128 + s, h * 128 + d, cw + 512 + h * 128 + d) * 0.08838834764831845f; }
        __syncthreads();
        const int t = F.tid >> 2, eq = F.tid & 3;
        float pm = -INFINITY;
        for (int s = 0; s <= t; ++s) pm = fmaxf(pm, sg[128 + s]);
        const float bt = sg[t], inter = bt + m_in, mt = fmaxf(inter, bt + pm), w_inter = fexp(inter - mt);
        float sreg[32], acc2[32]; float qn = 0.f;
#pragma unroll
        for (int j = 0; j < 32; ++j) { sreg[j] = 0.f; acc2[j] = 0.f; }
        const float* Cg = UC + (size_t)it * 16384 + eq * 32;
#pragma nounroll
        for (int d = 0; d < 128; ++d) { const float qv = A0[t * P + d]; qn += qv * sg[384 + d];
#pragma unroll
            for (int j = 0; j < 32; ++j) sreg[j] += qv * A1[(4 * j + eq) * P + d]; }
#pragma nounroll
        for (int d = 0; d < 128; ++d) { const float qv = A0[t * P + d];
#pragma unroll
            for (int j = 0; j < 8; ++j) { const f32x4 cc = *(const f32x4*)(Cg + d * 128 + 4 * j); acc2[4 * j] += qv * cc.x; acc2[4 * j + 1] += qv * cc.y; acc2[4 * j + 2] += qv * cc.z; acc2[4 * j + 3] += qv * cc.w; } }
        __syncthreads();
#pragma unroll
        for (int j = 0; j < 32; ++j) { const int s = 4 * j + eq; A0[t * P + s] = (s <= t) ? sreg[j] * fexp(bt + sg[128 + s] - mt) : 0.f; }
        for (int i = 0; i < 32; ++i) { const int e = F.tid + 512 * i, s = e >> 7, d = e & 127; A1[s * 128 + d] = bf2f(MLV[(row0 + s) * 512 + h * 128 + d]); }
        __syncthreads();
        float num[32]; float den = 0.f;
#pragma unroll
        for (int j = 0; j < 32; ++j) num[j] = 0.f;
#pragma nounroll
        for (int s = 0; s < 128; ++s) { const float p = A0[t * P + s]; den += p;
#pragma unroll
            for (int j = 0; j < 8; ++j) { const f32x4 vv = *(const LAS f32x4*)(A1 + s * 128 + eq * 32 + 4 * j); num[4 * j] += p * vv.x; num[4 * j + 1] += p * vv.y; num[4 * j + 2] += p * vv.z; num[4 * j + 3] += p * vv.w; } }
        den += w_inter * qn;
        const float rden = 1.f / fmaxf(fabsf(den), fexp(-mt));
        { const size_t o = (row0 + t) * 512 + h * 128 + eq * 32;
#pragma unroll
          for (int j = 0; j < 4; ++j) { const v4u og = *(const v4u*)(MLO + o + 8 * j); float y[8];
#pragma unroll
              for (int i = 0; i < 8; ++i) y[i] = (num[8 * j + i] + w_inter * acc2[8 * j + i]) * rden;
              v4u r; r.x = pk2(bflo(og.x) * y[0], bfhi(og.x) * y[1]); r.y = pk2(bflo(og.y) * y[2], bfhi(og.y) * y[3]); r.z = pk2(bflo(og.z) * y[4], bfhi(og.z) * y[5]); r.w = pk2(bflo(og.w) * y[6], bfhi(og.w) * y[7]);
              *(v4u*)(MLV + o + 8 * j) = r; } }
    }
    __syncthreads();
}

__device__ __forceinline__ void ln1_route(const Frame& F, const Args& args, int l) {
    const float* lng = inptr(F, 12) + (size_t)l * D; const float* lnb = inptr(F, 13) + (size_t)l * D;
    const float* wgrp = inptr(F, 14) + (size_t)l * D * 4; const float* bgrp = inptr(F, 15) + (size_t)l * 4;
    const float* brt = inptr(F, 17) + (size_t)l * NEXP;
    float* tokg = (float*)(F.ws + WS_TOKG); int* ent2 = (int*)(F.ws + WS_ENT2);
    unsigned* cnt = (unsigned*)(F.ctl + CW_CNT + l * 64 + F.cpass);
    LAS float* wl = (LAS float*)F.lds;
    LAS unsigned* lcnt = (LAS unsigned*)(F.lds + XTRA_OFF);
    LAS int* rec = (LAS int*)(F.lds + XTRA_OFF + 256);
    { const f32x4* src = (const f32x4*)(F.ws + WS_WRT);
#pragma unroll
      for (int i = 0; i < 16; ++i) *(LAS f32x4*)(wl + 4 * (F.tid + NTHR * i)) = src[F.tid + NTHR * i]; }
    if (F.tid < 64) lcnt[F.tid] = 0u;
    const int gw = F.bid * NWAVES + F.wave, NGW = F.G * NWAVES;
    f32x4 gv[4], bv[4], wg[4][4];
#pragma unroll
    for (int j = 0; j < 4; ++j) { gv[j] = *(const f32x4*)(lng + 4 * F.lane + 256 * j); bv[j] = *(const f32x4*)(lnb + 4 * F.lane + 256 * j);
#pragma unroll
        for (int i = 0; i < 4; ++i) wg[j][i] = *(const f32x4*)(wgrp + (size_t)(4 * F.lane + 256 * j + i) * 4); }
    __syncthreads();
    v2u vn[4];
    if (gw < T) {
#pragma unroll
        for (int j = 0; j < 4; ++j) vn[j] = *(const v2u*)(F.XB + (size_t)gw * D + 4 * F.lane + 256 * j); }
    int it = 0;
#pragma nounroll
    for (int row = gw; row < T; row += NGW, ++it) {
        f32x4 v[4]; float s = 0.f; const size_t ro = (size_t)row * D + 4 * F.lane;
#pragma unroll
        for (int j = 0; j < 4; ++j) { v[j] = (f32x4){bflo(vn[j].x), bfhi(vn[j].x), bflo(vn[j].y), bfhi(vn[j].y)}; s += (v[j].x + v[j].y) + (v[j].z + v[j].w); }
        if (row + NGW < T) {
#pragma unroll
            for (int j = 0; j < 4; ++j) vn[j] = *(const v2u*)(F.XB + ro + (size_t)NGW * D + 256 * j); }
        const float mean = wave_sum(s) * (1.f / D); float s2 = 0.f;
#pragma unroll
        for (int j = 0; j < 4; ++j) { v[j] = v[j] - mean; s2 += (v[j].x * v[j].x + v[j].y * v[j].y) + (v[j].z * v[j].z + v[j].w * v[j].w); }
        const float rstd = 1.f / sqrtf(wave_sum(s2) * (1.f / D) + LN_EPS);
#pragma unroll
        for (int j = 0; j < 4; ++j) { v[j] = v[j] * rstd * gv[j] + bv[j];
            v2u o; o.x = pk2(v[j].x, v[j].y); o.y = pk2(v[j].z, v[j].w); *(v2u*)(F.XB + ro + 256 * j) = o;
            *(unsigned*)(F.ws + WS_XB8 + ro + 256 * j) = f8pk4(v[j].x, v[j].y, v[j].z, v[j].w); }
#if defined(EXPT) && EXPT == 1
        if (F.cpass == 0) continue;
#endif
        float lg[4] = {0.f, 0.f, 0.f, 0.f};
#pragma unroll
        for (int j = 0; j < 4; ++j)
#pragma unroll
            for (int i = 0; i < 4; ++i) { const f32x4 w = wg[j][i]; const float xv = v[j][i]; lg[0] += xv * w.x; lg[1] += xv * w.y; lg[2] += xv * w.z; lg[3] += xv * w.w; }
#pragma unroll
        for (int c = 0; c < 4; ++c) lg[c] = wave_sum(lg[c]) + bgrp[c];
        int gt = 0; float gm = lg[0];
#pragma unroll
        for (int c = 1; c < 4; ++c) if (lg[c] > gm) { gm = lg[c]; gt = c; }
        float gs = 0.f;
#pragma unroll
        for (int c = 0; c < 4; ++c) gs += fexp(lg[c] - gm);
        const float pgsel = frcp(gs);
        gt = __builtin_amdgcn_readfirstlane(gt);
        float le[8];
#pragma unroll
        for (int c = 0; c < 8; ++c) { float a = 0.f;
#pragma unroll
            for (int j = 0; j < 4; ++j) { const f32x4 w = *(const LAS f32x4*)(wl + (gt * 8 + c) * 1024 + 4 * F.lane + 256 * j); a += (v[j].x * w.x + v[j].y * w.y) + (v[j].z * w.z + v[j].w * w.w); }
            le[c] = wave_sum(a) + brt[gt * 8 + c]; if (c == 3) asm volatile("" ::: "memory"); }
        int i0 = 0; float m0 = le[0];
#pragma unroll
        for (int c = 1; c < 8; ++c) if (le[c] > m0) { m0 = le[c]; i0 = c; }
        int i1 = (i0 == 0) ? 1 : 0; float m1 = -INFINITY;
#pragma unroll
        for (int c = 0; c < 8; ++c) if (c != i0 && le[c] > m1) { m1 = le[c]; i1 = c; }
        float one_ = 1.f; asm volatile("" : "+v"(one_));
        const float e1 = fexp(m1 - m0), inv = frcp(one_ + e1);
        if (F.lane == 0) {
            const int ex0 = gt * 8 + i0, ex1 = gt * 8 + i1;
            const unsigned p0 = __hip_atomic_fetch_add(lcnt + ex0, 1u, __ATOMIC_RELAXED, __HIP_MEMORY_SCOPE_WORKGROUP), p1 = __hip_atomic_fetch_add(lcnt + ex1, 1u, __ATOMIC_RELAXED, __HIP_MEMORY_SCOPE_WORKGROUP);
            LAS int* r = rec + (F.wave * 16 + it) * 4; r[0] = row; r[1] = ex0 | (ex1 << 8); r[2] = (int)p0; r[3] = (int)p1;
            tokg[2 * row] = pgsel * inv; tokg[2 * row + 1] = pgsel * e1 * inv; }
    }
    __syncthreads();
    if (F.tid < 32) { const unsigned c = lcnt[F.tid]; lcnt[32 + F.tid] = c ? __hip_atomic_fetch_add(cnt + F.tid, c, RLX_AGENT) : 0u; }
    __syncthreads();
    if (F.lane < it) { const LAS int* r = rec + (F.wave * 16 + F.lane) * 4; const int row = r[0], ex0 = r[1] & 255, ex1 = r[1] >> 8;
        ent2[(size_t)ex0 * 32768 + lcnt[32 + ex0] + r[2]] = 2 * row; ent2[(size_t)ex1 * 32768 + lcnt[32 + ex1] + r[3]] = 2 * row + 1; }
    __syncthreads();
}

__device__ __forceinline__ void moe_tiles(const Frame& F, int l, LAS int* pst, LAS int* cntl, LAS int* tile_e) {
    __syncthreads();
    if (F.tid < NEXP) { const unsigned* cnt = (const unsigned*)(F.ctl + CW_CNT + l * 64 + F.cpass); cntl[F.tid] = (int)__hip_atomic_load(cnt + F.tid, RLX_AGENT); }
    __syncthreads();
    if (F.tid == 0) { int run = 0;
#pragma nounroll
        for (int e = 0; e < NEXP; ++e) { pst[e] = run; run += (cntl[e] + 255) >> 8; }
        pst[NEXP] = run; }
    __syncthreads();
    const int total = pst[NEXP];
    for (int t = F.tid; t < total; t += NTHR) { int e = 0;
#pragma nounroll
        for (int q = 1; q < NEXP; ++q) e += (pst[q] <= t) ? 1 : 0;
        tile_e[t] = e; }
    __syncthreads();
}

namespace mx {
typedef float f32x16 __attribute__((ext_vector_type(16)));
typedef short s16x4 __attribute__((ext_vector_type(4)));
typedef short v4i16_t __attribute__((ext_vector_type(4)));
constexpr int LP = 136;
constexpr int IMG = 128 * LP * 2;
#define MX_MFMA(a, b, c) __builtin_amdgcn_mfma_f32_32x32x16_bf16(a, b, c, 0, 0, 0)
__device__ __forceinline__ int crow(int r, int hi) { return (r & 3) + 8 * (r >> 2) + 4 * hi; }
__device__ __forceinline__ bf16x8 frag_row(const LAS bf16* img, int row0, int k0, int lane) { return *(const LAS bf16x8*)(img + (row0 + (lane & 31)) * LP + k0 + 8 * (lane >> 5)); }
__device__ __forceinline__ s16x4 tr4(const LAS bf16* p) { return __builtin_bit_cast(s16x4, __builtin_amdgcn_ds_read_tr16_b64_v4i16((LAS v4i16_t*)p)); }
__device__ __forceinline__ bf16x8 frag_tr(const LAS bf16* img, int k0, int n0, int lane) {
    const LAS bf16* p = img + (k0 + 8 * (lane >> 5) + ((lane & 15) >> 2)) * LP + n0 + 16 * ((lane >> 4) & 1) + 4 * (lane & 3);
    const s16x4 lo = tr4(p), hi = tr4(p + 4 * LP);
    return (bf16x8){lo[0], lo[1], lo[2], lo[3], hi[0], hi[1], hi[2], hi[3]};
}
__device__ __forceinline__ bf16x8 frag_tr_acc(const LAS bf16* img, int k16, int n0, int lane) {
    const LAS bf16* p = img + (k16 + 4 * (lane >> 5) + ((lane & 15) >> 2)) * LP + n0 + 16 * ((lane >> 4) & 1) + 4 * (lane & 3);
    const s16x4 lo = tr4(p), hi = tr4(p + 8 * LP);
    return (bf16x8){lo[0], lo[1], lo[2], lo[3], hi[0], hi[1], hi[2], hi[3]};
}
__device__ __forceinline__ bf16x8 pack8(const f32x16& x, int s) {
    v4u w; w.x = pg8::cvt_pk_bf16(x[8 * s], x[8 * s + 1]); w.y = pg8::cvt_pk_bf16(x[8 * s + 2], x[8 * s + 3]); w.z = pg8::cvt_pk_bf16(x[8 * s + 4], x[8 * s + 5]); w.w = pg8::cvt_pk_bf16(x[8 * s + 6], x[8 * s + 7]);
    return __builtin_bit_cast(bf16x8, w);
}
__device__ __forceinline__ float swap_add(float v) { auto rr = __builtin_amdgcn_permlane32_swap(__float_as_uint(v), __float_as_uint(v), false, false); return __uint_as_float(rr[0]) + __uint_as_float(rr[1]); }
}

__device__ __forceinline__ void sgu_mfma(const Frame& F, int l) {
    using namespace mx;
    constexpr int VP = 520;
    static_assert(128 * VP * 2 <= SCR_BYTES, "SGU LDS map");
    bf16* SU = seg(F, S_SU); const bf16* SV = seg(F, S_SV);
    const float* lng = inptr(F, 6) + (size_t)l * 512; const float* lnb = inptr(F, 7) + (size_t)l * 512;
    const float* sb = inptr(F, 9) + (size_t)l * 4 * 128;
    const bf16* Wm = (const bf16*)(F.ws + WS_SGUW);
    LAS bf16* Vl = (LAS bf16*)F.lds;
    const int tb = F.wave & 3, ch = F.wave >> 2;
    for (int it = F.bid; it < 256; it += F.G) {
        int lane = F.lane; asm volatile("" : "+v"(lane));
        const int hi = lane >> 5;
        const size_t row0 = (size_t)it * 128;
        const f32x4 g0 = *(const f32x4*)(lng + lane * 8), g1 = *(const f32x4*)(lng + lane * 8 + 4), b0 = *(const f32x4*)(lnb + lane * 8), b1 = *(const f32x4*)(lnb + lane * 8 + 4);
        __syncthreads();
        v4u xr[16];
#pragma unroll
        for (int i = 0; i < 16; ++i) xr[i] = *(const v4u*)(SV + (row0 + F.wave * 16 + i) * 512 + lane * 8);
#pragma unroll
        for (int i = 0; i < 16; ++i) { const v4u x = xr[i];
            const float a0 = bflo(x.x), a1 = bfhi(x.x), a2 = bflo(x.y), a3 = bfhi(x.y), a4 = bflo(x.z), a5 = bfhi(x.z), a6 = bflo(x.w), a7 = bfhi(x.w);
            const float mean = wave_sum(((a0 + a1) + (a2 + a3)) + ((a4 + a5) + (a6 + a7))) * (1.f / 512.f);
            const float d0 = a0 - mean, d1 = a1 - mean, d2 = a2 - mean, d3 = a3 - mean, d4 = a4 - mean, d5 = a5 - mean, d6 = a6 - mean, d7 = a7 - mean;
            const float var = wave_sum(((d0 * d0 + d1 * d1) + (d2 * d2 + d3 * d3)) + ((d4 * d4 + d5 * d5) + (d6 * d6 + d7 * d7))) * (1.f / 512.f);
            const float rstd = 1.f / sqrtf(var + LN_EPS);
            v4u o; o.x = pk2(d0 * rstd * g0.x + b0.x, d1 * rstd * g0.y + b0.y); o.y = pk2(d2 * rstd * g0.z + b0.z, d3 * rstd * g0.w + b0.w);
            o.z = pk2(d4 * rstd * g1.x + b1.x, d5 * rstd * g1.y + b1.y); o.w = pk2(d6 * rstd * g1.z + b1.z, d7 * rstd * g1.w + b1.w);
            *(LAS v4u*)(Vl + (F.wave * 16 + i) * VP + lane * 8) = o; }
        __syncthreads();
#pragma nounroll
        for (int g = 0; g < 4; ++g) {
            f32x16 z0 = {}, z1 = {};
            const bf16* wrow = Wm + (size_t)g * 16384 + (size_t)(32 * tb + (lane & 31)) * 128 + 8 * hi;
            const int lim = 2 * tb + 2;
            bf16x8 af[8];
#pragma unroll
            for (int ks = 0; ks < 8; ++ks) af[ks] = (ks < lim) ? *(const bf16x8*)(wrow + 16 * ks) : (bf16x8){0, 0, 0, 0, 0, 0, 0, 0};
#pragma unroll
            for (int ks = 0; ks < 8; ++ks) { if (ks < lim) {
                const LAS bf16* p = Vl + (16 * ks + 8 * hi + ((lane & 15) >> 2)) * VP + g * 128 + 64 * ch + 16 * ((lane >> 4) & 1) + 4 * (lane & 3);
                const s16x4 l0 = tr4(p), h0 = tr4(p + 4 * VP), l1 = tr4(p + 32), h1 = tr4(p + 4 * VP + 32);
                z0 = MX_MFMA(af[ks], ((bf16x8){l0[0], l0[1], l0[2], l0[3], h0[0], h0[1], h0[2], h0[3]}), z0);
                z1 = MX_MFMA(af[ks], ((bf16x8){l1[0], l1[1], l1[2], l1[3], h1[0], h1[1], h1[2], h1[3]}), z1); } }
#pragma unroll
            for (int r = 0; r < 16; ++r) { const int t = 32 * tb + crow(r, hi); const float bs = sb[g * 128 + t];
                const size_t o = (row0 + t) * 512 + g * 128 + 64 * ch + (lane & 31);
                SU[o] = (bf16)f2bf(bf2f(SU[o]) * (z0[r] + bs)); SU[o + 32] = (bf16)f2bf(bf2f(SU[o + 32]) * (z1[r] + bs)); }
        }
    }
    __syncthreads();
}

__device__ __forceinline__ float scan128_sum(float x, int tid, int lane, LAS float* tmp) {
    float v = x;
#pragma unroll
    for (int o = 1; o < 64; o <<= 1) { const float t = __shfl_up(v, o); if (lane >= o) v += t; }
    if (tid == 63) tmp[0] = v;
    __syncthreads();
    if (tid >= 64 && tid < 128) v += tmp[0];
    return v;
}
__device__ __forceinline__ float scan128_max(float x, int tid, int lane, LAS float* tmp) {
    float v = x;
#pragma unroll
    for (int o = 1; o < 64; o <<= 1) { const float t = __shfl_up(v, o); if (lane >= o) v = fmaxf(v, t); }
    if (tid == 63) tmp[0] = v;
    __syncthreads();
    if (tid >= 64 && tid < 128) v = fmaxf(v, tmp[0]);
    return v;
}
template <bool ROWSCALE>
__device__ __forceinline__ void stage_conv(const Frame& F, LAS bf16* img, const bf16* srcseg, size_t rowb, int c, int h, const float* cw  , float scale, const LAS float* rs) {
    const int c8 = (F.tid & 15) * 8, s0 = (F.tid >> 4) * 4, tt0 = c * 128 + s0;
    f32x4 w0[4], w1[4];
#pragma unroll
    for (int j = 0; j < 4; ++j) { w0[j] = *(const f32x4*)(cw + j * 1024 + c8); w1[j] = *(const f32x4*)(cw + j * 1024 + c8 + 4); }
    v4u x[7];
#pragma unroll
    for (int r = 0; r < 7; ++r) { const int ts = tt0 - 3 + r; x[r] = (ts >= 0) ? *(const v4u*)(srcseg + (rowb + ts) * 512 + h * 128 + c8) : (v4u){0u, 0u, 0u, 0u}; }
#pragma unroll
    for (int i = 0; i < 4; ++i) { float acc[8] = {0.f, 0.f, 0.f, 0.f, 0.f, 0.f, 0.f, 0.f};
#pragma unroll
        for (int j = 0; j < 4; ++j) { const v4u xv = x[i + j];
            acc[0] += w0[j].x * bflo(xv.x); acc[1] += w0[j].y * bfhi(xv.x); acc[2] += w0[j].z * bflo(xv.y); acc[3] += w0[j].w * bfhi(xv.y);
            acc[4] += w1[j].x * bflo(xv.z); acc[5] += w1[j].y * bfhi(xv.z); acc[6] += w1[j].z * bflo(xv.w); acc[7] += w1[j].w * bfhi(xv.w); }
        float sc = scale; if (ROWSCALE) sc *= rs[s0 + i];
        v4u o; o.x = pk2(siluf_(acc[0]) * sc, siluf_(acc[1]) * sc); o.y = pk2(siluf_(acc[2]) * sc, siluf_(acc[3]) * sc); o.z = pk2(siluf_(acc[4]) * sc, siluf_(acc[5]) * sc); o.w = pk2(siluf_(acc[6]) * sc, siluf_(acc[7]) * sc);
        *(LAS v4u*)(img + (s0 + i) * mx::LP + c8) = o; }
}
__device__ __forceinline__ void stage_copy(const Frame& F, LAS bf16* img, const bf16* srcseg, size_t row0, int h) {
#pragma unroll
    for (int i = 0; i < 4; ++i) { const int e = F.tid + NTHR * i, s = e >> 4, c8 = (e & 15) * 8;
        *(LAS v4u*)(img + s * mx::LP + c8) = *(const v4u*)(srcseg + (row0 + s) * 512 + h * 128 + c8); }
}

__device__ __forceinline__ void mlstm_m1_mfma(const Frame& F, int l) {
    using namespace mx;
    const bf16* MLK = seg(F, S_MLK); const bf16* MLV = seg(F, S_MLV);
    const float* cw = inptr(F, 5) + (size_t)l * 4 * 1024;
    const float* mli = (const float*)(F.ws + WS_MLI); const float* mlf = (const float*)(F.ws + WS_MLF);
    float* UC = F.XF; float* NV = (float*)(F.ws + WS_NV); float* MST = (float*)(F.ws + WS_MST);
    LAS bf16* Kl = (LAS bf16*)F.lds; LAS bf16* Vl = (LAS bf16*)(F.lds + IMG);
    LAS float* sg = (LAS float*)(F.lds + 2 * IMG);
    const int lane = F.lane, hi = lane >> 5, db = F.wave & 3, eh = F.wave >> 2;
    for (int it = F.bid; it < 1024; it += F.G) {
        const int bh4 = it >> 5, c = it & 31, b = bh4 >> 2, h = bh4 & 3;
        const size_t rowb = (size_t)b * SEQ, row0 = rowb + c * 128;
        __syncthreads();
        float mg, blast;
        { const bool act = F.tid < 128; const float lf = act ? mlf[(row0 + F.tid) * 4 + h] : 0.f, li = act ? mli[(row0 + F.tid) * 4 + h] : 0.f;
          const float bc = scan128_sum(lf, F.tid, F.lane, sg + 384);
          if (F.tid == 127) sg[385] = bc;
          __syncthreads();
          blast = sg[385];
          const float g = blast - bc + li;
          float gm = act ? g : -INFINITY; gm = wave_max(gm);
          if (F.lane == 0 && F.wave < 2) sg[386 + F.wave] = gm;
          __syncthreads();
          mg = fmaxf(sg[386], sg[387]);
          if (act) sg[256 + F.tid] = fexp(g - mg);
          __syncthreads(); }
        stage_conv<true>(F, Kl, MLK, rowb, c, h, cw + 512 + h * 128, 0.08838834764831845f, sg + 256);
        stage_copy(F, Vl, MLV, row0, h);
        __syncthreads();
        f32x16 u0 = {}, u1 = {};
#pragma unroll
        for (int ks = 0; ks < 8; ++ks) { const bf16x8 a = frag_tr(Kl, 16 * ks, 32 * db, lane);
            u0 = MX_MFMA(a, frag_tr(Vl, 16 * ks, 64 * eh, lane), u0); u1 = MX_MFMA(a, frag_tr(Vl, 16 * ks, 64 * eh + 32, lane), u1); }
        bf16* Uo = (bf16*)UC + (size_t)it * 16384;
#pragma unroll
        for (int r = 0; r < 16; ++r) { const int d = 32 * db + crow(r, hi); Uo[d * 128 + 64 * eh + (lane & 31)] = (bf16)f2bf(u0[r]); Uo[d * 128 + 64 * eh + 32 + (lane & 31)] = (bf16)f2bf(u1[r]); }
        if (F.tid < 128) { float n = 0.f;
#pragma nounroll
            for (int s = 0; s < 128; ++s) n += bf2f(Kl[s * LP + F.tid]); NV[(size_t)it * 128 + F.tid] = n; }
        if (F.tid == 0) { MST[it * 4] = mg; MST[it * 4 + 1] = blast; }
    }
    __syncthreads();
}

__device__ __forceinline__ void mlstm_m3_mfma(const Frame& F, int l) {
    using namespace mx;
    const bf16* MLQ = seg(F, S_MLQ); const bf16* MLK = seg(F, S_MLK); bf16* MLV = seg(F, S_MLV); const bf16* MLO = seg(F, S_MLO);
    const float* cw = inptr(F, 5) + (size_t)l * 4 * 1024;
    const float* mli = (const float*)(F.ws + WS_MLI); const float* mlf = (const float*)(F.ws + WS_MLF);
    const float* UC = (const float*)F.XF; const float* NV = (const float*)(F.ws + WS_NV); const float* MST = (const float*)(F.ws + WS_MST);
    LAS bf16* Ql = (LAS bf16*)F.lds; LAS bf16* Kl = (LAS bf16*)(F.lds + IMG); LAS bf16* Vl = (LAS bf16*)(F.lds + 2 * IMG); LAS bf16* Cl = (LAS bf16*)(F.lds + 3 * IMG);
    LAS float* sg = (LAS float*)(F.lds + 4 * IMG);
    static_assert(4 * IMG + (768 + 256) * 4 <= SCR_BYTES, "M3 LDS map");
    const int qb = F.wave & 3, eh = F.wave >> 2;
    for (int it = F.bid; it < 1024; it += F.G) {
        int lane = F.lane; asm volatile("" : "+v"(lane));
        const int hi = lane >> 5, r32 = lane & 31;
        const int bh4 = it >> 5, c = it & 31, b = bh4 >> 2, h = bh4 & 3;
        const size_t rowb = (size_t)b * SEQ, row0 = rowb + c * 128;
        const float m_in = MST[it * 4 + 2];
        __syncthreads();
#if defined(EXPT) && EXPT == 6
        if (F.cpass != 0)
#endif
        { const bool act = F.tid < 128; const float lf = act ? mlf[(row0 + F.tid) * 4 + h] : 0.f, li = act ? mli[(row0 + F.tid) * 4 + h] : 0.f;
          if (act) sg[512 + F.tid] = NV[(size_t)it * 128 + F.tid];
          const float bc = scan128_sum(lf, F.tid, F.lane, sg + 640);
          const float a = li - bc;
          const float pm = scan128_max(act ? a : -INFINITY, F.tid, F.lane, sg + 641);
          if (act) { const float inter = bc + m_in, mt = fmaxf(inter, bc + pm);
              sg[128 + F.tid] = a; sg[256 + F.tid] = fexp(inter - mt); sg[384 + F.tid] = fexp(-mt); sg[F.tid] = bc - mt; } }
#if defined(EXPT) && EXPT == 7
        if (F.cpass != 0)
#endif
        { stage_conv<false>(F, Ql, MLQ, rowb, c, h, cw + h * 128, 1.f, nullptr);
        stage_conv<false>(F, Kl, MLK, rowb, c, h, cw + 512 + h * 128, 0.08838834764831845f, nullptr); }
        stage_copy(F, Vl, MLV, row0, h);
        { const bf16* Cg = (const bf16*)UC + (size_t)it * 16384;
#pragma unroll
          for (int i = 0; i < 4; ++i) { const int e = F.tid + NTHR * i, d = e >> 4, c8 = (e & 15) * 8; *(LAS v4u*)(Cl + d * LP + c8) = *(const v4u*)(Cg + d * 128 + c8); } }
        __syncthreads();
        const int t = 32 * qb + r32;
        const float btl = sg[t];
        f32x16 o0 = {}, o1 = {}; float den = 0.f;
#pragma nounroll
        for (int j = 0; j <= qb; ++j) {
            f32x16 s = {};
#pragma unroll
            for (int ks = 0; ks < 8; ++ks) s = MX_MFMA(frag_row(Kl, 32 * j, 16 * ks, lane), frag_row(Ql, 32 * qb, 16 * ks, lane), s);
#pragma unroll
            for (int g = 0; g < 4; ++g) { const f32x4 av = *(const LAS f32x4*)(sg + 128 + 32 * j + 8 * g + 4 * hi);
#pragma unroll
                for (int i = 0; i < 4; ++i) { const int kv = 32 * j + 8 * g + 4 * hi + i; const float p = (kv <= t) ? s[4 * g + i] * fexp(btl + av[i]) : 0.f; s[4 * g + i] = p; den += p; } }
#pragma unroll
            for (int k2 = 0; k2 < 2; ++k2) { const bf16x8 pa = pack8(s, k2);
                o0 = MX_MFMA(pa, frag_tr_acc(Vl, 32 * j + 16 * k2, 64 * eh, lane), o0); o1 = MX_MFMA(pa, frag_tr_acc(Vl, 32 * j + 16 * k2, 64 * eh + 32, lane), o1); }
        }
        f32x16 c0 = {}, c1 = {};
#pragma unroll
        for (int ks = 0; ks < 8; ++ks) { const bf16x8 a = frag_row(Ql, 32 * qb, 16 * ks, lane);
            c0 = MX_MFMA(a, frag_tr(Cl, 16 * ks, 64 * eh, lane), c0); c1 = MX_MFMA(a, frag_tr(Cl, 16 * ks, 64 * eh + 32, lane), c1); }
        float qn = 0.f;
#pragma unroll
        for (int i = 0; i < 8; ++i) { const v4u qv = *(const LAS v4u*)(Ql + t * LP + 64 * hi + 8 * i); const LAS float* np = sg + 512 + 64 * hi + 8 * i;
            qn += bflo(qv.x) * np[0] + bfhi(qv.x) * np[1] + bflo(qv.y) * np[2] + bfhi(qv.y) * np[3] + bflo(qv.z) * np[4] + bfhi(qv.z) * np[5] + bflo(qv.w) * np[6] + bfhi(qv.w) * np[7]; }
        den = swap_add(den); qn = swap_add(qn);
        const float dtot = den + sg[256 + t] * qn;
        LAS float* wd = sg + 768 + F.wave * 32;
        if (hi == 0) wd[r32] = 1.f / fmaxf(fabsf(dtot), sg[384 + t]);
        asm volatile("s_waitcnt lgkmcnt(0)" ::: "memory");
#if defined(EXPT) && EXPT == 5
        if (F.cpass != 0)
#endif
#pragma unroll
        for (int r = 0; r < 16; ++r) { const int tl = crow(r, hi), tq = 32 * qb + tl; const float wi = sg[256 + tq], rd = wd[tl];
            const size_t o = (row0 + tq) * 512 + h * 128 + 64 * eh + r32;
            MLV[o] = (bf16)f2bf(bf2f(MLO[o]) * (o0[r] + wi * c0[r]) * rd); MLV[o + 32] = (bf16)f2bf(bf2f(MLO[o + 32]) * (o1[r] + wi * c1[r]) * rd); }
    }
    __syncthreads();
}


using pg8::Unit;
template <int K, int nM, int nN, int RB, int CB> struct SchedPlain {
    static_assert(RB * CB == 32 && nM % RB == 0 && nN % CB == 0, "block shape"); static constexpr bool GATHER = false;
    __device__ __forceinline__ unsigned rowoff(const Unit&, int) const { return 0u; }
    const char* A; const char* B; int G, c;
    __device__ __forceinline__ int ktiles() const { return K / 64; }
    __device__ __forceinline__ int lda() const { return K; }
    __device__ __forceinline__ int ldb() const { return K; }
    __device__ __forceinline__ bool next(int i, Unit& u) const {
        u.ex = 0;
        if (G == 256) { const int x = c & 7, j = c >> 3, bi = 8 * i + x; constexpr int nrb = nM / RB, ncb = nN / CB; if (bi >= nrb * ncb) return false;
            u.pm = (bi % nrb) * RB + (j % RB); u.pn = (bi / nrb) * CB + (j / RB); return true; }
        const int L = i * G + c; if (L >= nM * nN) return false; u.pm = L % nM; u.pn = L / nM; return true; }
    __device__ __forceinline__ const char* aptr(const Unit& u, int t) const { return A + ((size_t)u.pm * 256 * K + (size_t)t * 64) * 2; }
    __device__ __forceinline__ const char* bptr(const Unit& u, int t) const { return B + ((size_t)u.pn * 256 * K + (size_t)t * 64) * 2; }
};
struct SchedInProj {
    static constexpr bool GATHER = false;
    const char* A; const char* B; int G, c;
    __device__ __forceinline__ unsigned rowoff(const Unit&, int) const { return 0u; }
    __device__ __forceinline__ int ktiles() const { return 8; }
    __device__ __forceinline__ int lda() const { return 512; }
    __device__ __forceinline__ int ldb() const { return 512; }
    __device__ __forceinline__ bool next(int i, Unit& u) const {
        u.ex = 0; u.nv = 256;
        if (G == 256) { const int x = c & 7, j = c >> 3; if (i >= 15) return false;
            if (i < 14) { const int bi = 8 * i + x; u.pm = (bi & 15) * 8 + (j & 7); u.pn = (bi >> 4) * 4 + (j >> 3); }
            else { u.pm = x * 16 + (j & 15); u.pn = 28 + (j >> 4); }
            return true; }
        const int L = i * G + c; if (L >= 128 * 30) return false; u.pm = L % 128; u.pn = L / 128; return true; }
    __device__ __forceinline__ const char* aptr(const Unit& u, int t) const { return A + (size_t)u.pm * 256 * 1024 + (size_t)t * 128; }
    __device__ __forceinline__ const char* bptr(const Unit& u, int t) const { return B + (size_t)u.pn * 256 * 1024 + (size_t)t * 128; }
};
struct SchedMerge {
    static constexpr bool GATHER = false;
    __device__ __forceinline__ unsigned rowoff(const Unit&, int) const { return 0u; }
    const char* H0; const char* B; int G, c;
    __device__ __forceinline__ int ktiles() const { return 24; }
    __device__ __forceinline__ int lda() const { return 512; }
    __device__ __forceinline__ int ldb() const { return 1536; }
    __device__ __forceinline__ bool next(int i, Unit& u) const { u.ex = 0;
        if (G == 256) { const int x = c & 7, j = c >> 3, bi = 8 * i + x; if (bi >= 16) return false; u.pm = bi * 8 + (j & 7); u.pn = j >> 3; return true; }
        const int L = i * G + c; if (L >= 128 * 4) return false; u.pm = L >> 2; u.pn = L & 3; return true; }
    __device__ __forceinline__ const char* aptr(const Unit& u, int t) const { const int s = t >> 3; return H0 + ((size_t)(5 * s - 3 * (s >> 1)) * SEGE + (size_t)u.pm * 256 * 512 + (size_t)(t & 7) * 64) * 2; }
    __device__ __forceinline__ const char* bptr(const Unit& u, int t) const { return B + ((size_t)u.pn * 256 * 1536 + (size_t)t * 64) * 2; }
};
constexpr int MOE_CAP = 32768;
template <int K, int ROWB, bool BYTOK> struct SchedMoe {
    static constexpr bool GATHER = true;
    const char* A; const char* B; const int* ent2; int ntiles; const LAS int* tile_e; const LAS int* pst; const LAS int* cntl; int G, c;
    __device__ __forceinline__ int ktiles() const { return K / 64; }
    __device__ __forceinline__ int lda() const { return K; }
    __device__ __forceinline__ int ldb() const { return K; }
    __device__ __forceinline__ bool next(int i, Unit& u) const {
        int gt;
        if (G == 256) { const int x = c & 7, j = c >> 3; gt = (8 * i + x) * 8 + (j & 7); u.pn = j >> 3; if ((8 * i + x) * 8 >= ntiles) return false; if (gt >= ntiles) gt = ntiles - 1; }
        else { const int L = i * G + c; if (L >= ntiles * 4) return false; gt = L >> 2; u.pn = L & 3; }
        u.gt = gt; u.ex = __builtin_amdgcn_readfirstlane(tile_e[gt]); u.pm = gt - __builtin_amdgcn_readfirstlane(pst[u.ex]);
        const int left = __builtin_amdgcn_readfirstlane(cntl[u.ex]) - 256 * u.pm; u.nv = left < 256 ? left : 256; return true; }
    __device__ __forceinline__ const char* aptr(const Unit&, int t) const { return A + (size_t)t * 128; }
    __device__ __forceinline__ const char* bptr(const Unit& u, int t) const { return B + (((size_t)u.ex * 1024 + (size_t)u.pn * 256) * K + (size_t)t * 64) * 2; }
    __device__ __forceinline__ unsigned rowoff(const Unit& u, int r) const {
        const int rc = r < u.nv ? r : u.nv - 1;
        const int slot = ent2[(size_t)u.ex * MOE_CAP + 256 * u.pm + rc]; return (unsigned)(BYTOK ? (slot >> 1) : slot) * (unsigned)ROWB; }
};

struct SchedMoe1 {
    static constexpr bool GATHER = true;
    const char* A; const char* B; const int* ent2; int ntiles; const LAS int* tile_e; const LAS int* pst; const LAS int* cntl; int G, c;
    __device__ __forceinline__ int ktiles() const { return 8; }
    __device__ __forceinline__ int lda() const { return 512; }
    __device__ __forceinline__ int ldb() const { return 512; }
    __device__ __forceinline__ bool next(int i, Unit& u) const {
        int gt;
        if (G == 256) { const int x = c & 7, j = c >> 3; gt = (8 * i + x) * 8 + (j & 7); u.pn = j >> 3; if ((8 * i + x) * 8 >= ntiles) return false; if (gt >= ntiles) gt = ntiles - 1; }
        else { const int L = i * G + c; if (L >= ntiles * 4) return false; gt = L >> 2; u.pn = L & 3; }
        u.gt = gt; u.ex = __builtin_amdgcn_readfirstlane(tile_e[gt]); u.pm = gt - __builtin_amdgcn_readfirstlane(pst[u.ex]);
        const int left = __builtin_amdgcn_readfirstlane(cntl[u.ex]) - 256 * u.pm; u.nv = left < 256 ? left : 256; return true; }
    __device__ __forceinline__ const char* aptr(const Unit&, int t) const { return A + (size_t)t * 128; }
    __device__ __forceinline__ const char* bptr(const Unit& u, int t) const { return B + ((size_t)u.ex * 1024 + (size_t)u.pn * 256) * 1024 + (size_t)t * 128; }
    __device__ __forceinline__ unsigned rowoff(const Unit& u, int r) const {
        const int rc = r < u.nv ? r : u.nv - 1;
        const int slot = ent2[(size_t)u.ex * MOE_CAP + 256 * u.pm + rc]; return (unsigned)(slot >> 1) * 1024u; }
};
struct SchedMoe2 {
    static constexpr bool GATHER = false;
    const char* A; const char* B; int ntiles; const LAS int* tile_e; const LAS int* pst; const LAS int* cntl; int G, c;
    __device__ __forceinline__ unsigned rowoff(const Unit&, int) const { return 0u; }
    __device__ __forceinline__ int ktiles() const { return 4; }
    __device__ __forceinline__ int lda() const { return 256; }
    __device__ __forceinline__ int ldb() const { return 256; }
    __device__ __forceinline__ bool next(int i, Unit& u) const {
        int gt;
        if (G == 256) { const int x = c & 7, j = c >> 3; gt = (8 * i + x) * 8 + (j & 7); u.pn = j >> 3; if ((8 * i + x) * 8 >= ntiles) return false; if (gt >= ntiles) gt = ntiles - 1; }
        else { const int L = i * G + c; if (L >= ntiles * 4) return false; gt = L >> 2; u.pn = L & 3; }
        u.gt = gt; u.ex = __builtin_amdgcn_readfirstlane(tile_e[gt]); u.pm = gt - __builtin_amdgcn_readfirstlane(pst[u.ex]);
        const int left = __builtin_amdgcn_readfirstlane(cntl[u.ex]) - 256 * u.pm; u.nv = left < 256 ? left : 256; return true; }
    __device__ __forceinline__ const char* aptr(const Unit& u, int t) const { return A + (size_t)u.gt * 256 * 512 + (size_t)t * 128; }
    __device__ __forceinline__ const char* bptr(const Unit& u, int t) const { return B + ((size_t)u.ex * 1024 + (size_t)u.pn * 256) * 512 + (size_t)t * 128; }
};

typedef pg8::f32x4 (AccT)[2][2][4][2];
__device__ __forceinline__ void st16_wt(void* p, v4u v) { asm volatile("global_store_dwordx4 %0, %1, off sc1\n\ts_nop 1" :: "v"(p), "v"(v) : "memory"); }
__device__ __forceinline__ void st8_wt(void* p, v2u v) { asm volatile("global_store_dwordx2 %0, %1, off sc1\n\ts_nop 1" :: "v"(p), "v"(v) : "memory"); }
__device__ __forceinline__ unsigned char* gate_tile(bf16* H, int pm, int gt) { return (unsigned char*)(H + (size_t)S_G0 * SEGE) + ((size_t)(gt >> 2) * 128 * 4 + (size_t)pm * 4 + (gt & 3)) * 65536; }
__device__ __forceinline__ unsigned gate_q(float g) { const float q = fmaxf(__builtin_rintf(g * 255.f), 1.f); return (unsigned)q; }
struct EpiInProj {
    static constexpr bool PERM = true, HAS_MID = false, F8 = false, I8 = true; static constexpr int SEG = 0;
    bf16* H; const float* bias; const float* sA; const unsigned* cmax;
    __device__ __forceinline__ void mid(AccT&, const Unit&, int, int, int, int, int) const {}
    __device__ __forceinline__ void operator()(AccT& acc, const Unit& u, int wr, int wc, int fr, int fq) const {
        asm volatile("" : "+v"(fr), "+v"(fq));
        const int sg = u.pn >> 1; bf16* base = H + (size_t)sg * SEGE;
        const int act = (sg == S_Q) ? 1 : ((sg == S_MLO || sg >= S_G0) ? 2 : ((sg == S_SU || sg == S_SV) ? 3 : 0));
        const int row0 = u.pm * 256 + wr * 64 + fr, col0 = (u.pn & 1) * 256 + wc * 32 + 8 * fq, bcol0 = u.pn * 256 + wc * 32 + 8 * fq;
        const int tid8 = (((wr * 4 + wc) * 64) + fq * 16 + fr) * 8;
        f32x4 bv[2][2], sw[2][2];
#pragma unroll
        for (int bj = 0; bj < 2; ++bj)
#pragma unroll
            for (int n = 0; n < 2; ++n) { bv[bj][n] = *(const f32x4*)(bias + bcol0 + bj * 128 + 4 * n); { const float c0 = __builtin_bit_cast(float, cmax[(bcol0 + bj * 128) >> 5]) * (1.f / 127.f); sw[bj][n] = (f32x4){c0, c0, c0, c0}; }
            }
#pragma unroll
        for (int ai = 0; ai < 2; ++ai)
#pragma unroll
            for (int m = 0; m < 4; ++m) { const int row = row0 + ai * 128 + m * 16; bf16* rowp = base + (size_t)row * 512 + col0; const float sa = sA[row];
#pragma unroll
                for (int bj = 0; bj < 2; ++bj) { const pg8::i32x4 i0 = __builtin_bit_cast(pg8::i32x4, acc[ai][bj][m][0]), i1 = __builtin_bit_cast(pg8::i32x4, acc[ai][bj][m][1]); f32x4 v0, v1;
#pragma unroll
                    for (int i = 0; i < 4; ++i) { v0[i] = (float)i0[i] * (sa * sw[bj][0][i]) + bv[bj][0][i]; v1[i] = (float)i1[i] * (sa * sw[bj][1][i]) + bv[bj][1][i]; }
                    if (act == 1) { v0 = v0 * QSCALE; v1 = v1 * QSCALE; }
                    else if (act == 2) {
#pragma unroll
                        for (int i = 0; i < 4; ++i) { v0[i] = sigmoidf_(v0[i]); v1[i] = sigmoidf_(v1[i]); } }
                    else if (act == 3) {
#pragma unroll
                        for (int i = 0; i < 4; ++i) { v0[i] = gelu_tanh(v0[i]); v1[i] = gelu_tanh(v1[i]); } }
                    v4u w; w.x = pg8::cvt_pk_bf16(v0[0], v0[1]); w.y = pg8::cvt_pk_bf16(v0[2], v0[3]); w.z = pg8::cvt_pk_bf16(v1[0], v1[1]); w.w = pg8::cvt_pk_bf16(v1[2], v1[3]);
                    if (sg >= S_G0) { v2u q; q.x = gate_q(v0[0]) | (gate_q(v0[1]) << 8) | (gate_q(v0[2]) << 16) | (gate_q(v0[3]) << 24); q.y = gate_q(v1[0]) | (gate_q(v1[1]) << 8) | (gate_q(v1[2]) << 16) | (gate_q(v1[3]) << 24);
                        st8_wt(gate_tile(H, u.pm, u.pn - 2 * S_G0) + (size_t)(((ai * 4 + m) * 2 + bj) * 4096 + tid8), q); }
                    else st16_wt(rowp + bj * 128, w); } }
    }
};
struct EpiMerge {
    static constexpr bool PERM = true, HAS_MID = true, F8 = false, I8 = false;
    bf16* Hb;
    bf16* O;
    template <int MODE>
    __device__ __forceinline__ void scale(AccT& acc, const Unit& u, int n, int wr, int wc, int fr, int fq) const {
        const int tid8 = (((wr * 4 + wc) * 64) + fq * 16 + fr) * 8;
        const unsigned char* g0 = gate_tile(Hb, u.pm, n * 4 + u.pn) + tid8; const unsigned char* g1 = gate_tile(Hb, u.pm, (MODE == 0 ? n + 1 : n) * 4 + u.pn) + tid8;
#pragma unroll
        for (int ai = 0; ai < 2; ++ai)
#pragma unroll
            for (int m = 0; m < 4; ++m) {
#pragma unroll
                for (int bj = 0; bj < 2; ++bj) { const int fo = ((ai * 4 + m) * 2 + bj) * 4096; const v2u a = *(const v2u*)(g0 + fo);
                    float r[8] = {(float)(a.x & 255u), (float)((a.x >> 8) & 255u), (float)((a.x >> 16) & 255u), (float)(a.x >> 24), (float)(a.y & 255u), (float)((a.y >> 8) & 255u), (float)((a.y >> 16) & 255u), (float)(a.y >> 24)};
                    if (MODE == 0) { const v2u b = *(const v2u*)(g1 + fo);
                        const float d[8] = {(float)(b.x & 255u), (float)((b.x >> 8) & 255u), (float)((b.x >> 16) & 255u), (float)(b.x >> 24), (float)(b.y & 255u), (float)((b.y >> 8) & 255u), (float)((b.y >> 16) & 255u), (float)(b.y >> 24)};
#pragma unroll
                        for (int i = 0; i < 8; ++i) r[i] = r[i] * frcp(fmaxf(d[i], 1.f)); }
                    else {
#pragma unroll
                        for (int i = 0; i < 8; ++i) r[i] *= (1.f / 255.f); }
#pragma unroll
                    for (int i = 0; i < 4; ++i) { acc[ai][bj][m][0][i] *= r[i]; acc[ai][bj][m][1][i] *= r[4 + i]; } } }
    }
    static constexpr int SEG = 8;
    __device__ __forceinline__ void mid(AccT& acc, const Unit& u, int t, int wr, int wc, int fr, int fq) const { scale<0>(acc, u, (t >> 3) - 1, wr, wc, fr, fq); }
    __device__ __forceinline__ void operator()(AccT& acc, const Unit& u, int wr, int wc, int fr, int fq) const {
        scale<1>(acc, u, 2, wr, wc, fr, fq);
        const int row0 = u.pm * 256 + wr * 64 + fr, col0 = u.pn * 256 + wc * 32 + 8 * fq;
#pragma unroll
        for (int ai = 0; ai < 2; ++ai)
#pragma unroll
            for (int m = 0; m < 4; ++m) { bf16* rowp = O + (size_t)(row0 + ai * 128 + m * 16) * 1024 + col0;
#pragma unroll
                for (int bj = 0; bj < 2; ++bj) { const f32x4 v0 = acc[ai][bj][m][0], v1 = acc[ai][bj][m][1];
                    v4u w; w.x = pg8::cvt_pk_bf16(v0[0], v0[1]); w.y = pg8::cvt_pk_bf16(v0[2], v0[3]); w.z = pg8::cvt_pk_bf16(v1[0], v1[1]); w.w = pg8::cvt_pk_bf16(v1[2], v1[3]);
                    *(v4u*)(rowp + bj * 128) = w; } }
    }
};
struct EpiWout {
    static constexpr bool PERM = true, HAS_MID = false, F8 = false, I8 = false; static constexpr int SEG = 0;
    bf16* XB;
    __device__ __forceinline__ void mid(AccT&, const Unit&, int, int, int, int, int) const {}
    __device__ __forceinline__ void operator()(AccT& acc, const Unit& u, int wr, int wc, int fr, int fq) const {
        const int row0 = u.pm * 256 + wr * 64 + fr, col0 = u.pn * 256 + wc * 32 + 8 * fq;
#pragma unroll
        for (int ai = 0; ai < 2; ++ai)
#pragma unroll
            for (int m = 0; m < 4; ++m) { bf16* rowp = XB + (size_t)(row0 + ai * 128 + m * 16) * 1024 + col0;
#pragma unroll
                for (int bj = 0; bj < 2; ++bj) { const v4u x = *(const v4u*)(rowp + bj * 128); const f32x4 v0 = acc[ai][bj][m][0], v1 = acc[ai][bj][m][1];
                    v4u w; w.x = pg8::cvt_pk_bf16(ALPHA * bflo(x.x) + v0[0], ALPHA * bfhi(x.x) + v0[1]); w.y = pg8::cvt_pk_bf16(ALPHA * bflo(x.y) + v0[2], ALPHA * bfhi(x.y) + v0[3]);
                    w.z = pg8::cvt_pk_bf16(ALPHA * bflo(x.z) + v1[0], ALPHA * bfhi(x.z) + v1[1]); w.w = pg8::cvt_pk_bf16(ALPHA * bflo(x.w) + v1[2], ALPHA * bfhi(x.w) + v1[3]);
                    *(v4u*)(rowp + bj * 128) = w; } }
    }
};
constexpr float HSCALE = 8.f;
__device__ __forceinline__ unsigned f8pk4s(float a, float b, float c, float d, float sc) { int w = 0; w = __builtin_amdgcn_cvt_pk_fp8_f32(f8clamp(a * sc), f8clamp(b * sc), w, false); w = __builtin_amdgcn_cvt_pk_fp8_f32(f8clamp(c * sc), f8clamp(d * sc), w, true); return (unsigned)w; }
struct EpiMoe1 {
    static constexpr bool PERM = true, HAS_MID = false, F8 = true, I8 = false; static constexpr int SEG = 0;
    unsigned char* HID;
    __device__ __forceinline__ void mid(AccT&, const Unit&, int, int, int, int, int) const {}
    __device__ __forceinline__ void operator()(AccT& acc, const Unit& u, int wr, int wc, int fr, int fq) const {
        asm volatile("" : "+v"(fr), "+v"(fq));
        const int r0 = wr * 64 + fr, col0 = u.pn * 128 + wc * 32 + 8 * fq; unsigned char* tp = HID + (size_t)u.gt * 256 * 512 + col0;
#pragma unroll
        for (int ai = 0; ai < 2; ++ai)
#pragma unroll
            for (int m = 0; m < 4; ++m) { const int r = r0 + ai * 128 + m * 16;
                if (r < u.nv) { float h[8];
#pragma unroll
                    for (int i = 0; i < 4; ++i) { h[i] = siluf_(acc[ai][0][m][0][i] * W8INV) * acc[ai][1][m][0][i]; h[4 + i] = siluf_(acc[ai][0][m][1][i] * W8INV) * acc[ai][1][m][1][i]; }
                    v2u w; w.x = f8pk4s(h[0], h[1], h[2], h[3], W8INV * HSCALE); w.y = f8pk4s(h[4], h[5], h[6], h[7], W8INV * HSCALE);
                    *(v2u*)(tp + (size_t)r * 512) = w; }
                asm volatile("" ::: "memory"); }
    }
};
constexpr float YSCALE = 16.f, YINV = 1.f / 16.f;
struct EpiMoe2 {
    static constexpr bool PERM = true, HAS_MID = false, F8 = true, I8 = false; static constexpr int SEG = 0;
    unsigned char* Y; const int* ent2;
    __device__ __forceinline__ void mid(AccT&, const Unit&, int, int, int, int, int) const {}
    __device__ __forceinline__ void operator()(AccT& acc, const Unit& u, int wr, int wc, int fr, int fq) const {
        asm volatile("" : "+v"(fr), "+v"(fq));
        const int r0 = wr * 64 + fr, col0 = u.pn * 256 + wc * 32 + 8 * fq; const int* ep = ent2 + (size_t)u.ex * MOE_CAP + 256 * u.pm;
        constexpr float sc = YSCALE / (W8SCALE * HSCALE);
#pragma unroll
        for (int ai = 0; ai < 2; ++ai)
#pragma unroll
            for (int m = 0; m < 4; ++m) { const int r = r0 + ai * 128 + m * 16;
                if (r < u.nv) { unsigned char* rowp = Y + (size_t)ep[r] * 1024 + col0;
#pragma unroll
                    for (int bj = 0; bj < 2; ++bj) { const f32x4 v0 = acc[ai][bj][m][0], v1 = acc[ai][bj][m][1];
                        v2u w; w.x = f8pk4s(v0[0], v0[1], v0[2], v0[3], sc); w.y = f8pk4s(v1[0], v1[1], v1[2], v1[3], sc);
                        *(v2u*)(rowp + bj * 128) = w; } }
                asm volatile("" ::: "memory"); }
    }
};

#include <hip/hip_bf16.h>
#include <cmath>
namespace attn_body {
using bf16=__hip_bfloat16;
using bf16x8=__attribute__((ext_vector_type(8)))short;
using s16x4=__attribute__((ext_vector_type(4)))short;
using f32x16=__attribute__((ext_vector_type(16)))float;
using u32x4=__attribute__((ext_vector_type(4)))unsigned;
constexpr int BATCH=8,NHEAD=8,SEQ=4096,D=64,DM=NHEAD*D;
constexpr int NW=8,QBLK=32,QB=QBLK*NW,KVBLK=64,NQB=SEQ/QB;
constexpr int ATTN_PITCH=DM, ATTN_UNIT_ROWS=QB;
__device__ __forceinline__ int crow(int r,int hi){return (r&3)+8*(r>>2)+4*hi;}
#define SBAR() __builtin_amdgcn_sched_barrier(0)
__device__ __forceinline__ void cmask(f32x16&p0,f32x16&p1,int jb,int qrel,int hi){
  const float NEG=-INFINITY; int kb=64*jb+4*hi;
  #pragma unroll
  for(int r=0;r<16;++r){int kv=kb+(r&3)+8*(r>>2); if(kv>qrel)p0[r]=NEG; if(kv+32>qrel)p1[r]=NEG;}
}

constexpr int NSLOT=3, SLOTB=8192;
constexpr int LDS_K=0, LDS_V=NSLOT*SLOTB, LDS_WS=2*NSLOT*SLOTB, LDS_OST=LDS_WS+NW*64*4, LDS_BYTES=LDS_OST+NW*4096;
constexpr float C2=0.125f*1.4426950408889634f;
__device__ __forceinline__ void glds16(const void*gsrc,unsigned lds_dst){unsigned keep;
  asm volatile("s_mov_b32 %0, m0\n\ts_mov_b32 m0, %2\n\ts_nop 0\n\tglobal_load_lds_dwordx4 %1, off\n\ts_mov_b32 m0, %0":"=&s"(keep):"v"(gsrc),"s"(lds_dst):"memory");}
__device__ __forceinline__ float max3f(float a,float b,float c){float r;asm("v_max3_f32 %0, %1, %2, %3":"=v"(r):"v"(a),"v"(b),"v"(c));return r;}
__device__ __forceinline__ float max2f(float a,float b){float r;asm("v_max_f32_e32 %0, %1, %2":"=v"(r):"v"(a),"v"(b));return r;}
__device__ __forceinline__ float fadd_s(float a,float b){float r;asm("v_add_f32_e32 %0, %1, %2":"=v"(r):"v"(a),"v"(b));return r;}
__device__ __forceinline__ float fsub_s(float a,float b){float r;asm("v_sub_f32_e32 %0, %1, %2":"=v"(r):"v"(a),"v"(b));return r;}
typedef float f32x2_t __attribute__((ext_vector_type(2))); typedef float f32x4_t __attribute__((ext_vector_type(4))); typedef __bf16 bf16x2_t __attribute__((ext_vector_type(2)));
__device__ __forceinline__ unsigned cvtpk_s(float lo,float hi){f32x2_t v={lo,hi};bf16x2_t b=__builtin_convertvector(v,bf16x2_t);return __builtin_bit_cast(unsigned,b);}
#define WAIT_BAR(N) asm volatile("s_waitcnt vmcnt(" #N ") lgkmcnt(0)\n\ts_barrier":::"memory")

__device__ __forceinline__ void qkt(f32x16&p0,f32x16&p1,const char*Kslot,const bf16x8*qr,int r32,int hi){
  const char*kb=Kslot+hi*1024+r32*16;
  #pragma unroll
  for(int d0=0;d0<4;++d0){
    const bf16x8 b0=*reinterpret_cast<const bf16x8*>(kb+d0*2048);
    const bf16x8 b1=*reinterpret_cast<const bf16x8*>(kb+d0*2048+512);
    p0=__builtin_amdgcn_mfma_f32_32x32x16_bf16(b0,qr[d0],p0,0,0,0);p1=__builtin_amdgcn_mfma_f32_32x32x16_bf16(b1,qr[d0],p1,0,0,0);}
}
typedef __attribute__((address_space(3))) const char* lds_cptr;
typedef short v4i16_t __attribute__((ext_vector_type(4)));
__device__ __forceinline__ void kload8(bf16x8*kf,lds_cptr kp){
  kf[0]=*(const __attribute__((address_space(3))) bf16x8*)(kp);      kf[1]=*(const __attribute__((address_space(3))) bf16x8*)(kp+512);
  kf[2]=*(const __attribute__((address_space(3))) bf16x8*)(kp+2048); kf[3]=*(const __attribute__((address_space(3))) bf16x8*)(kp+2560);
  kf[4]=*(const __attribute__((address_space(3))) bf16x8*)(kp+4096); kf[5]=*(const __attribute__((address_space(3))) bf16x8*)(kp+4608);
  kf[6]=*(const __attribute__((address_space(3))) bf16x8*)(kp+6144); kf[7]=*(const __attribute__((address_space(3))) bf16x8*)(kp+6656);
}
__device__ __forceinline__ void kload2(bf16x8*kf,lds_cptr kp,int j){ kf[2*j]=*(const __attribute__((address_space(3))) bf16x8*)(kp+j*2048); kf[2*j+1]=*(const __attribute__((address_space(3))) bf16x8*)(kp+j*2048+512); }
__device__ __forceinline__ s16x4 vtr(lds_cptr p){ return __builtin_bit_cast(s16x4,__builtin_amdgcn_ds_read_tr16_b64_v4i16((__attribute__((address_space(3))) v4i16_t*)p)); }
__device__ __forceinline__ float rowmax(const f32x16&p0,const f32x16&p1){
  float a=max3f(p0[0],p0[1],p1[0]),b=max3f(p0[2],p0[3],p1[1]);a=max3f(a,p1[2],p1[3]);
  #pragma unroll
  for(int r=4;r<16;r+=4){a=max3f(a,p0[r],p0[r+1]);b=max3f(b,p0[r+2],p0[r+3]);a=max3f(a,p1[r],p1[r+1]);b=max3f(b,p1[r+2],p1[r+3]);}
  const float m=max2f(a,b);
  auto rr=__builtin_amdgcn_permlane32_swap(__float_as_uint(m),__float_as_uint(m),false,false);
  return max2f(__uint_as_float(rr[0]),__uint_as_float(rr[1]));
}
__device__ __forceinline__ void pv(f32x16*o,int vb,bf16x8 pa0,bf16x8 pa1,bf16x8 pa2,bf16x8 pa3){
  #pragma unroll
  for(int d0=0;d0<2;++d0){s16x4 lo[4],hi[4];
    #pragma unroll
    for(int ks=0;ks<4;++ks){
      asm volatile("ds_read_b64_tr_b16 %0,%1 offset:%c2":"=&v"(lo[ks]):"v"(vb),"i"(d0*4096+ks*1024):"memory");
      asm volatile("ds_read_b64_tr_b16 %0,%1 offset:%c2":"=&v"(hi[ks]):"v"(vb),"i"(d0*4096+ks*1024+512):"memory");}
    asm volatile("s_waitcnt lgkmcnt(0)":::"memory");SBAR();
    #define PK(k) (bf16x8){lo[k][0],lo[k][1],lo[k][2],lo[k][3],hi[k][0],hi[k][1],hi[k][2],hi[k][3]}
    o[d0]=__builtin_amdgcn_mfma_f32_32x32x16_bf16(pa0,PK(0),o[d0],0,0,0);
    o[d0]=__builtin_amdgcn_mfma_f32_32x32x16_bf16(pa1,PK(1),o[d0],0,0,0);
    o[d0]=__builtin_amdgcn_mfma_f32_32x32x16_bf16(pa2,PK(2),o[d0],0,0,0);
    o[d0]=__builtin_amdgcn_mfma_f32_32x32x16_bf16(pa3,PK(3),o[d0],0,0,0);
    #undef PK
  }
}

#ifndef ATTN_STORE16
#define ATTN_STORE16(p,v) asm volatile("global_store_dwordx4 %0, %1, off sc1\n\ts_nop 1" :: "v"(p), "v"(v) : "memory")
#endif
template<int THRL> __device__ __forceinline__ void attn_unit(int tid,int b,int h,int qb,const bf16*Q,const bf16*__restrict__ K,const bf16*__restrict__ V,bf16*O,char*shm,const __attribute__((address_space(3))) float*Fl){
  const int lane=tid&63,r32=lane&31,hi=lane>>5; const int wid=__builtin_amdgcn_readfirstlane(tid>>6);
  const long rowbase=(long)b*SEQ; const int q0=qb*QB;
  const bf16*Qw=Q+(rowbase+q0+wid*QBLK)*DM+h*D;
  const bf16*Kh=K+rowbase*DM+h*D,*Vh=V+rowbase*DM+h*D;
  const unsigned lds0=(unsigned)(uintptr_t)shm;
  float*wsf=(float*)(shm+LDS_WS)+wid*64;
  const bf16*ksrc=Kh+(long)lane*DM+wid*8;
  const bf16*vsrc=Vh+(long)(16*(wid&3)+(lane>>2))*DM+(wid>>2)*32+(lane&3)*8;
  const unsigned kdst=lds0+LDS_K+wid*1024, vdst=lds0+LDS_V+wid*1024;
  #define DMA_K(t,slot) glds16(ksrc+(long)(t)*KVBLK*DM,(unsigned)__builtin_amdgcn_readfirstlane(kdst+(slot)))
  #define DMA_V(t,slot) glds16(vsrc+(long)(t)*KVBLK*DM,(unsigned)__builtin_amdgcn_readfirstlane(vdst+(slot)))
  const int vb0=(int)(lds0+LDS_V)+((lane>>4)&1)*32+(lane&3)*8+(4*hi+((lane&15)>>2))*64;
  const char*Kbase=shm+LDS_K; bf16x8 kf[8];
  const lds_cptr shm3=(lds_cptr)shm; const lds_cptr kp0=shm3+LDS_K+hi*1024+r32*16; const lds_cptr vp0=shm3+LDS_V+((lane>>4)&1)*32+(lane&3)*8+(4*hi+((lane&15)>>2))*64;
  const int NT=(q0+QB)/KVBLK;
  DMA_K(0,0);DMA_V(0,0);DMA_K(1,SLOTB);
  bf16x8 qr[4];
  #pragma unroll
  for(int d0=0;d0<4;++d0)qr[d0]=*reinterpret_cast<const bf16x8*>(&Qw[(long)r32*DM+d0*16+hi*8]);
  const float ftq=Fl[q0+wid*QBLK+r32];
  float mhat=0.f,nm=ftq,l_reg=0.f;f32x16 o[2];o[0]=f32x16{};o[1]=f32x16{};
  #define CINIT(C0,C1,t) do{ const __attribute__((address_space(3))) float*fp_=Fl+(t)*64+4*hi; _Pragma("unroll") for(int g_=0;g_<4;++g_){ const f32x4_t a_=*(const __attribute__((address_space(3))) f32x4_t*)(fp_+8*g_),b_=*(const __attribute__((address_space(3))) f32x4_t*)(fp_+32+8*g_); _Pragma("unroll") for(int i_=0;i_<4;++i_){C0[4*g_+i_]=nm-a_[i_];C1[4*g_+i_]=nm-b_[i_];} } }while(0)
  const int qrel=wid*QBLK+r32;
  #define CMASK(P0,P1,t) do{int jb_=(t)-(NT-4); if(jb_>=0)cmask(P0,P1,jb_,qrel,hi);}while(0)
  bool resc=false;
  #define START(P0,P1) do{ const float rm=rowmax(P0,P1); resc=false; \
    { const float dl=rm; mhat=fadd_s(mhat,dl); \
      _Pragma("unroll") for(int r=0;r<16;++r){P0[r]=fsub_s(P0[r],dl);P1[r]=fsub_s(P1[r],dl);} \
      nm=ftq-mhat; } \
    _Pragma("unroll") for(int r=0;r<16;++r)P0[r]=__builtin_amdgcn_exp2f(P0[r]); }while(0)
  #define RESC() do{ if(resc){ asm volatile("s_waitcnt lgkmcnt(0)":::"memory"); \
      _Pragma("unroll") for(int d_=0;d_<2;++d_) _Pragma("unroll") for(int r=0;r<16;++r)o[d_][r]*=wsf[crow(r,hi)]; } }while(0)
  f32x16 pA0,pA1,pB0,pB1;
  int sl_prev=0,sl_cur=0,sl_next=SLOTB;
  #define ROT() do{sl_prev=sl_cur;sl_cur=sl_next;sl_next=(sl_next==(NSLOT-1)*SLOTB)?0:sl_next+SLOTB;}while(0)
  DMA_K(2,2*SLOTB);
  WAIT_BAR(3);
  CINIT(pA0,pA1,0); qkt(pA0,pA1,Kbase,qr,r32,hi);asm volatile("s_nop 15\n\ts_nop 7":"+v"(pA0),"+v"(pA1));CMASK(pA0,pA1,0);
  START(pA0,pA1);
  _Pragma("unroll") for(int r=0;r<16;++r)pA1[r]=__builtin_amdgcn_exp2f(pA1[r]);
  WAIT_BAR(0);
  DMA_K(3,0);DMA_V(1,SLOTB);
  ROT();
  kload8(kf,kp0+sl_cur);
  WAIT_BAR(2);
  s16x4 vlo[8],vhi[8]; u32x4 pw0,pw1,pw2,pw3;
  #define PKW(P,B) cvtpk_s(P[B],P[B+1])
  #define PAF(k) __builtin_bit_cast(bf16x8,pw##k)
  #define VFR(i) (bf16x8){vlo[i][0],vlo[i][1],vlo[i][2],vlo[i][3],vhi[i][0],vhi[i][1],vhi[i][2],vhi[i][3]}
  #define PIN(x) asm volatile("":"+v"(x))
  #define MX3(a,b,c) __builtin_fmaxf(__builtin_fmaxf((a),(b)),(c))
  #define GAPA(MF,A0,A1,A2,A3,W0,W1,PW) do{ MF; sacc+=A0; sacc+=A1; sacc+=A2; sacc+=A3; PIN(sacc); W0; W1; PIN(PW); SBAR(); }while(0)
  #define EX(v) __builtin_amdgcn_exp2f(v)
  #define GAPB(MF,X,B) do{ MF; X[B]=EX(X[B]); X[B+1]=EX(X[B+1]); X[B+2]=EX(X[B+2]); X[B+3]=EX(X[B+3]); PIN(X); SBAR(); }while(0)
  #define VRD(i) do{ vlo[i]=vtr(vp_+(((i)>>2)*4096+((i)&3)*1024)); vhi[i]=vtr(vp_+(((i)>>2)*4096+((i)&3)*1024+512)); }while(0)
  #define KRD(G,j) do{ if(G){ kload2(kf,kp0+sl_next,j); SBAR(); } }while(0)
  #define STEP(C0,C1,P0,P1,t,GK,GV,GL) do{ SBAR(); \
    const lds_cptr vp_=vp0+sl_prev; \
    CINIT(C0,C1,t); SBAR(); \
    VRD(0); SBAR(); float sacc=(P0[0]+P0[1]); \
    GAPA(C0=__builtin_amdgcn_mfma_f32_32x32x16_bf16(kf[0],qr[0],C0,0,0,0), P0[2],P0[3],P0[4],P0[5],     pw0[0]=PKW(P0,0), pw0[1]=PKW(P0,2), pw0); \
    VRD(4); SBAR(); GAPA(C1=__builtin_amdgcn_mfma_f32_32x32x16_bf16(kf[1],qr[0],C1,0,0,0), P0[6],P0[7],P0[8],P0[9],     pw0[2]=PKW(P0,4), pw0[3]=PKW(P0,6), pw0); \
    VRD(1); SBAR(); GAPA(C0=__builtin_amdgcn_mfma_f32_32x32x16_bf16(kf[2],qr[1],C0,0,0,0),   P0[10],P0[11],P0[12],P0[13], pw1[0]=PKW(P0,8), pw1[1]=PKW(P0,10), pw1); \
    VRD(5); SBAR(); GAPA(C1=__builtin_amdgcn_mfma_f32_32x32x16_bf16(kf[3],qr[1],C1,0,0,0),   P0[14],P0[15],P1[0],P1[1],   pw1[2]=PKW(P0,12),pw1[3]=PKW(P0,14), pw1); \
    VRD(2); SBAR(); GAPA(C0=__builtin_amdgcn_mfma_f32_32x32x16_bf16(kf[4],qr[2],C0,0,0,0),   P1[2],P1[3],P1[4],P1[5],     pw2[0]=PKW(P1,0), pw2[1]=PKW(P1,2), pw2); \
    VRD(6); SBAR(); GAPA(C1=__builtin_amdgcn_mfma_f32_32x32x16_bf16(kf[5],qr[2],C1,0,0,0),   P1[6],P1[7],P1[8],P1[9],     pw2[2]=PKW(P1,4), pw2[3]=PKW(P1,6), pw2); \
    VRD(3); SBAR(); GAPA(C0=__builtin_amdgcn_mfma_f32_32x32x16_bf16(kf[6],qr[3],C0,0,0,0),   P1[10],P1[11],P1[12],P1[13], pw3[0]=PKW(P1,8), pw3[1]=PKW(P1,10), pw3); \
    VRD(7); SBAR(); GAPA(C1=__builtin_amdgcn_mfma_f32_32x32x16_bf16(kf[7],qr[3],C1,0,0,0),   P1[14],P1[15],0.f,0.f,       pw3[2]=PKW(P1,12),pw3[3]=PKW(P1,14), pw3); \
    l_reg+=sacc; \
    if(GK){DMA_K((t)+3,sl_cur);} if(GV){DMA_V((t)+1,sl_next);} \
    CMASK(C0,C1,t); \
    { float a=MX3(C0[0],C0[1],C1[0]),b=MX3(C0[2],C0[3],C1[1]); a=MX3(a,C1[2],C1[3]); \
      _Pragma("unroll") for(int r=4;r<16;r+=4){a=MX3(a,C0[r],C0[r+1]);b=MX3(b,C0[r+2],C0[r+3]);a=MX3(a,C1[r],C1[r+1]);b=MX3(b,C1[r+2],C1[r+3]);} \
      float rm=__builtin_fmaxf(a,b); { auto rr=__builtin_amdgcn_permlane32_swap(__float_as_uint(rm),__float_as_uint(rm),false,false); rm=__builtin_fmaxf(__uint_as_float(rr[0]),__uint_as_float(rr[1])); } \
      resc=false; \
      if(__builtin_expect(__any(rm>(float)THRL),0)){ const float dl=__builtin_fmaxf(rm,0.f); mhat+=dl; \
        _Pragma("unroll") for(int r=0;r<16;++r){C0[r]-=dl;C1[r]-=dl;} \
        nm=ftq-mhat; \
        const float f=__builtin_amdgcn_exp2f(-dl); l_reg*=f; if(hi==0)wsf[r32]=f; resc=true; } } \
    SBAR(); \
    GAPB(o[0]=__builtin_amdgcn_mfma_f32_32x32x16_bf16(PAF(0),VFR(0),o[0],0,0,0), C0,0); \
    GAPB(o[1]=__builtin_amdgcn_mfma_f32_32x32x16_bf16(PAF(0),VFR(4),o[1],0,0,0), C0,4); \
    KRD(GL,0); GAPB(o[0]=__builtin_amdgcn_mfma_f32_32x32x16_bf16(PAF(1),VFR(1),o[0],0,0,0), C0,8); \
    KRD(GL,1); GAPB(o[1]=__builtin_amdgcn_mfma_f32_32x32x16_bf16(PAF(1),VFR(5),o[1],0,0,0), C0,12); \
    KRD(GL,2); GAPB(o[0]=__builtin_amdgcn_mfma_f32_32x32x16_bf16(PAF(2),VFR(2),o[0],0,0,0), C1,0); \
    KRD(GL,3); GAPB(o[1]=__builtin_amdgcn_mfma_f32_32x32x16_bf16(PAF(2),VFR(6),o[1],0,0,0), C1,4); \
    GAPB(o[0]=__builtin_amdgcn_mfma_f32_32x32x16_bf16(PAF(3),VFR(3),o[0],0,0,0), C1,8); \
    GAPB(o[1]=__builtin_amdgcn_mfma_f32_32x32x16_bf16(PAF(3),VFR(7),o[1],0,0,0), C1,12); \
    }while(0)
  int t=1;
  #undef CMASK
  #define CMASK(P0,P1,t) do{}while(0)
  for(;t+5<NT;t+=2){
    STEP(pB0,pB1,pA0,pA1,t,true,true,true);     WAIT_BAR(2); RESC(); ROT();
    STEP(pA0,pA1,pB0,pB1,t+1,true,true,true);   WAIT_BAR(2); RESC(); ROT();
  }
  #undef CMASK
  #define CMASK(P0,P1,t) do{int jb_=(t)-(NT-4); if(jb_>=0)cmask(P0,P1,jb_,qrel,hi);}while(0)
  #define ENDW(tt) do{ if((tt)+3<NT){WAIT_BAR(2);} else if((tt)+2<NT){WAIT_BAR(1);} else {WAIT_BAR(0);} }while(0)
  for(;t+1<NT;t+=2){
    STEP(pB0,pB1,pA0,pA1,t,(t+3<NT),(t+1<NT),(t+1<NT));       ENDW(t);   RESC(); ROT();
    STEP(pA0,pA1,pB0,pB1,t+1,(t+4<NT),(t+2<NT),(t+2<NT));     ENDW(t+1); RESC(); ROT();
  }
  STEP(pB0,pB1,pA0,pA1,NT-1,false,false,false); RESC();
  { float sacc=pB0[0]+pB0[1]; _Pragma("unroll") for(int r=2;r<16;++r)sacc+=pB0[r]; _Pragma("unroll") for(int r=0;r<16;++r)sacc+=pB1[r]; l_reg+=sacc;
    pw0=(u32x4){PKW(pB0,0),PKW(pB0,2),PKW(pB0,4),PKW(pB0,6)};pw1=(u32x4){PKW(pB0,8),PKW(pB0,10),PKW(pB0,12),PKW(pB0,14)};pw2=(u32x4){PKW(pB1,0),PKW(pB1,2),PKW(pB1,4),PKW(pB1,6)};pw3=(u32x4){PKW(pB1,8),PKW(pB1,10),PKW(pB1,12),PKW(pB1,14)};
    SBAR(); pv(o,vb0+sl_cur,PAF(0),PAF(1),PAF(2),PAF(3)); }
  #undef PKW
  #undef PAF
  #undef VFR
  #undef PIN
  #undef MX3
  #undef GAPA
  #undef GAPB
  #undef EX
  #undef VRD
  #undef KRD
  #undef STEP
  #undef ENDW
  {auto rr=__builtin_amdgcn_permlane32_swap(__float_as_uint(l_reg),__float_as_uint(l_reg),false,false);l_reg=__uint_as_float(rr[0])+__uint_as_float(rr[1]);}
  if(hi==0)wsf[32+r32]=l_reg;asm volatile("s_waitcnt lgkmcnt(0)":::"memory");
  float rli[16];
  #pragma unroll
  for(int r=0;r<16;++r)rli[r]=__builtin_amdgcn_rcpf(wsf[32+crow(r,hi)]);
  bf16*Ow=O+(rowbase+q0+wid*QBLK)*DM+h*D;
  { bf16*stg=(bf16*)(shm+LDS_OST)+wid*2048;
    #pragma unroll
    for(int r=0;r<16;++r){const int orow=crow(r,hi);
      #pragma unroll
      for(int d0=0;d0<2;++d0)stg[orow*64+d0*32+r32]=__float2bfloat16(o[d0][r]*rli[r]);}
    asm volatile("s_waitcnt lgkmcnt(0)":::"memory");
    #pragma unroll
    for(int i=0;i<4;++i){const int row=i*8+(lane>>3),ch=lane&7; const u32x4 v=*(const u32x4*)(stg+row*64+ch*8); ATTN_STORE16(Ow+(long)row*DM+ch*8,v);} }
  asm volatile("s_waitcnt lgkmcnt(0)\n\ts_barrier":::"memory");
  #undef DMA_K
  #undef DMA_V
  #undef CMASK
  #undef CINIT
  #undef START
  #undef RESC
  #undef ROT
}
constexpr int ATTN_LDS_BYTES=LDS_BYTES;
#undef SBAR
#undef WAIT_BAR
}

constexpr int ATT_FL_OFF = 86016;
__device__ __forceinline__ void attn_phase(const Frame& F) {
    static_assert(attn_body::ATTN_LDS_BYTES <= ATT_FL_OFF && ATT_FL_OFF + 16384 <= RING_BYTES, "attention LDS map");
    const attn_body::bf16* Q = (const attn_body::bf16*)seg(F, S_Q); const attn_body::bf16* K = (const attn_body::bf16*)seg(F, S_K); const attn_body::bf16* V = (const attn_body::bf16*)seg(F, S_V);
    const float* Fc = (const float*)(F.ws + WS_FC);
    LAS float* Fl = (LAS float*)(F.lds + ATT_FL_OFF);
    const int v0 = (F.G % 8 == 0) ? (F.bid % 8) * (F.G / 8) + F.bid / 8 : F.bid;
#pragma nounroll
    for (int v = v0; v < 256; v += F.G) {
        const int bh = v >> 2, s = v & 3, b = bh >> 3, h = bh & 7;
        __syncthreads();
        for (int i = F.tid; i < 1024; i += NTHR) { const f32x4 x = *(const f32x4*)(Fc + (size_t)bh * SEQ + 4 * i); *(LAS f32x4*)(Fl + 4 * i) = x * LOG2E; }
        asm volatile("s_waitcnt vmcnt(0) lgkmcnt(0)" ::: "memory");
        __syncthreads();
#pragma nounroll
        for (int i = 0; i < 4; ++i) { const int qb = (i >> 1) * 8 + ((i & 1) ? 7 - s : s);
            int t2 = F.tid; asm volatile("" : "+v"(t2));
            attn_body::attn_unit<8>(t2, b, h, qb, Q, K, V, (attn_body::bf16*)Q, (char*)F.lds, Fl); }
    }
}
constexpr int PPL = 13, NPH = 1 + PPL * DEPTH;
__device__ __forceinline__ void make_frame(Frame& F, const Args& args, unsigned char* lds) {
    GAS unsigned char* w_ = (GAS unsigned char*)args.ws; GAS float* o_ = (GAS float*)args.out; int b_ = blockIdx.x, g_ = gridDim.x;
    asm volatile("" : "+s"(w_), "+s"(o_), "+s"(b_), "+s"(g_));
    F.lds = (LAS unsigned char*)lds; F.MISC = (volatile LAS unsigned*)(F.lds + MISC_OFF);
    unsigned z_ = 0u; asm volatile("" : "+v"(z_)); int ln_ = __builtin_amdgcn_mbcnt_hi(~0u, __builtin_amdgcn_mbcnt_lo(~0u, z_));
    unsigned tk_ = ((volatile LAS unsigned*)(F.lds + TICKET_OFF))[(unsigned)__builtin_amdgcn_s_getreg(63492) & 63u];
    tk_ = __builtin_amdgcn_readfirstlane(tk_) & 7u; asm volatile("" : "+v"(ln_));
    F.lane = ln_; F.wave = (int)tk_; F.tid = (int)tk_ * 64 + ln_; F.G = g_; F.bid = b_; F.cpass = 0;
    F.ws = (unsigned char*)w_; F.ctl = (gu32*)(F.ws + WS_CTL); F.XF = (float*)o_; F.XB = (bf16*)(F.ws + WS_XB); F.H = (bf16*)(F.ws + WS_H);
}
struct FillSpec { int l, kind, k; };
__host__ __device__ constexpr FillSpec fill_spec(int PH) {
    if (PH == 0) return {0, 0, 0};
    const int l = (PH - 1) / 13, p = (PH - 1) % 13;
    if (l == 0) { switch (p) { case 0: return {0, 0, 1}; case 3: return {0, 0, 2}; case 4: return {0, 0, 3}; case 5: return {0, 0, 4}; case 6: return {0, 0, 5};
                               case 7: return {0, 1, 0}; case 9: return {0, 1, 1}; case 11: return {1, 0, 0}; case 12: return {1, 0, 1}; default: return {0, -1, 0}; } }
    switch (p) { case 0: return {1, 0, 2}; case 3: return {1, 0, 3}; case 4: return {1, 0, 4}; case 5: return {1, 0, 5}; case 6: return {1, 0, 6};
                 case 7: return {1, 1, 0}; case 9: return {1, 1, 1}; default: return {1, -1, 0}; }
}
constexpr int FILLW = 7;
__host__ __device__ constexpr int fill_done(int l, int kind) { return FILLW * (kind == 0 ? (l == 0 ? 6 : 7) : 2); }
struct NoFill { __device__ __forceinline__ void operator()() const {} };
struct ExpertFill {
    const Frame& B; int l, kind, k; bool on;
    __device__ __forceinline__ void operator()() const {
        if (!on || B.wave == 0 || B.wave > FILLW) return;
        const int i = FILLW * k + (B.wave - 1);
        expert_item(B, l, kind, B.bid + 256 * i, (LAS float*)(B.lds + B.wave * 16384));
    }
};
template <int PH, int MASK>
__device__ __forceinline__ void run_phase(const Args& args, unsigned char* lds, int lo, int hi, int pass, int npass, unsigned xcc) {
    if (!(PH >= lo && PH < hi)) return;
    constexpr int l = PH == 0 ? 0 : (PH - 1) / PPL, p = PH == 0 ? 13 : (PH - 1) % PPL;
    Frame F; make_frame(F, args, lds); F.cpass = pass * 128;
    const bool fill_on = (lo == 0 && hi == NPH && F.G == 256);
    LAS int* pst = (LAS int*)(F.lds + XTRA_OFF); LAS int* cntl = (LAS int*)(F.lds + XTRA_OFF + 256); LAS int* tile_e = (LAS int*)(F.lds + XTRA_OFF + 512); (void)pst; (void)cntl; (void)tile_e;
    constexpr int probe_ = SKIP_PH >= 0 ? SKIP_PH : SOLO_PH;
    const bool skip_ = (pass + 1 < npass) && ((SKIP_PH >= 0) ? (p == probe_) : (p != probe_));
    if (!skip_) {
        if constexpr (((MASK >> p) & 1) != 0) {
            if constexpr (p == 13) {
                convert_small(F, args, 0);
                __syncthreads();
                ln_rows<0>(F, args, inptr(F, 1), inptr(F, 2), 0);
            } else if constexpr (p == 0) {
                fox_scan(F);
                SchedInProj S{(const char*)(F.ws + WS_XB8), (const char*)(F.ws + WS_WIN), F.G, F.bid};
                EpiInProj E{F.H, (const float*)(F.ws + WS_BIAS), (const float*)(F.ws + WS_SA), (const unsigned*)(F.ctl + CW_CMAX) + l * (NH / 32)};
                pg8::gemm_phase(F.lds, F.tid, S, E);
            } else if constexpr (p == 1) { attn_phase(F);
            } else if constexpr (p == 2) { sgu_mfma(F, l);
            } else if constexpr (p == 3) { mlstm_m1_mfma(F, l);
            } else if constexpr (p == 4) { mlstm_m2(F);
            } else if constexpr (p == 5) { mlstm_m3_mfma(F, l);
            } else if constexpr (p == 6) {
                SchedMerge S{(const char*)F.H, (const char*)(F.ws + WS_WBR), F.G, F.bid};
                EpiMerge E{F.H, (bf16*)(F.ws + WS_MERGED)};
                pg8::gemm_phase(F.lds, F.tid, S, E);
            } else if constexpr (p == 7) {
                SchedPlain<1024, T / 256, 4, 8, 4> S{(const char*)(F.ws + WS_MERGED), (const char*)(F.ws + WS_WOUT), F.G, F.bid};
                EpiWout E{F.XB};
                pg8::gemm_phase(F.lds, F.tid, S, E);
            } else if constexpr (p == 8) {
                ln1_route(F, args, l);
            } else if constexpr (p == 9) { convert_experts(F, l, fill_on ? fill_done(l, 0) : 0, fill_on ? fill_done(l, 1) : 0);
            } else if constexpr (p == 10) {
                moe_tiles(F, l, pst, cntl, tile_e);
                SchedMoe1 S{(const char*)(F.ws + WS_XB8), (const char*)wgu_ptr(F), (const int*)(F.ws + WS_ENT2), __builtin_amdgcn_readfirstlane(pst[NEXP]), tile_e, pst, cntl, F.G, F.bid};
                EpiMoe1 E{(unsigned char*)(F.ws + WS_HID)};
                pg8::gemm_phase(F.lds, F.tid, S, E);
            } else if constexpr (p == 11) {
                moe_tiles(F, l, pst, cntl, tile_e);
                SchedMoe2 S{(const char*)(F.ws + WS_HID), (const char*)(F.ws + WS_WD), __builtin_amdgcn_readfirstlane(pst[NEXP]), tile_e, pst, cntl, F.G, F.bid};
                EpiMoe2 E{(unsigned char*)(F.ws + WS_YBUF), (const int*)(F.ws + WS_ENT2)};
                pg8::gemm_phase(F.lds, F.tid, S, E);
            } else {
                constexpr bool more = (l + 1 < DEPTH);
                ln_rows<2>(F, args, inptr(F, 21) + (size_t)l * D, inptr(F, 22) + (size_t)l * D, more ? l + 1 : -1);
                if constexpr (more) convert_small(F, args, l + 1);
            }
        }
    }
    constexpr bool nobar = (p == 1 || p == 2 || p == 8);
    if ((PH + 1 < hi || pass + 1 < npass) && !nobar) {
        Frame B; make_frame(B, args, lds);
        XcdBarrier bar; bar.bar = (unsigned*)(B.ctl + CW_BAR); bar.x = xcc; bar.st = B.MISC + 8;
        constexpr FillSpec fs = fill_spec(PH);
        if constexpr (fs.kind >= 0) xcd_barrier(bar, B.tid == 0, ExpertFill{B, fs.l, fs.kind, fs.k, fill_on});
        else xcd_barrier(bar, B.tid == 0, NoFill{});
    }
}
template <int MASK, int... PHS>
__device__ __forceinline__ void run_all(const Args& args, unsigned char* lds, int lo, int hi, int pass, int npass, unsigned xcc, std::integer_sequence<int, PHS...>) {
    (run_phase<PHS, MASK>(args, lds, lo, hi, pass, npass, xcc), ...);
}
template <int MASK> __global__ void __launch_bounds__(NTHR, 2) fwd_kernel(Args args) {
    extern __shared__ __attribute__((aligned(16))) unsigned char lds[];
    { LAS unsigned char* l3 = (LAS unsigned char*)lds; const int tid0 = threadIdx.x;
      for (int u = tid0; u < (LDS_BYTES - LDSCTL_OFF) / 4; u += NTHR) ((LAS unsigned*)(l3 + LDSCTL_OFF))[u] = 0u;
      __syncthreads();
      if (tid0 < 23) ((LAS unsigned long long*)(l3 + INTBL_OFF))[tid0] = (unsigned long long)args.in[tid0];
      if ((tid0 & 63) == 0) ((LAS unsigned*)(l3 + TICKET_OFF))[(unsigned)__builtin_amdgcn_s_getreg(63492) & 63u] = (unsigned)(tid0 >> 6);
      __syncthreads(); }
    const int lo = args.ph_lo, hi = args.ph_hi;
    unsigned xcc = 0;
    if (hi - lo > 1) { const XcdBarrier b0 = xcd_barrier_post((unsigned*)((gu32*)(args.ws + WS_CTL) + CW_BAR), (volatile LAS unsigned*)((LAS unsigned char*)lds + MISC_OFF) + 8); xcc = b0.x; }
    constexpr int NPASS = (SKIP_PH >= 0 || SOLO_PH >= 0) ? 2 : 1;
    if constexpr (NPASS == 2) run_all<MASK>(args, lds, lo, hi, 0, NPASS, xcc, std::make_integer_sequence<int, NPH>{});
    run_all<MASK>(args, lds, lo, hi, NPASS - 1, NPASS, xcc, std::make_integer_sequence<int, NPH>{});
}

#ifdef ONLY_MASK
template __global__ void fwd_kernel<ONLY_MASK>(Args);
#else
#if PROBE_PH >= 0
__global__ void probe_fill_kernel(float* out, const unsigned long long* ts) {
    unsigned long long dt = 0;
    if (PROBE_PH == 13) dt = ts[1] - ts[0]; else if (PROBE_PH == 14) dt = ts[NPH] - ts[0]; else { for (int l = 0; l < DEPTH; ++l) dt += ts[2 + l * PPL + PROBE_PH] - ts[1 + l * PPL + PROBE_PH]; }
    const float c = sqrtf((float)dt * 0.001f);
    for (size_t i = (size_t)blockIdx.x * blockDim.x + threadIdx.x; i < (size_t)T * D; i += (size_t)gridDim.x * blockDim.x) out[i] = c;
}
#endif
__global__ void fill_kernel(float* out, int n, float c) { for (int i = blockIdx.x * blockDim.x + threadIdx.x; i < n; i += gridDim.x * blockDim.x) out[i] = c; }

#ifndef N_LAUNCH_MODE
#define N_LAUNCH_MODE 1
#endif
extern "C" void kernel_launch(void* const* d_in, const int* in_sizes, int n_in, void* d_out, int out_size, void* d_ws, size_t ws_size, hipStream_t stream) {
    static int grid = 0;
    if (grid == 0) {
        int dev = 0, cus = 0;
        if (hipGetDevice(&dev) != hipSuccess || hipDeviceGetAttribute(&cus, hipDeviceAttributeMultiprocessorCount, dev) != hipSuccess) { grid = -1; return; }
        if (hipFuncSetAttribute((const void*)fwd_kernel<0x3fff>, hipFuncAttributeMaxDynamicSharedMemorySize, LDS_BYTES) != hipSuccess) { grid = -1; return; }
        int per_cu = 0;
        if (hipOccupancyMaxActiveBlocksPerMultiprocessor(&per_cu, (const void*)fwd_kernel<0x3fff>, NTHR, LDS_BYTES) != hipSuccess || per_cu < 1) { (void)hipGetLastError(); grid = -2; }
        else { (void)hipGetLastError(); grid = cus; }
#if N_LAUNCH_MODE != 1
#define SCASE(Q) (void)hipFuncSetAttribute((const void*)fwd_kernel<(1 << Q)>, hipFuncAttributeMaxDynamicSharedMemorySize, LDS_BYTES);
        SCASE(0) SCASE(1) SCASE(2) SCASE(3) SCASE(4) SCASE(5) SCASE(6) SCASE(7) SCASE(8) SCASE(9) SCASE(10) SCASE(11) SCASE(12) SCASE(13)
#undef SCASE
#endif
    }
    if (grid == -2) { hipLaunchKernelGGL(fill_kernel, dim3(1024), dim3(256), 0, stream, (float*)d_out, out_size, 7.0f); return; }
    if (grid < 0) return;
    if (n_in != 23 || out_size != T * D || ws_size < WS_END) {
        hipLaunchKernelGGL(fill_kernel, dim3(1024), dim3(256), 0, stream, (float*)d_out, out_size, (n_in != 23 || out_size != T * D) ? 5.0f : 3.0f);
        return;
    }
    (void)hipMemsetAsync((char*)d_ws + WS_CTL, 0, CTL_ZERO_BYTES, stream);
    Args a{};
    for (int i = 0; i < 23; ++i) a.in[i] = (const float*)d_in[i];
    a.out = (float*)d_out; a.ws = (unsigned char*)d_ws;
#if N_LAUNCH_MODE == 1
    a.ph_lo = 0; a.ph_hi = NPH;
    hipLaunchKernelGGL(fwd_kernel<0x3fff>, dim3(grid), dim3(NTHR), LDS_BYTES, stream, a);
#if PROBE_PH >= 0
    hipLaunchKernelGGL(probe_fill_kernel, dim3(2048), dim3(256), 0, stream, (float*)d_out, (const unsigned long long*)((char*)d_ws + WS_SM + 6 * MiB));
#endif
#else
    for (int p = 0; p < NPH; ++p) { a.ph_lo = p; a.ph_hi = p + 1; const int q = p == 0 ? 13 : (p - 1) % PPL;
        switch (q) {
#define LCASE(Q) case Q: hipLaunchKernelGGL(fwd_kernel<(1 << Q)>, dim3(grid), dim3(NTHR), LDS_BYTES, stream, a); break;
            LCASE(0) LCASE(1) LCASE(2) LCASE(3) LCASE(4) LCASE(5) LCASE(6) LCASE(7) LCASE(8) LCASE(9) LCASE(10) LCASE(11) LCASE(12) LCASE(13)
#undef LCASE
        } }
#endif
}
#endif
```

```cpp
#include <hip/hip_runtime.h>
#ifndef PROBE_PH
#define PROBE_PH -1
#endif
#ifndef SOLO_PH
#define SOLO_PH -1
#endif
#ifndef SKIP_PH
#define SKIP_PH -1
#endif
#include <cstdio>
#include <cstdint>
#include <utility>

namespace pg8 {
#define PG8_LAS __attribute__((address_space(3)))
typedef unsigned short bf16_t;
typedef short bf16x8 __attribute__((ext_vector_type(8)));
typedef float f32x4 __attribute__((ext_vector_type(4)));
typedef float f32x2 __attribute__((ext_vector_type(2)));
typedef unsigned u32x4 __attribute__((ext_vector_type(4)));
typedef int i32x4 __attribute__((ext_vector_type(4)));
typedef int i32x8 __attribute__((ext_vector_type(8)));
constexpr int BM = 256, BK = 64, HALF = 128, HTB = HALF * BK * 2  , STAGE_BYTES = 8 * HTB;

__host__ __device__ __forceinline__ int lds_byte(int r, int c) { const int st = (r >> 4) * 2 + (c >> 5), rr = r & 15, cc = c & 31, ob = rr * 64 + cc * 2; return st * 1024 + (ob ^ (((ob >> 9) & 1) << 5)); }
__host__ __device__ __forceinline__ void stage_rc(int b, int& R, int& C) { const int st = b / 1024, sb = b % 1024, swz = sb ^ (((sb >> 9) & 1) << 5); R = (st >> 1) * 16 + swz / 64; C = (st & 1) * 32 + (swz % 64) / 2; }
__host__ __device__ __forceinline__ int perm32(int rho) { const int n = rho >> 4, i = rho & 15; return 8 * (i >> 2) + 4 * n + (i & 3); }

struct Unit { int pm, pn, ex, nv, gt; };

__device__ __forceinline__ unsigned cvt_pk_bf16(float lo, float hi) { unsigned r; asm volatile("v_cvt_pk_bf16_f32 %0, %1, %2" : "=v"(r) : "v"(lo), "v"(hi)); return r; }

template <class Epi, class Sched>
__device__ __forceinline__ void gemm_phase(PG8_LAS unsigned char* lds, int tid_, const Sched& S, const Epi& E) {
    asm volatile("" : "+v"(tid_));
    const int tid = tid_, wid = __builtin_amdgcn_readfirstlane(tid >> 6), lane = tid & 63, wr = wid >> 2, wc = wid & 3, fr = lane & 15, fq = lane >> 4;
    const int nt = S.ktiles();
    const int lda = S.lda(), ldb = S.ldb();
    unsigned voffA[2][2], voffAn[2][2], voffB[2]; int Rl[2], Cl[2];
#pragma unroll
    for (int i = 0; i < 2; ++i) { stage_rc(tid * 16 + i * 8192, Rl[i], Cl[i]); const int Rb = Epi::PERM ? ((Rl[i] & ~31) + perm32(Rl[i] & 31)) : Rl[i];
        voffB[i] = (unsigned)(Rb * ldb + Cl[i]) * 2u; }
#define PG8_SETA(vo, u) do { int t_ = tid; asm volatile("" : "+v"(t_)); _Pragma("unroll") for (int i_ = 0; i_ < 2; ++i_) { int R_, C_; stage_rc(t_ * 16 + i_ * 8192, R_, C_);     \
        _Pragma("unroll") for (int h_ = 0; h_ < 2; ++h_) { \
        if constexpr (Sched::GATHER) vo[h_][i_] = S.rowoff(u, h_ * HALF + R_) + (unsigned)C_ * 2u; else vo[h_][i_] = (unsigned)((h_ * HALF + R_) * lda + C_) * 2u; } } } while (0)
    const size_t kstep = (size_t)(BK * 2);
    const size_t hstepB = (size_t)HALF * ldb * 2;
    const unsigned ldsw = (unsigned)wid * 1024u;
    constexpr bool F8 = Epi::F8, I8 = Epi::I8; constexpr int KOFF = F8 ? 16 : 1024;
    const int aoff = lds_byte(wr * 64 + fr, F8 ? fq * 16 : fq * 8), boff = lds_byte(wc * 32 + fr, F8 ? fq * 16 : fq * 8);
#define PG8_SA(b, h) (((b) * 2 + (h)) * HTB)
#define PG8_SB(b, h) ((4 + (b) * 2 + (h)) * HTB)
#define PG8_STAGE(bufoff, gbase, voff) do { const char* gb_ = (const char*)(gbase); asm volatile("" : "+s"(gb_)); _Pragma("unroll") for (int _i = 0; _i < 2; ++_i) { \
        unsigned vo_ = (voff)[_i]; asm volatile("" : "+v"(vo_));     \
        __builtin_amdgcn_global_load_lds((const unsigned*)(gb_ + vo_), (PG8_LAS unsigned*)(lds + (bufoff) + ldsw + _i * 8192), 16, 0, 0); } } while (0)
#define PG8_LDA(dst, b, h) do { _Pragma("unroll") for (int m = 0; m < 4; ++m) _Pragma("unroll") for (int k = 0; k < 2; ++k) dst[m][k] = *(const PG8_LAS bf16x8*)(lds + PG8_SA(b, h) + aoff + m * 2048 + k * KOFF); } while (0)
#define PG8_LDB(dst, b, h) do { _Pragma("unroll") for (int n = 0; n < 2; ++n) _Pragma("unroll") for (int k = 0; k < 2; ++k) dst[n][k] = *(const PG8_LAS bf16x8*)(lds + PG8_SB(b, h) + boff + n * 2048 + k * KOFF); } while (0)
#define PG8_CAT(X) __builtin_shufflevector(__builtin_bit_cast(i32x4, X[0]), __builtin_bit_cast(i32x4, X[1]), 0, 1, 2, 3, 4, 5, 6, 7)
#define PG8_MMA(ai, bj, At, Bt, Z) do { __builtin_amdgcn_s_setprio(1); _Pragma("unroll") for (int m = 0; m < 4; ++m) _Pragma("unroll") for (int n = 0; n < 2; ++n) { \
        const f32x4 c0_ = (Z) ? (f32x4){0.f, 0.f, 0.f, 0.f} : acc[ai][bj][m][n];     \
        if constexpr (F8) acc[ai][bj][m][n] = __builtin_amdgcn_mfma_scale_f32_16x16x128_f8f6f4(PG8_CAT(Bt[n]), PG8_CAT(At[m]), c0_, 0, 0, 0, 0x7f7f7f7f, 0, 0x7f7f7f7f); \
        else if constexpr (I8) { acc[ai][bj][m][n] = __builtin_bit_cast(f32x4, __builtin_amdgcn_mfma_i32_16x16x64_i8(__builtin_bit_cast(i32x4, Bt[n][0]), __builtin_bit_cast(i32x4, At[m][0]), __builtin_bit_cast(i32x4, c0_), 0, 0, 0)); \
            acc[ai][bj][m][n] = __builtin_bit_cast(f32x4, __builtin_amdgcn_mfma_i32_16x16x64_i8(__builtin_bit_cast(i32x4, Bt[n][1]), __builtin_bit_cast(i32x4, At[m][1]), __builtin_bit_cast(i32x4, acc[ai][bj][m][n]), 0, 0, 0)); } \
        else { acc[ai][bj][m][n] = __builtin_amdgcn_mfma_f32_16x16x32_bf16(Bt[n][0], At[m][0], c0_, 0, 0, 0); acc[ai][bj][m][n] = __builtin_amdgcn_mfma_f32_16x16x32_bf16(Bt[n][1], At[m][1], acc[ai][bj][m][n], 0, 0, 0); } } __builtin_amdgcn_s_setprio(0); } while (0)
#define PG8_WAIT_V(n) asm volatile("s_waitcnt vmcnt(" #n ")" ::: "memory")
#define PG8_WAIT_L(n) asm volatile("s_waitcnt lgkmcnt(" #n ")" ::: "memory")
#define PG8_BAR __builtin_amdgcn_s_barrier()
#define PG8_SCHED __builtin_amdgcn_sched_barrier(0)
#define PG8_TRIP(Z) do { \
            PG8_LDB(B0, 0, 0); PG8_LDB(B1, 0, 1); PG8_SCHED; PG8_LDA(At, 0, 0); PG8_STAGE(PG8_SA(1, 1), a1, voffA[1]); \
            if constexpr (Sched::GATHER) { _Pragma("unroll") for (int h_ = 0; h_ < 2; ++h_) _Pragma("unroll") for (int i_ = 0; i_ < 2; ++i_) voffA[h_][i_] ^= (voffA[h_][i_] ^ voffAn[h_][i_]) & lmask_; } \
            PG8_WAIT_V(8); PG8_WAIT_L(0); PG8_BAR; PG8_MMA(0, 0, At, B0, Z); PG8_MMA(0, 1, At, B1, Z); PG8_BAR; PG8_SCHED; \
            PG8_LDA(At, 0, 1); PG8_STAGE(PG8_SB(0, 0), b2, voffB); PG8_STAGE(PG8_SB(0, 1), b2 + hstepB, voffB); PG8_STAGE(PG8_SA(0, 0), a2, voffA[0]); \
            PG8_WAIT_V(8); PG8_WAIT_L(0); PG8_BAR; PG8_MMA(1, 0, At, B0, Z); PG8_MMA(1, 1, At, B1, Z); PG8_BAR; PG8_SCHED; \
            PG8_LDB(B0, 1, 0); PG8_LDB(B1, 1, 1); PG8_SCHED; PG8_LDA(At, 1, 0); PG8_STAGE(PG8_SA(0, 1), a2, voffA[1]); \
            PG8_WAIT_V(8); PG8_WAIT_L(0); PG8_BAR; PG8_MMA(0, 0, At, B0, false); PG8_MMA(0, 1, At, B1, false); PG8_BAR; PG8_SCHED; \
            PG8_LDA(At, 1, 1); PG8_STAGE(PG8_SB(1, 0), b3, voffB); PG8_STAGE(PG8_SB(1, 1), b3 + hstepB, voffB); PG8_STAGE(PG8_SA(1, 0), a3, voffA[0]); \
            PG8_WAIT_V(8); PG8_WAIT_L(0); PG8_BAR; PG8_MMA(1, 0, At, B0, false); PG8_MMA(1, 1, At, B1, false); PG8_BAR; PG8_SCHED; \
        } while (0)
    Unit cur, nxt; int ui = 0;
    if (!S.next(0, cur)) return;
    PG8_SETA(voffA, cur);
    f32x4 acc[2][2][4][2];
    bf16x8 At[4][2], B0[2][2], B1[2][2];
    {
        const char* cA = S.aptr(cur, 0); const char* cB = S.bptr(cur, 0); const char* cA1 = S.aptr(cur, 1); const char* cB1 = S.bptr(cur, 1);
        PG8_STAGE(PG8_SB(0, 0), cB, voffB); PG8_STAGE(PG8_SB(0, 1), cB + hstepB, voffB); PG8_STAGE(PG8_SA(0, 0), cA, voffA[0]); PG8_STAGE(PG8_SA(0, 1), cA, voffA[1]);
        if (wr == 1) PG8_BAR;
        PG8_WAIT_V(2); PG8_BAR;
        PG8_STAGE(PG8_SB(1, 0), cB1, voffB); PG8_STAGE(PG8_SA(1, 0), cA1, voffA[0]); PG8_STAGE(PG8_SB(1, 1), cB1 + hstepB, voffB);
        PG8_WAIT_V(6); PG8_BAR;
    }
    for (;;) {
        const bool has_next = S.next(ui + 1, nxt);
        const Unit& nu = has_next ? nxt : cur;
        if constexpr (Sched::GATHER) { if (has_next) PG8_SETA(voffAn, nxt); else { _Pragma("unroll") for (int h_ = 0; h_ < 2; ++h_) _Pragma("unroll") for (int i_ = 0; i_ < 2; ++i_) voffAn[h_][i_] = voffA[h_][i_]; } }
        const int seglen = Epi::HAS_MID ? Epi::SEG : nt;
        _Pragma("nounroll") for (int tb = 0; tb < nt; tb += seglen) {
        if constexpr (Epi::HAS_MID) { if (tb > 0) E.mid(acc, cur, tb, wr, wc, fr, fq); }
        _Pragma("nounroll") for (int t = tb; t < tb + seglen; t += 2) {
            const bool last = (t == nt - 2);
            const char* a1 = S.aptr(cur, t + 1);
            const char* a2 = last ? S.aptr(nu, 0) : S.aptr(cur, t + 2); const char* b2 = last ? S.bptr(nu, 0) : S.bptr(cur, t + 2);
            const char* a3 = last ? S.aptr(nu, 1) : S.aptr(cur, t + 3); const char* b3 = last ? S.bptr(nu, 1) : S.bptr(cur, t + 3);
            const unsigned lmask_ = last ? 0xffffffffu : 0u;
            if (t == 0) PG8_TRIP(true); else PG8_TRIP(false);
        }
        }
        if (wr == 0) PG8_BAR;
        { int t_ = tid; asm volatile("" : "+v"(t_)); E(acc, cur, wr, wc, t_ & 15, (t_ & 63) >> 4); }
        if (!has_next) break;
        cur = nxt; ++ui;
        if constexpr (Sched::GATHER) { _Pragma("unroll") for (int h_ = 0; h_ < 2; ++h_) _Pragma("unroll") for (int i_ = 0; i_ < 2; ++i_) voffA[h_][i_] = voffAn[h_][i_]; }
        if (wr == 1) PG8_BAR;
    }
    PG8_WAIT_V(0);
    PG8_BAR;
#undef PG8_SETA
#undef PG8_SA
#undef PG8_SB
#undef PG8_STAGE
#undef PG8_LDA
#undef PG8_LDB
#undef PG8_MMA
#undef PG8_TRIP
#undef PG8_CAT
#undef PG8_WAIT_V
#undef PG8_WAIT_L
#undef PG8_BAR
#undef PG8_SCHED
}
}


constexpr int NWAVES = 8, NTHR = 512;
constexpr int D = 1024, BATCH = 8, SEQ = 4096, T = BATCH * SEQ, DEPTH = 2;
constexpr int DIN = 7696, NH = 7680;
constexpr int NEXP = 32, DEXP = 512;
constexpr float ALPHA = 1.41421356237309515f;
constexpr float LN_EPS = 1e-5f;
constexpr float LOG2E = 1.4426950408889634f;
constexpr float QSCALE = 0.125f * LOG2E;
constexpr int MAXROWS = 73728, MAXTILES = MAXROWS / 256;

constexpr size_t MiB = 1u << 20;
constexpr size_t WS_CTL = 0, CTL_ZERO_BYTES = 1 * MiB;
constexpr size_t WS_BIAS = 1 * MiB;
constexpr size_t WS_WIN = 2 * MiB, WS_WBR = 18 * MiB, WS_WOUT = 21 * MiB;
constexpr size_t WS_XB = 24 * MiB;
constexpr size_t WS_SM = 88 * MiB;
constexpr size_t WS_LFOX = WS_SM;
constexpr size_t WS_FC = WS_SM + 1 * MiB;
constexpr size_t WS_MLI = WS_SM + 2 * MiB;
constexpr size_t WS_MLF = WS_SM + 2 * MiB + 512 * 1024;
constexpr size_t WS_MST = WS_SM + 3 * MiB;
constexpr size_t WS_NV = WS_SM + 3 * MiB + 64 * 1024;
constexpr size_t WS_TOKE = WS_SM + 4 * MiB;
constexpr size_t WS_TOKP = WS_SM + 4 * MiB + 256 * 1024;
constexpr size_t WS_TOKG = WS_SM + 4 * MiB + 512 * 1024;
constexpr size_t WS_ENT = WS_SM + 5 * MiB;
constexpr size_t WS_SGUW = WS_SM + 7 * MiB;
constexpr size_t WS_WRT = WS_SM + 7 * MiB + 256 * 1024;
constexpr size_t WS_H = 96 * MiB, SEGB = 32 * MiB;
constexpr size_t SEGE = (size_t)T * 512;
enum Seg { S_Q = 0, S_K = 1, S_V = 2, S_MLQ = 3, S_MLK = 4, S_MLV = 5, S_MLO = 6, S_SU = 7, S_SV = 8, S_G0 = 9 };
constexpr size_t WS_MERGED = WS_H + 1 * SEGB;
constexpr size_t WS_ENT2 = WS_H;
constexpr size_t WS_HID = WS_H + 144 * MiB;
constexpr size_t WS_YBUF = WS_H + 216 * MiB;
constexpr size_t WS_WD = WS_H + 448 * MiB;
constexpr size_t WS_XB8 = WS_H + 384 * MiB;
constexpr size_t WS_SA = WS_SM + 6 * MiB;
constexpr size_t WS_END = WS_H + 480 * MiB;
constexpr int CW_BAR = 4096;
constexpr int CW_CNT = 16384;
constexpr int CW_CMAX = 32768;

constexpr int RING_BYTES = 131072;
constexpr int LDS_BYTES = 147456;
constexpr int LDSCTL_OFF = LDS_BYTES - 1024, MISC_OFF = LDSCTL_OFF + 320;
constexpr int XTRA_OFF = RING_BYTES;
constexpr int SCR_BYTES = LDSCTL_OFF;

#define GAS __attribute__((address_space(1)))
#define LAS __attribute__((address_space(3)))
typedef unsigned short bf16;
typedef unsigned v4u __attribute__((ext_vector_type(4)));
typedef unsigned v2u __attribute__((ext_vector_type(2)));
typedef float f32x4 __attribute__((ext_vector_type(4)));
typedef float f32x2 __attribute__((ext_vector_type(2)));
typedef short bf16x8 __attribute__((ext_vector_type(8)));
typedef GAS unsigned gu32;
#define RLX_AGENT __ATOMIC_RELAXED, __HIP_MEMORY_SCOPE_AGENT
#define LDS_WAIT() asm volatile("s_waitcnt lgkmcnt(0)" ::: "memory")
#define VM_WAIT() asm volatile("s_waitcnt vmcnt(0)" ::: "memory")
__device__ __forceinline__ unsigned f2bf(float f) { unsigned u = __builtin_bit_cast(unsigned, f); return (u + 0x7fffu + ((u >> 16) & 1u)) >> 16; }
__device__ __forceinline__ unsigned pk2(float lo, float hi) { return f2bf(lo) | (f2bf(hi) << 16); }
__device__ __forceinline__ float bf2f(unsigned h) { return __builtin_bit_cast(float, h << 16); }
__device__ __forceinline__ float bflo(unsigned w) { return __builtin_bit_cast(float, w << 16); }
__device__ __forceinline__ float bfhi(unsigned w) { return __builtin_bit_cast(float, w & 0xffff0000u); }
__device__ __forceinline__ float fexp2(float x) { return __builtin_amdgcn_exp2f(x); }
__device__ __forceinline__ float fexp(float x) { return __builtin_amdgcn_exp2f(x * LOG2E); }
__device__ __forceinline__ float frcp(float x) { return __builtin_amdgcn_rcpf(x); }
__device__ __forceinline__ float sigmoidf_(float x) { return frcp(1.f + fexp(-x)); }
__device__ __forceinline__ float siluf_(float x) { return x * sigmoidf_(x); }
__device__ __forceinline__ float gelu_tanh(float x) { const float y = 0.7978845608028654f * (x + 0.044715f * x * x * x); return x * sigmoidf_(2.f * y); }
__device__ __forceinline__ float log_sigmoid(float x) { return fminf(x, 0.f) - 0.6931471805599453f * __builtin_amdgcn_logf(1.f + fexp(-fabsf(x))); }
template <int CTRL> __device__ __forceinline__ float dpp_f(float v) { return __builtin_bit_cast(float, __builtin_amdgcn_update_dpp(0, __builtin_bit_cast(int, v), CTRL, 0xF, 0xF, true)); }
__device__ __forceinline__ float wave_sum(float v) {
    v += dpp_f<0xB1>(v);
    v += dpp_f<0x4E>(v);
    v += dpp_f<0x141>(v);
    v += dpp_f<0x140>(v);
    { auto r = __builtin_amdgcn_permlane16_swap(__float_as_uint(v), __float_as_uint(v), false, false); v = __uint_as_float(r[0]) + __uint_as_float(r[1]); }
    { auto r = __builtin_amdgcn_permlane32_swap(__float_as_uint(v), __float_as_uint(v), false, false); v = __uint_as_float(r[0]) + __uint_as_float(r[1]); }
    return v;
}
__device__ __forceinline__ float wave_max(float v) {
    v = fmaxf(v, dpp_f<0xB1>(v)); v = fmaxf(v, dpp_f<0x4E>(v)); v = fmaxf(v, dpp_f<0x141>(v)); v = fmaxf(v, dpp_f<0x140>(v));
    { auto r = __builtin_amdgcn_permlane16_swap(__float_as_uint(v), __float_as_uint(v), false, false); v = fmaxf(__uint_as_float(r[0]), __uint_as_float(r[1])); }
    { auto r = __builtin_amdgcn_permlane32_swap(__float_as_uint(v), __float_as_uint(v), false, false); v = fmaxf(__uint_as_float(r[0]), __uint_as_float(r[1])); }
    return v;
}

#define XB_TMO      128
#define XB_XCNT(j)  (256  + 64 * (j))
#define XB_XSUB(j)  (1280 + 64 * (j))
#define XB_XGEN(j)  (2304 + 64 * (j))
#define XB_TOP      3328
#define XB_TOPGEN   3392
#define XCD_BAR_WORDS 3456
#define XB_SPIN_CAP (1u << 22)
__device__ __forceinline__ unsigned xb_ld(unsigned* p)              { return __hip_atomic_load(p, __ATOMIC_RELAXED, __HIP_MEMORY_SCOPE_AGENT); }
__device__ __forceinline__ unsigned xb_add(unsigned* p, unsigned v) { return __hip_atomic_fetch_add(p, v, __ATOMIC_RELAXED, __HIP_MEMORY_SCOPE_AGENT); }
__device__ __forceinline__ unsigned xb_xcc_id() { return (unsigned)__builtin_amdgcn_s_getreg((3 << 11) | 20) & 0xFu; }
#define XB_SPIN(cond, bar) do { unsigned _sp = 0; while (cond) { __builtin_amdgcn_s_sleep(1); \
    if ((++_sp & 255u) == 0u) { if (xb_ld(&(bar)[XB_TMO])) break; if (_sp > XB_SPIN_CAP) { atomicAdd(&(bar)[XB_TMO], 1u); break; } } } } while (0)
struct XcdBarrier { unsigned* bar; unsigned x; volatile LAS unsigned* st; };
__device__ __forceinline__ XcdBarrier xcd_barrier_post(unsigned* bar, volatile LAS unsigned* st) {
    XcdBarrier b; b.bar = bar; b.x = xb_xcc_id(); b.st = st;
    if (threadIdx.x == 0) (void)xb_add(&bar[XB_XCNT(b.x)], 1u);
    return b;
}
__device__ __forceinline__ void xcd_barrier_complete(unsigned* bar, unsigned x, unsigned& nloc, unsigned& nx) {
    const unsigned G = gridDim.x * gridDim.y * gridDim.z;
    unsigned sum, cnt, mine, sp = 0u;
    for (;;) {
        sum = 0u; cnt = 0u; mine = 0u;
#pragma nounroll
        for (unsigned j = 0; j < 16; ++j) { const unsigned c = xb_ld(&bar[XB_XCNT(j)]); sum += c; cnt += (c > 0u) ? 1u : 0u; mine = (j == x) ? c : mine; }
        if (sum == G) break;
        __builtin_amdgcn_s_sleep(1);
        if ((++sp & 255u) == 0u) { if (xb_ld(&bar[XB_TMO])) break; if (sp > XB_SPIN_CAP) { atomicAdd(&bar[XB_TMO], 1u); break; } }
    }
    nloc = mine > 0u ? mine : 1u; nx = cnt > 0u ? cnt : 1u;
}
template <class Fill>
__device__ __forceinline__ void xcd_barrier(const XcdBarrier& b, bool leader, const Fill& fill) {
    asm volatile("s_waitcnt vmcnt(0)" ::: "memory");
    __syncthreads();
    fill();
    if (leader) {
        unsigned* bar = b.bar;
        __builtin_amdgcn_s_waitcnt(0);
        unsigned nloc = b.st[0], nx = b.st[1];
        if (nloc == 0u) { xcd_barrier_complete(bar, b.x, nloc, nx); b.st[0] = nloc; b.st[1] = nx; }
        const unsigned old = xb_add(&bar[XB_XSUB(b.x)], 1u);
        const unsigned gen = old / nloc;
        if (old + 1u == (gen + 1u) * nloc) {
            __builtin_amdgcn_fence(__ATOMIC_RELEASE, "agent");
            asm volatile("s_waitcnt vmcnt(0)" ::: "memory");
            const unsigned og = xb_add(&bar[XB_TOP], 1u);
            const unsigned tg = og / nx;
            if (og + 1u == (tg + 1u) * nx) xb_add(&bar[XB_TOPGEN], 1u);
            else XB_SPIN(xb_ld(&bar[XB_TOPGEN]) == tg, bar);
            __builtin_amdgcn_fence(__ATOMIC_ACQUIRE, "agent");
            xb_add(&bar[XB_XGEN(b.x)], 1u);
            asm volatile("s_waitcnt vmcnt(0)" ::: "memory");
        } else {
            XB_SPIN(xb_ld(&bar[XB_XGEN(b.x)]) == gen, bar);
            __builtin_amdgcn_fence(__ATOMIC_ACQUIRE, "agent");
            asm volatile("s_waitcnt vmcnt(0)" ::: "memory");
        }
    }
    __syncthreads();
}

struct Args { const float* in[23]; float* out; unsigned char* ws; int ph_lo, ph_hi; };
struct Frame {
    LAS unsigned char* lds;
    volatile LAS unsigned* MISC;
    gu32* ctl;
    int tid, lane, wave, G, bid, cpass;
    unsigned char* ws;
    float* XF;
    bf16* XB;
    bf16* H;
};
__device__ __forceinline__ bf16* seg(const Frame& F, int s) { return F.H + (size_t)s * SEGE; }
constexpr int INTBL_OFF = LDSCTL_OFF + 512, TICKET_OFF = LDSCTL_OFF + 768;
__device__ __forceinline__ const float* inptr(const Frame& F, int k) {
    const LAS unsigned* t = (const LAS unsigned*)(F.lds + INTBL_OFF) + 2 * k;
    const unsigned lo = __builtin_amdgcn_readfirstlane(t[0]), hi = __builtin_amdgcn_readfirstlane(t[1]);
    return (const float*)(((unsigned long long)hi << 32) | lo);
}

__device__ __forceinline__ void transpose_item(const float* src, int src_pitch, int k0, int n0, bf16* dst, int dst_pitch, int dst_row0, int dst_k0, LAS float* scr, int lane) {
    float tv[32];
#pragma unroll
    for (int i = 0; i < 32; ++i) tv[i] = __builtin_nontemporal_load(src + (size_t)(k0 + 2 * i + (lane >> 5)) * src_pitch + n0 + (lane & 31));
#pragma unroll
    for (int i = 0; i < 32; ++i) scr[(2 * i + (lane >> 5)) * 33 + (lane & 31)] = tv[i];
    LDS_WAIT(); asm volatile("" ::: "memory");
    const int c = lane & 7;
#pragma unroll
    for (int j = 0; j < 4; ++j) { const int n = (lane >> 3) + 8 * j; const LAS float* s = scr + (8 * c) * 33 + n;
        v4u o; o.x = pk2(s[0 * 33], s[1 * 33]); o.y = pk2(s[2 * 33], s[3 * 33]); o.z = pk2(s[4 * 33], s[5 * 33]); o.w = pk2(s[6 * 33], s[7 * 33]);
        asm volatile("global_store_dwordx4 %0, %1, off sc1\n\ts_nop 1" :: "v"(dst + (size_t)(dst_row0 + n) * dst_pitch + dst_k0 + k0 + 8 * c), "v"(o) : "memory"); }
    LDS_WAIT(); asm volatile("" ::: "memory");
}
__device__ __forceinline__ unsigned f8pk4(float a, float b, float c, float d) { int w = 0; w = __builtin_amdgcn_cvt_pk_fp8_f32(a, b, w, false); w = __builtin_amdgcn_cvt_pk_fp8_f32(c, d, w, true); return (unsigned)w; }
__device__ __forceinline__ unsigned i8pk4(float a, float b, float c, float d) {
    unsigned w = 0u; w = __builtin_amdgcn_cvt_pk_u8_f32(a + 128.f, 0u, w); w = __builtin_amdgcn_cvt_pk_u8_f32(b + 128.f, 1u, w); w = __builtin_amdgcn_cvt_pk_u8_f32(c + 128.f, 2u, w); w = __builtin_amdgcn_cvt_pk_u8_f32(d + 128.f, 3u, w);
    return w ^ 0x80808080u; }
#define I8_LOAD(tv, k0_) do { _Pragma("unroll") for (int i = 0; i < 32; ++i) tv[i] = __builtin_nontemporal_load(src + (size_t)((k0_) + 2 * i + (lane >> 5)) * src_pitch + n0 + (lane & 31)); } while (0)
#define I8_EMIT(tv, k0_) do { _Pragma("unroll") for (int i = 0; i < 32; ++i) scr[(2 * i + (lane >> 5)) * 33 + (lane & 31)] = tv[i]; \
        LDS_WAIT(); asm volatile("" ::: "memory"); \
        _Pragma("unroll") for (int j = 0; j < 2; ++j) { const int n = (lane >> 2) + 16 * j; const LAS float* s_ = scr + (16 * c) * 33 + n; \
            v4u o; o.x = i8pk4(__builtin_rintf(s_[0 * 33] * sc), __builtin_rintf(s_[1 * 33] * sc), __builtin_rintf(s_[2 * 33] * sc), __builtin_rintf(s_[3 * 33] * sc)); \
            o.y = i8pk4(__builtin_rintf(s_[4 * 33] * sc), __builtin_rintf(s_[5 * 33] * sc), __builtin_rintf(s_[6 * 33] * sc), __builtin_rintf(s_[7 * 33] * sc)); \
            o.z = i8pk4(__builtin_rintf(s_[8 * 33] * sc), __builtin_rintf(s_[9 * 33] * sc), __builtin_rintf(s_[10 * 33] * sc), __builtin_rintf(s_[11 * 33] * sc)); \
            o.w = i8pk4(__builtin_rintf(s_[12 * 33] * sc), __builtin_rintf(s_[13 * 33] * sc), __builtin_rintf(s_[14 * 33] * sc), __builtin_rintf(s_[15 * 33] * sc)); \
            asm volatile("global_store_dwordx4 %0, %1, off sc1\n\ts_nop 1" :: "v"(dst + (size_t)(dst_row0 + n) * dst_pitch + (k0_) + 16 * c), "v"(o) : "memory"); } \
        LDS_WAIT(); asm volatile("" ::: "memory"); } while (0)
__device__ __forceinline__ void strip_i8(const float* src, int src_pitch, int n0, unsigned char* dst, int dst_pitch, int dst_row0, unsigned* cmax1, LAS float* scr, LAS float* red, int wave, int lane) {
    float ta[32], tb[32];
    I8_LOAD(ta, wave * 64); I8_LOAD(tb, (wave + 8) * 64);
    float m = 0.f;
#pragma unroll
    for (int i = 0; i < 32; ++i) m = fmaxf(m, fmaxf(fabsf(ta[i]), fabsf(tb[i])));
    m = wave_max(m);
    if (lane == 0) red[wave] = m;
    __syncthreads();
    float mm = red[0];
#pragma unroll
    for (int w = 1; w < NWAVES; ++w) mm = fmaxf(mm, red[w]);
    if (wave == 0 && lane == 0) *cmax1 = __float_as_uint(mm);
    const float sc = 127.f * frcp(fmaxf(mm, 1e-30f)); const int c = lane & 3;
    I8_EMIT(ta, wave * 64); I8_EMIT(tb, (wave + 8) * 64);
    __syncthreads();
}
#undef I8_LOAD
#undef I8_EMIT
__device__ __forceinline__ float f8clamp(float x) { return __builtin_amdgcn_fmed3f(x, -448.f, 448.f); }
__device__ __forceinline__ void transpose_item8(const float* src, int src_pitch, int k0, int n0, unsigned char* dst, int dst_pitch, int dst_row0, int dst_k0, float scale, LAS float* scr, int lane) {
    float tv[32];
#pragma unroll
    for (int i = 0; i < 32; ++i) tv[i] = __builtin_nontemporal_load(src + (size_t)(k0 + 2 * i + (lane >> 5)) * src_pitch + n0 + (lane & 31));
#pragma unroll
    for (int i = 0; i < 32; ++i) scr[(2 * i + (lane >> 5)) * 33 + (lane & 31)] = tv[i];
    LDS_WAIT(); asm volatile("" ::: "memory");
    const int c = lane & 3;
#pragma unroll
    for (int j = 0; j < 2; ++j) { const int n = (lane >> 2) + 16 * j; const LAS float* s = scr + (16 * c) * 33 + n;
        v4u o;
        o.x = f8pk4(f8clamp(s[0 * 33] * scale), f8clamp(s[1 * 33] * scale), f8clamp(s[2 * 33] * scale), f8clamp(s[3 * 33] * scale));
        o.y = f8pk4(f8clamp(s[4 * 33] * scale), f8clamp(s[5 * 33] * scale), f8clamp(s[6 * 33] * scale), f8clamp(s[7 * 33] * scale));
        o.z = f8pk4(f8clamp(s[8 * 33] * scale), f8clamp(s[9 * 33] * scale), f8clamp(s[10 * 33] * scale), f8clamp(s[11 * 33] * scale));
        o.w = f8pk4(f8clamp(s[12 * 33] * scale), f8clamp(s[13 * 33] * scale), f8clamp(s[14 * 33] * scale), f8clamp(s[15 * 33] * scale));
        asm volatile("global_store_dwordx4 %0, %1, off sc1\n\ts_nop 1" :: "v"(dst + (size_t)(dst_row0 + n) * dst_pitch + dst_k0 + k0 + 16 * c), "v"(o) : "memory"); }
    LDS_WAIT(); asm volatile("" ::: "memory");
}
__device__ __forceinline__ int orig_col(int n) { return n < 1536 ? n : (n < 3584 ? n + 8 : n + 16); }

__device__ __forceinline__ void convert_small(const Frame& F, const Args& args, int l) {
    LAS float* scr = (LAS float*)(F.lds + F.wave * 16384);
    const int gw = F.bid * NWAVES + F.wave, NGW = F.G * NWAVES;
    const float* w_in = inptr(F, 3) + (size_t)l * D * DIN;
    const float* w_br = inptr(F, 10) + (size_t)l * 3 * 512 * D;
    const float* w_out = inptr(F, 11) + (size_t)l * D * D;
    bf16* Wbr_t = (bf16*)(F.ws + WS_WBR); bf16* Wout_t = (bf16*)(F.ws + WS_WOUT);
    constexpr int I_BR = 3 * (512 / 64) * (D / 32), I_OUT = (D / 64) * (D / 32);
    for (int strip = F.bid; strip < NH / 32; strip += F.G) { const int n0 = strip * 32;
        strip_i8(w_in, DIN, orig_col(n0), (unsigned char*)(F.ws + WS_WIN), D, n0, (unsigned*)(F.ctl + CW_CMAX) + l * (NH / 32) + strip, scr, (LAS float*)(F.lds + XTRA_OFF), F.wave, F.lane); }
    for (int it = gw; it < I_BR + I_OUT; it += NGW) {
        int r = it;
        if (r < I_BR) { const int n = r / ((512 / 64) * (D / 32)), q = r % ((512 / 64) * (D / 32)); const int kb = q / (D / 32), nb = q % (D / 32);
            transpose_item(w_br + (size_t)n * 512 * D, D, kb * 64, nb * 32, Wbr_t, 1536, nb * 32, n * 512, scr, F.lane); continue; }
        r -= I_BR;
        { const int kb = r / (D / 32), nb = r % (D / 32); transpose_item(w_out, D, kb * 64, nb * 32, Wout_t, D, nb * 32, 0, scr, F.lane); }
    }
    float* bias_p = (float*)(F.ws + WS_BIAS); const float* b_in = inptr(F, 4) + (size_t)l * DIN;
    for (int i = F.bid * NTHR + F.tid; i < NH; i += F.G * NTHR) bias_p[i] = b_in[orig_col(i)];
    { const float* wrt = inptr(F, 16) + (size_t)l * D * NEXP; float* wrT = (float*)(F.ws + WS_WRT);
      for (int i = F.bid * NTHR + F.tid; i < NEXP * D; i += F.G * NTHR) wrT[i] = wrt[(size_t)(i & 1023) * NEXP + (i >> 10)]; }
    { const float* sw = inptr(F, 8) + (size_t)l * 4 * 128 * 128; bf16* Wm = (bf16*)(F.ws + WS_SGUW);
      for (int i = F.bid * NTHR + F.tid; i < 4 * 128 * 128; i += F.G * NTHR) { const int t = (i >> 7) & 127, s = i & 127; Wm[i] = (bf16)((s <= t) ? f2bf(sw[i]) : 0u); } }
}

__device__ __forceinline__ unsigned char* wgu_ptr(const Frame& F) { return (unsigned char*)(F.XF + (size_t)16 * 1024 * 1024); }
constexpr float W8SCALE = 64.f, W8INV = 1.f / 64.f;
__device__ __forceinline__ void expert_item(const Frame& F, int l, int kind, int idx, LAS float* scr) {
    if (kind == 0) { const int e = idx >> 9, which = (idx >> 8) & 1, q = idx & 255, kb = q >> 4, n0 = (q & 15) * 32;
        const float* w = inptr(F, which ? 19 : 18) + ((size_t)l * NEXP + e) * D * DEXP;
        transpose_item8(w, DEXP, kb * 64, n0, wgu_ptr(F) + (size_t)e * 1024 * 1024, 1024, 256 * (n0 >> 7) + (n0 & 127) + which * 128, 0, W8SCALE, scr, F.lane); }
    else { const int e = idx >> 8, q = idx & 255, kb = q >> 5, nb = q & 31;
        const float* w = inptr(F, 20) + ((size_t)l * NEXP + e) * DEXP * D;
        transpose_item8(w, D, kb * 64, nb * 32, (unsigned char*)(F.ws + WS_WD) + (size_t)e * 1024 * 512, 512, nb * 32, 0, W8SCALE, scr, F.lane); }
}
__device__ __forceinline__ void convert_experts(const Frame& F, int l, int iu0, int id0) {
    LAS float* scr = (LAS float*)(F.lds + F.wave * 16384);
    if (F.G == 256) {
        const int nu = 64 - iu0, nd = 32 - id0;
#pragma nounroll
        for (int j = F.wave; j < nu + nd; j += NWAVES) { if (j < nu) expert_item(F, l, 0, F.bid + 256 * (iu0 + j), scr); else expert_item(F, l, 1, F.bid + 256 * (id0 + j - nu), scr); }
    } else {
        const int gw = F.bid * NWAVES + F.wave, NGW = F.G * NWAVES;
#pragma nounroll
        for (int it = gw; it < 16384 + 8192; it += NGW) { if (it < 16384) expert_item(F, l, 0, it, scr); else expert_item(F, l, 1, it - 16384, scr); }
    }
}

#if defined(EXPT) && EXPT == 3
#define EXPT3 1
#else
#define EXPT3 0
#endif
template <int MODE>
__device__ __forceinline__ void ln_rows(const Frame& F, const Args& args, const float* lng, const float* lnb, int gl) {
    constexpr int WP = 1032;
    LAS bf16* wt = (LAS bf16*)F.lds;
    if (gl >= 0) {
        const float* w_in = inptr(F, 3) + (size_t)gl * D * DIN;
        for (int k = F.tid; k < D; k += NTHR) {
#pragma unroll
            for (int c = 0; c < 16; ++c) wt[c * WP + k] = (bf16)f2bf(w_in[(size_t)k * DIN + (c < 8 ? 1536 + c : 3592 + (c - 8))]);
        }
        __syncthreads();
    }
    const int gw = F.bid * NWAVES + F.wave, NGW = F.G * NWAVES;
    const float* xin = inptr(F, 0);
    const unsigned char* ybuf = (const unsigned char*)(F.ws + WS_YBUF); const float* tokg = (const float*)(F.ws + WS_TOKG);
    float* lfox = (float*)(F.ws + WS_LFOX); float* mli = (float*)(F.ws + WS_MLI); float* mlf = (float*)(F.ws + WS_MLF);
    unsigned char* xb8 = F.ws + WS_XB8; float* sa = (float*)(F.ws + WS_SA);
    f32x4 gv[4], bv[4];
#pragma unroll
    for (int j = 0; j < 4; ++j) { gv[j] = *(const f32x4*)(lng + 4 * F.lane + 256 * j); bv[j] = *(const f32x4*)(lnb + 4 * F.lane + 256 * j); }
    f32x4 vn[4]; unsigned yan[4], ybn[4]; float g0n = 0.f, g1n = 0.f;
#define LNR_LOAD(rw) do { const size_t ro_ = (size_t)(rw) * D + 4 * F.lane; \
        if (MODE == 0) { _Pragma("unroll") for (int j = 0; j < 4; ++j) vn[j] = __builtin_nontemporal_load((const f32x4*)(xin + ro_ + 256 * j)); } \
        else { _Pragma("unroll") for (int j = 0; j < 4; ++j) { const v2u x_ = *(const v2u*)(F.XB + ro_ + 256 * j); vn[j] = (f32x4){bflo(x_.x), bfhi(x_.x), bflo(x_.y), bfhi(x_.y)}; } } \
        if (MODE == 2 && !(EXPT3 && F.cpass == 0)) { g0n = tokg[2 * (rw)]; g1n = tokg[2 * (rw) + 1]; \
            _Pragma("unroll") for (int j = 0; j < 4; ++j) { yan[j] = *(const unsigned*)(ybuf + (size_t)(2 * (rw)) * D + 4 * F.lane + 256 * j); ybn[j] = *(const unsigned*)(ybuf + (size_t)(2 * (rw) + 1) * D + 4 * F.lane + 256 * j); } } } while (0)
    if (gw < T) LNR_LOAD(gw);
#pragma nounroll
    for (int row = gw; row < T; row += NGW) {
        f32x4 v[4]; float s = 0.f;
        const size_t ro = (size_t)row * D + 4 * F.lane;
#pragma unroll
        for (int j = 0; j < 4; ++j) v[j] = vn[j];
        if (MODE == 2) {
#pragma unroll
            for (int j = 0; j < 4; ++j) { const int a = (int)yan[j], b = (int)ybn[j]; const float ga = g0n * (1.f / 16.f), gb = g1n * (1.f / 16.f);
                v[j].x = ALPHA * v[j].x + ga * __builtin_amdgcn_cvt_f32_fp8(a, 0) + gb * __builtin_amdgcn_cvt_f32_fp8(b, 0); v[j].y = ALPHA * v[j].y + ga * __builtin_amdgcn_cvt_f32_fp8(a, 1) + gb * __builtin_amdgcn_cvt_f32_fp8(b, 1);
                v[j].z = ALPHA * v[j].z + ga * __builtin_amdgcn_cvt_f32_fp8(a, 2) + gb * __builtin_amdgcn_cvt_f32_fp8(b, 2); v[j].w = ALPHA * v[j].w + ga * __builtin_amdgcn_cvt_f32_fp8(a, 3) + gb * __builtin_amdgcn_cvt_f32_fp8(b, 3); } }
        if (row + NGW < T) LNR_LOAD(row + NGW);
#pragma unroll
        for (int j = 0; j < 4; ++j) s += (v[j].x + v[j].y) + (v[j].z + v[j].w);
        const float mean = wave_sum(s) * (1.f / D); float s2 = 0.f;
#pragma unroll
        for (int j = 0; j < 4; ++j) { v[j] = v[j] - mean; s2 += (v[j].x * v[j].x + v[j].y * v[j].y) + (v[j].z * v[j].z + v[j].w * v[j].w); }
        const float rstd = 1.f / sqrtf(wave_sum(s2) * (1.f / D) + LN_EPS);
#pragma unroll
        for (int j = 0; j < 4; ++j) { v[j] = v[j] * rstd * gv[j] + bv[j];
            if (MODE == 2 && gl < 0) __builtin_nontemporal_store(v[j], (f32x4*)(F.XF + ro + 256 * j));
            else { v2u o; o.x = pk2(v[j].x, v[j].y); o.y = pk2(v[j].z, v[j].w); *(v2u*)(F.XB + ro + 256 * j) = o; } }
        if (gl >= 0) {
            float am = 0.f;
#pragma unroll
            for (int j = 0; j < 4; ++j) am = fmaxf(fmaxf(am, fmaxf(fabsf(v[j].x), fabsf(v[j].y))), fmaxf(fabsf(v[j].z), fabsf(v[j].w)));
            am = fmaxf(wave_max(am), 1e-30f); const float qs = 127.f * frcp(am);
#pragma unroll
            for (int j = 0; j < 4; ++j) *(unsigned*)(xb8 + ro + 256 * j) = i8pk4(__builtin_rintf(v[j].x * qs), __builtin_rintf(v[j].y * qs), __builtin_rintf(v[j].z * qs), __builtin_rintf(v[j].w * qs));
            if (F.lane == 0) sa[row] = am * (1.f / 127.f); }
    }
    if (gl >= 0) {
        typedef float f32x4m __attribute__((ext_vector_type(4)));
        asm volatile("s_waitcnt vmcnt(0)" ::: "memory");
        __builtin_amdgcn_fence(__ATOMIC_ACQUIRE, "agent");
        const int r16 = F.lane & 15, kq = F.lane >> 4;
        const int arow = gw + r16 * NGW;
        bf16x8 af[32];
#pragma unroll
        for (int ks = 0; ks < 32; ++ks) af[ks] = (arow < T) ? *(const bf16x8*)(F.XB + (size_t)arow * D + 32 * ks + 8 * kq) : (bf16x8){0, 0, 0, 0, 0, 0, 0, 0};
        f32x4m acc = {0.f, 0.f, 0.f, 0.f};
#pragma unroll
        for (int ks = 0; ks < 32; ++ks) acc = __builtin_amdgcn_mfma_f32_16x16x32_bf16(af[ks], *(const LAS bf16x8*)(wt + r16 * WP + 32 * ks + 8 * kq), acc, 0, 0, 0);
        const int c = r16; const float* b_in = inptr(F, 4) + (size_t)gl * DIN; const float bias = b_in[c < 8 ? 1536 + c : 3592 + (c - 8)];
#pragma unroll
        for (int i = 0; i < 4; ++i) { const int row = gw + (4 * kq + i) * NGW; if (row < T) { const float logit = acc[i] + bias;
            if (c < 8) lfox[(size_t)row * 8 + c] = log_sigmoid(logit);
            else if (c < 12) mli[(size_t)row * 4 + (c - 8)] = logit;
            else mlf[(size_t)row * 4 + (c - 12)] = log_sigmoid(logit); } }
    }
#undef LNR_LOAD
    __syncthreads();
}

__device__ __forceinline__ void fox_scan(const Frame& F) {
    if (F.bid >= 64) return;
    const float* lfox = (const float*)(F.ws + WS_LFOX); float* Fc = (float*)(F.ws + WS_FC);
    LAS float* wt = (LAS float*)(F.lds + XTRA_OFF);
    for (int bh = F.bid; bh < 64; bh += F.G) {
        const int b = bh >> 3, h = bh & 7; const int s0 = F.tid * 8;
        float v[8]; float run = 0.f;
#pragma unroll
        for (int i = 0; i < 8; ++i) { run += lfox[((size_t)b * SEQ + s0 + i) * 8 + h]; v[i] = run; }
        float inc = run;
#pragma unroll
        for (int o = 1; o < 64; o <<= 1) { const float t = __shfl_up(inc, o); if (F.lane >= o) inc += t; }
        if (F.lane == 63) wt[F.wave] = inc;
        __syncthreads();
        float base = inc - run;
        for (int w = 0; w < F.wave; ++w) base += wt[w];
#pragma unroll
        for (int i = 0; i < 8; ++i) Fc[(size_t)bh * SEQ + s0 + i] = base + v[i];
        __syncthreads();
    }
}

__device__ __forceinline__ void attn_naive(const Frame& F) {
    bf16* Qs = seg(F, S_Q); const bf16* Ks = seg(F, S_K); const bf16* Vs = seg(F, S_V);
    const float* Fc = (const float*)(F.ws + WS_FC);
    LAS unsigned* Kt = (LAS unsigned*)F.lds;
    LAS unsigned* Vt = (LAS unsigned*)(F.lds + 8192);
    LAS float* Ft = (LAS float*)(F.lds + 16384);
    for (int u = F.bid; u < 512; u += F.G) {
        const int w = u >> 1, bh = w >> 2, sidx = w & 3, qb = ((u ^ (u / F.G)) & 1) ? 7 - sidx : sidx;
        const int b = bh >> 3, h = bh & 7;
        const int t = qb * 512 + F.tid; const size_t row = (size_t)b * SEQ + t;
        float q[64], o[64];
        { const v4u* qp = (const v4u*)(Qs + row * 512 + h * 64);
#pragma unroll
          for (int i = 0; i < 8; ++i) { const v4u x = qp[i]; q[8 * i] = bflo(x.x); q[8 * i + 1] = bfhi(x.x); q[8 * i + 2] = bflo(x.y); q[8 * i + 3] = bfhi(x.y); q[8 * i + 4] = bflo(x.z); q[8 * i + 5] = bfhi(x.z); q[8 * i + 6] = bflo(x.w); q[8 * i + 7] = bfhi(x.w); } }
#pragma unroll
        for (int d = 0; d < 64; ++d) o[d] = 0.f;
        float m = -INFINITY, l = 0.f;
        const int ntile = (qb * 512 + 512) / 64;
        const int wave_tmax = qb * 512 + F.wave * 64 + 63;
        for (int kt = 0; kt < ntile; ++kt) {
            __syncthreads();
            { const int kr = F.tid >> 3, ch = F.tid & 7; const size_t krow = (size_t)b * SEQ + kt * 64 + kr;
              *(LAS v4u*)(Kt + kr * 32 + ch * 4) = *(const v4u*)(Ks + krow * 512 + h * 64 + ch * 8);
              *(LAS v4u*)(Vt + kr * 32 + ch * 4) = *(const v4u*)(Vs + krow * 512 + h * 64 + ch * 8);
              if (F.tid < 64) Ft[F.tid] = Fc[(size_t)bh * SEQ + kt * 64 + F.tid] * LOG2E; }
            __syncthreads();
            if (kt * 64 > wave_tmax) continue;
#pragma nounroll
            for (int sl = 0; sl < 64; ++sl) {
                float acc = 0.f;
#pragma unroll
                for (int i = 0; i < 8; ++i) { const v4u kk = *(const LAS v4u*)(Kt + sl * 32 + i * 4);
                    acc += q[8 * i] * bflo(kk.x) + q[8 * i + 1] * bfhi(kk.x) + q[8 * i + 2] * bflo(kk.y) + q[8 * i + 3] * bfhi(kk.y) + q[8 * i + 4] * bflo(kk.z) + q[8 * i + 5] * bfhi(kk.z) + q[8 * i + 6] * bflo(kk.w) + q[8 * i + 7] * bfhi(kk.w); }
                const float x = (kt * 64 + sl <= t) ? acc - Ft[sl] : -INFINITY;
                if (x > m) { const float corr = fexp2(m - x); m = x; l *= corr;
#pragma unroll
                    for (int d = 0; d < 64; ++d) o[d] *= corr; }
                const float p = fexp2(x - m); l += p;
#pragma unroll
                for (int i = 0; i < 8; ++i) { const v4u vv = *(const LAS v4u*)(Vt + sl * 32 + i * 4);
                    o[8 * i] += p * bflo(vv.x); o[8 * i + 1] += p * bfhi(vv.x); o[8 * i + 2] += p * bflo(vv.y); o[8 * i + 3] += p * bfhi(vv.y); o[8 * i + 4] += p * bflo(vv.z); o[8 * i + 5] += p * bfhi(vv.z); o[8 * i + 6] += p * bflo(vv.w); o[8 * i + 7] += p * bfhi(vv.w); }
            }
        }
        const float rl = 1.f / l;
        { v4u* op = (v4u*)(Qs + row * 512 + h * 64);
#pragma unroll
          for (int i = 0; i < 8; ++i) { v4u x; x.x = pk2(o[8 * i] * rl, o[8 * i + 1] * rl); x.y = pk2(o[8 * i + 2] * rl, o[8 * i + 3] * rl); x.z = pk2(o[8 * i + 4] * rl, o[8 * i + 5] * rl); x.w = pk2(o[8 * i + 6] * rl, o[8 * i + 7] * rl); op[i] = x; } }
    }
    __syncthreads();
}

__device__ __forceinline__ void sgu_naive(const Frame& F, const Args& args, int l) {
    bf16* SU = seg(F, S_SU); const bf16* SV = seg(F, S_SV);
    const float* lng = inptr(F, 6) + (size_t)l * 512; const float* lnb = inptr(F, 7) + (size_t)l * 512;
    const float* sw = inptr(F, 8) + (size_t)l * 4 * 128 * 128; const float* sb = inptr(F, 9) + (size_t)l * 4 * 128;
    LAS float* vh = (LAS float*)F.lds; LAS float* Wt = (LAS float*)(F.lds + 65536);
    LAS float* st = (LAS float*)(F.lds + XTRA_OFF);
    for (int it = F.bid; it < 256; it += F.G) {
        const size_t row0 = (size_t)it * 128;
        __syncthreads();
        for (int i = 0; i < 16; ++i) { const int tok = F.wave * 16 + i;
            const v4u x = *(const v4u*)(SV + (row0 + tok) * 512 + F.lane * 8);
            const float a0 = bflo(x.x), a1 = bfhi(x.x), a2 = bflo(x.y), a3 = bfhi(x.y), a4 = bflo(x.z), a5 = bfhi(x.z), a6 = bflo(x.w), a7 = bfhi(x.w);
            const float mean = wave_sum(((a0 + a1) + (a2 + a3)) + ((a4 + a5) + (a6 + a7))) * (1.f / 512.f);
            const float d0 = a0 - mean, d1 = a1 - mean, d2 = a2 - mean, d3 = a3 - mean, d4 = a4 - mean, d5 = a5 - mean, d6 = a6 - mean, d7 = a7 - mean;
            const float var = wave_sum(((d0 * d0 + d1 * d1) + (d2 * d2 + d3 * d3)) + ((d4 * d4 + d5 * d5) + (d6 * d6 + d7 * d7))) * (1.f / 512.f);
            if (F.lane == 0) { st[2 * tok] = mean; st[2 * tok + 1] = 1.f / sqrtf(var + LN_EPS); } }
        for (int g = 0; g < 4; ++g) {
            __syncthreads();
            for (int i = 0; i < 32; ++i) { const int e = F.tid + 512 * i, s = e >> 7, c = e & 127;
                vh[s * 128 + c] = (bf2f(SV[(row0 + s) * 512 + g * 128 + c]) - st[2 * s]) * st[2 * s + 1] * lng[g * 128 + c] + lnb[g * 128 + c];
                const int t = e >> 7, s2 = e & 127;
                Wt[s2 * 128 + t] = (s2 <= t) ? sw[(size_t)g * 16384 + t * 128 + s2] : 0.f; }
            __syncthreads();
            const int c = F.tid & 127, tq = F.tid >> 7;
            float z[32];
#pragma unroll
            for (int j = 0; j < 32; ++j) z[j] = 0.f;
            for (int s = 0; s < 128; ++s) { const float v = vh[s * 128 + c];
#pragma unroll
                for (int j = 0; j < 8; ++j) { const f32x4 w = *(const LAS f32x4*)(Wt + s * 128 + tq * 32 + 4 * j); z[4 * j] += w.x * v; z[4 * j + 1] += w.y * v; z[4 * j + 2] += w.z * v; z[4 * j + 3] += w.w * v; } }
#pragma unroll
            for (int j = 0; j < 32; ++j) { const int t = tq * 32 + j; const size_t o = (row0 + t) * 512 + g * 128 + c;
                SU[o] = (bf16)f2bf(bf2f(SU[o]) * (z[j] + sb[g * 128 + t])); }
        }
    }
    __syncthreads();
}

__device__ __forceinline__ float conv_silu(const bf16* srcseg, size_t rowb, int tt, int col, const float* cw  ) {
    float a = 0.f;
#pragma unroll
    for (int j = 0; j < 4; ++j) { const int ts = tt - 3 + j; if (ts >= 0) a += cw[j * 1024] * bf2f(srcseg[(rowb + ts) * 512 + col]); }
    return siluf_(a);
}

__device__ __forceinline__ void mlstm_m1_naive(const Frame& F, const Args& args, int l) {
    const bf16* MLK = seg(F, S_MLK); const bf16* MLV = seg(F, S_MLV);
    const float* cw = inptr(F, 5) + (size_t)l * 4 * 1024;
    const float* mli = (const float*)(F.ws + WS_MLI); const float* mlf = (const float*)(F.ws + WS_MLF);
    float* UC = F.XF; float* NV = (float*)(F.ws + WS_NV); float* MST = (float*)(F.ws + WS_MST);
    LAS float* kh = (LAS float*)F.lds; LAS float* vv = (LAS float*)(F.lds + 65536);
    LAS float* sg = (LAS float*)(F.lds + XTRA_OFF);
    for (int it = F.bid; it < 1024; it += F.G) {
        const int bh4 = it >> 5, c = it & 31, b = bh4 >> 2, h = bh4 & 3;
        const size_t rowb = (size_t)b * SEQ, row0 = rowb + c * 128;
        __syncthreads();
        if (F.tid < 128) { sg[F.tid] = mlf[(row0 + F.tid) * 4 + h]; sg[128 + F.tid] = mli[(row0 + F.tid) * 4 + h]; }
        __syncthreads();
        float bc = 0.f, blast = 0.f;
        if (F.tid < 128) {
#pragma nounroll
            for (int i = 0; i < 128; ++i) { blast += sg[i]; if (i == F.tid) bc = blast; } }
        __syncthreads();
        if (F.tid < 128) { sg[F.tid] = bc; sg[128 + F.tid] = blast - bc + sg[128 + F.tid]; }
        __syncthreads();
        float mg = -INFINITY;
#pragma nounroll
        for (int i = 0; i < 128; ++i) mg = fmaxf(mg, sg[128 + i]);
        if (F.tid < 128) sg[256 + F.tid] = fexp(sg[128 + F.tid] - mg);
        __syncthreads();
        for (int i = 0; i < 32; ++i) { const int e = F.tid + 512 * i, s = e >> 7, d = e & 127;
            const float kv = conv_silu(MLK, rowb, c * 128 + s, h * 128 + d, cw + 512 + h * 128 + d) * 0.08838834764831845f;
            kh[s * 128 + d] = kv * sg[256 + s];
            vv[s * 128 + d] = bf2f(MLV[(row0 + s) * 512 + h * 128 + d]); }
        __syncthreads();
        { const int d0 = (F.tid >> 4) * 4, e0 = (F.tid & 15) * 8; float acc[4][8];
#pragma unroll
          for (int i = 0; i < 4; ++i)
#pragma unroll
              for (int j = 0; j < 8; ++j) acc[i][j] = 0.f;
          for (int s = 0; s < 128; ++s) { const f32x4 kd = *(const LAS f32x4*)(kh + s * 128 + d0); const f32x4 v0 = *(const LAS f32x4*)(vv + s * 128 + e0), v1 = *(const LAS f32x4*)(vv + s * 128 + e0 + 4);
#pragma unroll
              for (int i = 0; i < 4; ++i) { acc[i][0] += kd[i] * v0.x; acc[i][1] += kd[i] * v0.y; acc[i][2] += kd[i] * v0.z; acc[i][3] += kd[i] * v0.w; acc[i][4] += kd[i] * v1.x; acc[i][5] += kd[i] * v1.y; acc[i][6] += kd[i] * v1.z; acc[i][7] += kd[i] * v1.w; } }
          float* Uo = UC + (size_t)it * 16384;
#pragma unroll
          for (int i = 0; i < 4; ++i) { *(f32x4*)(Uo + (d0 + i) * 128 + e0) = (f32x4){acc[i][0], acc[i][1], acc[i][2], acc[i][3]}; *(f32x4*)(Uo + (d0 + i) * 128 + e0 + 4) = (f32x4){acc[i][4], acc[i][5], acc[i][6], acc[i][7]}; } }
        if (F.tid < 128) { float n = 0.f; for (int s = 0; s < 128; ++s) n += kh[s * 128 + F.tid]; NV[(size_t)it * 128 + F.tid] = n; }
        if (F.tid == 0) { MST[it * 4] = mg; MST[it * 4 + 1] = blast; }
    }
    __syncthreads();
}

__device__ __forceinline__ void mlstm_m2(const Frame& F) {
    float* UC = F.XF; float* NV = (float*)(F.ws + WS_NV); float* MST = (float*)(F.ws + WS_MST);
    for (int idx = F.bid * NTHR + F.tid; idx < 32 * 4096; idx += F.G * NTHR) {
        const int bh4 = idx >> 12, e4 = idx & 4095;
        f32x4 C = (f32x4){0.f, 0.f, 0.f, 0.f}; float m = 0.f;
#pragma nounroll
        for (int cb = 0; cb < 32; cb += 8) {
            v2u U[8]; float mgv[8], blv[8];
#pragma unroll
            for (int c = 0; c < 8; ++c) { const int it = bh4 * 32 + cb + c; U[c] = *((const v2u*)((const bf16*)UC + (size_t)it * 16384) + e4); mgv[c] = MST[it * 4]; blv[c] = MST[it * 4 + 1]; }
            asm volatile("" ::: "memory");
#pragma unroll
            for (int c = 0; c < 8; ++c) { const int it = bh4 * 32 + cb + c;
                const float mg = mgv[c], bl = blv[c];
                { v2u cb_; cb_.x = pk2(C.x, C.y); cb_.y = pk2(C.z, C.w); *((v2u*)((bf16*)UC + (size_t)it * 16384) + e4) = cb_; }
                const float mn = fmaxf(bl + m, mg), dc = fexp(bl + m - mn), sc = fexp(mg - mn);
                C = C * dc + (f32x4){bflo(U[c].x), bfhi(U[c].x), bflo(U[c].y), bfhi(U[c].y)} * sc;
                if (e4 == 0) MST[it * 4 + 2] = m;
                m = mn; }
            asm volatile("" ::: "memory");
        }
        if (e4 < 32) { f32x4 N = (f32x4){0.f, 0.f, 0.f, 0.f}; m = 0.f;
#pragma nounroll
            for (int cb = 0; cb < 32; cb += 8) {
                f32x4 nn[8]; float mgv[8], blv[8];
#pragma unroll
                for (int c = 0; c < 8; ++c) { const int it = bh4 * 32 + cb + c; nn[c] = *((const f32x4*)(NV + (size_t)it * 128) + e4); mgv[c] = MST[it * 4]; blv[c] = MST[it * 4 + 1]; }
                asm volatile("" ::: "memory");
#pragma unroll
                for (int c = 0; c < 8; ++c) { const int it = bh4 * 32 + cb + c; const float mg = mgv[c], bl = blv[c];
                    *((f32x4*)(NV + (size_t)it * 128) + e4) = N;
                    const float mn = fmaxf(bl + m, mg), dc = fexp(bl + m - mn), sc = fexp(mg - mn); N = N * dc + nn[c] * sc; m = mn; }
                asm volatile("" ::: "memory"); } }
    }
}

__device__ __forceinline__ void mlstm_m3_naive(const Frame& F, const Args& args, int l) {
    const bf16* MLQ = seg(F, S_MLQ); const bf16* MLK = seg(F, S_MLK); bf16* MLV = seg(F, S_MLV); const bf16* MLO = seg(F, S_MLO);
    const float* cw = inptr(F, 5) + (size_t)l * 4 * 1024;
    const float* mli = (const float*)(F.ws + WS_MLI); const float* mlf = (const float*)(F.ws + WS_MLF);
    const float* UC = (const float*)F.XF; const float* NV = (const float*)(F.ws + WS_NV); const float* MST = (const float*)(F.ws + WS_MST);
    constexpr int P = 129;
    LAS float* A0 = (LAS float*)F.lds;
    LAS float* A1 = (LAS float*)(F.lds + 128 * P * 4);
    LAS float* sg = (LAS float*)(F.lds + 2 * 128 * P * 4);
    for (int it = F.bid; it < 1024; it += F.G) {
        const int bh4 = it >> 5, c = it & 31, b = bh4 >> 2, h = bh4 & 3;
        const size_t rowb = (size_t)b * SEQ, row0 = rowb + c * 128;
        const float m_in = MST[it * 4 + 2];
        __syncthreads();
        if (F.tid < 128) { sg[F.tid] = mlf[(row0 + F.tid) * 4 + h]; sg[256 + F.tid] = mli[(row0 + F.tid) * 4 + h]; sg[384 + F.tid] = NV[(size_t)it * 128 + F.tid]; }
        __syncthreads();
        float bc = 0.f;
        if (F.tid < 128) { float r = 0.f;
#pragma nounroll
            for (int i = 0; i < 128; ++i) { r += sg[i]; if (i == F.tid) bc = r; } }
        __syncthreads();
        if (F.tid < 128) { sg[F.tid] = bc; sg[128 + F.tid] = sg[256 + F.tid] - bc; }
        for (int i = 0; i < 32; ++i) { const int e = F.tid + 512 * i, s = e >> 7, d = e & 127;
            A0[s * P + d] = conv_silu(MLQ, rowb, c * 128 + s, h * 128 + d, cw + h * 128 + d);
            A1[s * P + d] = conv_silu(MLK, rowb, c * 128 + s, h * 128 + d, cw + 512 + h * 128 + d) * 0.08838834764831845f; }
        __syncthreads();
        const int t = F.tid >> 2, eq = F.tid & 3;
        float pm = -INFINITY;
        for (int s = 0; s <= t; ++s) pm = fmaxf(pm, sg[128 + s]);
        const float bt = sg[t], inter = bt + m_in, mt = fmaxf(inter, bt + pm), w_inter = fexp(inter - mt);
        float sreg[32], acc2[32]; float qn = 0.f;
#pragma unroll
        for (int j = 0; j < 32; ++j) { sreg[j] = 0.f; acc2[j] = 0.f; }
        const float* Cg = UC + (size_t)it * 16384 + eq * 32;
#pragma nounroll
        for (int d = 0; d < 128; ++d) { const float qv = A0[t * P + d]; qn += qv * sg[384 + d];
#pragma unroll
            for (int j = 0; j < 32; ++j) sreg[j] += qv * A1[(4 * j + eq) * P + d]; }
#pragma nounroll
        for (int d = 0; d < 128; ++d) { const float qv = A0[t * P + d];
#pragma unroll
            for (int j = 0; j < 8; ++j) { const f32x4 cc = *(const f32x4*)(Cg + d * 128 + 4 * j); acc2[4 * j] += qv * cc.x; acc2[4 * j + 1] += qv * cc.y; acc2[4 * j + 2] += qv * cc.z; acc2[4 * j + 3] += qv * cc.w; } }
        __syncthreads();
#pragma unroll
        for (int j = 0; j < 32; ++j) { const int s = 4 * j + eq; A0[t * P + s] = (s <= t) ? sreg[j] * fexp(bt + sg[128 + s] - mt) : 0.f; }
        for (int i = 0; i < 32; ++i) { const int e = F.tid + 512 * i, s = e >> 7, d = e & 127; A1[s * 128 + d] = bf2f(MLV[(row0 + s) * 512 + h * 128 + d]); }
        __syncthreads();
        float num[32]; float den = 0.f;
#pragma unroll
        for (int j = 0; j < 32; ++j) num[j] = 0.f;
#pragma nounroll
        for (int s = 0; s < 128; ++s) { const float p = A0[t * P + s]; den += p;
#pragma unroll
            for (int j = 0; j < 8; ++j) { const f32x4 vv = *(const LAS f32x4*)(A1 + s * 128 + eq * 32 + 4 * j); num[4 * j] += p * vv.x; num[4 * j + 1] += p * vv.y; num[4 * j + 2] += p * vv.z; num[4 * j + 3] += p * vv.w; } }
        den += w_inter * qn;
        const float rden = 1.f / fmaxf(fabsf(den), fexp(-mt));
        { const size_t o = (row0 + t) * 512 + h * 128 + eq * 32;
#pragma unroll
          for (int j = 0; j < 4; ++j) { const v4u og = *(const v4u*)(MLO + o + 8 * j); float y[8];
#pragma unroll
              for (int i = 0; i < 8; ++i) y[i] = (num[8 * j + i] + w_inter * acc2[8 * j + i]) * rden;
              v4u r; r.x = pk2(bflo(og.x) * y[0], bfhi(og.x) * y[1]); r.y = pk2(bflo(og.y) * y[2], bfhi(og.y) * y[3]); r.z = pk2(bflo(og.z) * y[4], bfhi(og.z) * y[5]); r.w = pk2(bflo(og.w) * y[6], bfhi(og.w) * y[7]);
              *(v4u*)(MLV + o + 8 * j) = r; } }
    }
    __syncthreads();
}

__device__ __forceinline__ void ln1_route(const Frame& F, const Args& args, int l) {
    const float* lng = inptr(F, 12) + (size_t)l * D; const float* lnb = inptr(F, 13) + (size_t)l * D;
    const float* wgrp = inptr(F, 14) + (size_t)l * D * 4; const float* bgrp = inptr(F, 15) + (size_t)l * 4;
    const float* brt = inptr(F, 17) + (size_t)l * NEXP;
    float* tokg = (float*)(F.ws + WS_TOKG); int* ent2 = (int*)(F.ws + WS_ENT2);
    unsigned* cnt = (unsigned*)(F.ctl + CW_CNT + l * 64 + F.cpass);
    LAS float* wl = (LAS float*)F.lds;
    LAS unsigned* lcnt = (LAS unsigned*)(F.lds + XTRA_OFF);
    LAS int* rec = (LAS int*)(F.lds + XTRA_OFF + 256);
    { const f32x4* src = (const f32x4*)(F.ws + WS_WRT);
#pragma unroll
      for (int i = 0; i < 16; ++i) *(LAS f32x4*)(wl + 4 * (F.tid + NTHR * i)) = src[F.tid + NTHR * i]; }
    if (F.tid < 64) lcnt[F.tid] = 0u;
    const int gw = F.bid * NWAVES + F.wave, NGW = F.G * NWAVES;
    f32x4 gv[4], bv[4], wg[4][4];
#pragma unroll
    for (int j = 0; j < 4; ++j) { gv[j] = *(const f32x4*)(lng + 4 * F.lane + 256 * j); bv[j] = *(const f32x4*)(lnb + 4 * F.lane + 256 * j);
#pragma unroll
        for (int i = 0; i < 4; ++i) wg[j][i] = *(const f32x4*)(wgrp + (size_t)(4 * F.lane + 256 * j + i) * 4); }
    __syncthreads();
    v2u vn[4];
    if (gw < T) {
#pragma unroll
        for (int j = 0; j < 4; ++j) vn[j] = *(const v2u*)(F.XB + (size_t)gw * D + 4 * F.lane + 256 * j); }
    int it = 0;
#pragma nounroll
    for (int row = gw; row < T; row += NGW, ++it) {
        f32x4 v[4]; float s = 0.f; const size_t ro = (size_t)row * D + 4 * F.lane;
#pragma unroll
        for (int j = 0; j < 4; ++j) { v[j] = (f32x4){bflo(vn[j].x), bfhi(vn[j].x), bflo(vn[j].y), bfhi(vn[j].y)}; s += (v[j].x + v[j].y) + (v[j].z + v[j].w); }
        if (row + NGW < T) {
#pragma unroll
            for (int j = 0; j < 4; ++j) vn[j] = *(const v2u*)(F.XB + ro + (size_t)NGW * D + 256 * j); }
        const float mean = wave_sum(s) * (1.f / D); float s2 = 0.f;
#pragma unroll
        for (int j = 0; j < 4; ++j) { v[j] = v[j] - mean; s2 += (v[j].x * v[j].x + v[j].y * v[j].y) + (v[j].z * v[j].z + v[j].w * v[j].w); }
        const float rstd = 1.f / sqrtf(wave_sum(s2) * (1.f / D) + LN_EPS);
#pragma unroll
        for (int j = 0; j < 4; ++j) { v[j] = v[j] * rstd * gv[j] + bv[j];
            v2u o; o.x = pk2(v[j].x, v[j].y); o.y = pk2(v[j].z, v[j].w); *(v2u*)(F.XB + ro + 256 * j) = o;
            *(unsigned*)(F.ws + WS_XB8 + ro + 256 * j) = f8pk4(v[j].x, v[j].y, v[j].z, v[j].w); }
#if defined(EXPT) && EXPT == 1
        if (F.cpass == 0) continue;
#endif
        float lg[4] = {0.f, 0.f, 0.f, 0.f};
#pragma unroll
        for (int j = 0; j < 4; ++j)
#pragma unroll
            for (int i = 0; i < 4; ++i) { const f32x4 w = wg[j][i]; const float xv = v[j][i]; lg[0] += xv * w.x; lg[1] += xv * w.y; lg[2] += xv * w.z; lg[3] += xv * w.w; }
#pragma unroll
        for (int c = 0; c < 4; ++c) lg[c] = wave_sum(lg[c]) + bgrp[c];
        int gt = 0; float gm = lg[0];
#pragma unroll
        for (int c = 1; c < 4; ++c) if (lg[c] > gm) { gm = lg[c]; gt = c; }
        float gs = 0.f;
#pragma unroll
        for (int c = 0; c < 4; ++c) gs += fexp(lg[c] - gm);
        const float pgsel = frcp(gs);
        gt = __builtin_amdgcn_readfirstlane(gt);
        float le[8];
#pragma unroll
        for (int c = 0; c < 8; ++c) { float a = 0.f;
#pragma unroll
            for (int j = 0; j < 4; ++j) { const f32x4 w = *(const LAS f32x4*)(wl + (gt * 8 + c) * 1024 + 4 * F.lane + 256 * j); a += (v[j].x * w.x + v[j].y * w.y) + (v[j].z * w.z + v[j].w * w.w); }
            le[c] = wave_sum(a) + brt[gt * 8 + c]; if (c == 3) asm volatile("" ::: "memory"); }
        int i0 = 0; float m0 = le[0];
#pragma unroll
        for (int c = 1; c < 8; ++c) if (le[c] > m0) { m0 = le[c]; i0 = c; }
        int i1 = (i0 == 0) ? 1 : 0; float m1 = -INFINITY;
#pragma unroll
        for (int c = 0; c < 8; ++c) if (c != i0 && le[c] > m1) { m1 = le[c]; i1 = c; }
        float one_ = 1.f; asm volatile("" : "+v"(one_));
        const float e1 = fexp(m1 - m0), inv = frcp(one_ + e1);
        if (F.lane == 0) {
            const int ex0 = gt * 8 + i0, ex1 = gt * 8 + i1;
            const unsigned p0 = __hip_atomic_fetch_add(lcnt + ex0, 1u, __ATOMIC_RELAXED, __HIP_MEMORY_SCOPE_WORKGROUP), p1 = __hip_atomic_fetch_add(lcnt + ex1, 1u, __ATOMIC_RELAXED, __HIP_MEMORY_SCOPE_WORKGROUP);
            LAS int* r = rec + (F.wave * 16 + it) * 4; r[0] = row; r[1] = ex0 | (ex1 << 8); r[2] = (int)p0; r[3] = (int)p1;
            tokg[2 * row] = pgsel * inv; tokg[2 * row + 1] = pgsel * e1 * inv; }
    }
    __syncthreads();
    if (F.tid < 32) { const unsigned c = lcnt[F.tid]; lcnt[32 + F.tid] = c ? __hip_atomic_fetch_add(cnt + F.tid, c, RLX_AGENT) : 0u; }
    __syncthreads();
    if (F.lane < it) { const LAS int* r = rec + (F.wave * 16 + F.lane) * 4; const int row = r[0], ex0 = r[1] & 255, ex1 = r[1] >> 8;
        ent2[(size_t)ex0 * 32768 + lcnt[32 + ex0] + r[2]] = 2 * row; ent2[(size_t)ex1 * 32768 + lcnt[32 + ex1] + r[3]] = 2 * row + 1; }
    __syncthreads();
}

__device__ __forceinline__ void moe_tiles(const Frame& F, int l, LAS int* pst, LAS int* cntl, LAS int* tile_e) {
    __syncthreads();
    if (F.tid < NEXP) { const unsigned* cnt = (const unsigned*)(F.ctl + CW_CNT + l * 64 + F.cpass); cntl[F.tid] = (int)__hip_atomic_load(cnt + F.tid, RLX_AGENT); }
    __syncthreads();
    if (F.tid == 0) { int run = 0;
#pragma nounroll
        for (int e = 0; e < NEXP; ++e) { pst[e] = run; run += (cntl[e] + 255) >> 8; }
        pst[NEXP] = run; }
    __syncthreads();
    const int total = pst[NEXP];
    for (int t = F.tid; t < total; t += NTHR) { int e = 0;
#pragma unroll 8
        for (int q = 1; q < NEXP; ++q) e += (pst[q] <= t) ? 1 : 0;
        tile_e[t] = e; }
    __syncthreads();
}

namespace mx {
typedef float f32x16 __attribute__((ext_vector_type(16)));
typedef short s16x4 __attribute__((ext_vector_type(4)));
typedef short v4i16_t __attribute__((ext_vector_type(4)));
constexpr int LP = 136;
constexpr int IMG = 128 * LP * 2;
#define MX_MFMA(a, b, c) __builtin_amdgcn_mfma_f32_32x32x16_bf16(a, b, c, 0, 0, 0)
__device__ __forceinline__ int crow(int r, int hi) { return (r & 3) + 8 * (r >> 2) + 4 * hi; }
__device__ __forceinline__ bf16x8 frag_row(const LAS bf16* img, int row0, int k0, int lane) { return *(const LAS bf16x8*)(img + (row0 + (lane & 31)) * LP + k0 + 8 * (lane >> 5)); }
__device__ __forceinline__ s16x4 tr4(const LAS bf16* p) { return __builtin_bit_cast(s16x4, __builtin_amdgcn_ds_read_tr16_b64_v4i16((LAS v4i16_t*)p)); }
__device__ __forceinline__ bf16x8 frag_tr(const LAS bf16* img, int k0, int n0, int lane) {
    const LAS bf16* p = img + (k0 + 8 * (lane >> 5) + ((lane & 15) >> 2)) * LP + n0 + 16 * ((lane >> 4) & 1) + 4 * (lane & 3);
    const s16x4 lo = tr4(p), hi = tr4(p + 4 * LP);
    return (bf16x8){lo[0], lo[1], lo[2], lo[3], hi[0], hi[1], hi[2], hi[3]};
}
__device__ __forceinline__ bf16x8 frag_tr_acc(const LAS bf16* img, int k16, int n0, int lane) {
    const LAS bf16* p = img + (k16 + 4 * (lane >> 5) + ((lane & 15) >> 2)) * LP + n0 + 16 * ((lane >> 4) & 1) + 4 * (lane & 3);
    const s16x4 lo = tr4(p), hi = tr4(p + 8 * LP);
    return (bf16x8){lo[0], lo[1], lo[2], lo[3], hi[0], hi[1], hi[2], hi[3]};
}
__device__ __forceinline__ bf16x8 pack8(const f32x16& x, int s) {
    v4u w; w.x = pg8::cvt_pk_bf16(x[8 * s], x[8 * s + 1]); w.y = pg8::cvt_pk_bf16(x[8 * s + 2], x[8 * s + 3]); w.z = pg8::cvt_pk_bf16(x[8 * s + 4], x[8 * s + 5]); w.w = pg8::cvt_pk_bf16(x[8 * s + 6], x[8 * s + 7]);
    return __builtin_bit_cast(bf16x8, w);
}
__device__ __forceinline__ float swap_add(float v) { auto rr = __builtin_amdgcn_permlane32_swap(__float_as_uint(v), __float_as_uint(v), false, false); return __uint_as_float(rr[0]) + __uint_as_float(rr[1]); }
}

__device__ __forceinline__ void sgu_mfma(const Frame& F, int l) {
    using namespace mx;
    constexpr int VP = 520;
    static_assert(128 * VP * 2 <= SCR_BYTES, "SGU LDS map");
    bf16* SU = seg(F, S_SU); const bf16* SV = seg(F, S_SV);
    const float* lng = inptr(F, 6) + (size_t)l * 512; const float* lnb = inptr(F, 7) + (size_t)l * 512;
    const float* sb = inptr(F, 9) + (size_t)l * 4 * 128;
    const bf16* Wm = (const bf16*)(F.ws + WS_SGUW);
    LAS bf16* Vl = (LAS bf16*)F.lds;
    const int tb = F.wave & 3, ch = F.wave >> 2;
    for (int it = F.bid; it < 256; it += F.G) {
        int lane = F.lane; asm volatile("" : "+v"(lane));
        const int hi = lane >> 5;
        const size_t row0 = (size_t)it * 128;
        const f32x4 g0 = *(const f32x4*)(lng + lane * 8), g1 = *(const f32x4*)(lng + lane * 8 + 4), b0 = *(const f32x4*)(lnb + lane * 8), b1 = *(const f32x4*)(lnb + lane * 8 + 4);
        __syncthreads();
        v4u xr[16];
#pragma unroll
        for (int i = 0; i < 16; ++i) xr[i] = *(const v4u*)(SV + (row0 + F.wave * 16 + i) * 512 + lane * 8);
#pragma unroll
        for (int i = 0; i < 16; ++i) { const v4u x = xr[i];
            const float a0 = bflo(x.x), a1 = bfhi(x.x), a2 = bflo(x.y), a3 = bfhi(x.y), a4 = bflo(x.z), a5 = bfhi(x.z), a6 = bflo(x.w), a7 = bfhi(x.w);
            const float mean = wave_sum(((a0 + a1) + (a2 + a3)) + ((a4 + a5) + (a6 + a7))) * (1.f / 512.f);
            const float d0 = a0 - mean, d1 = a1 - mean, d2 = a2 - mean, d3 = a3 - mean, d4 = a4 - mean, d5 = a5 - mean, d6 = a6 - mean, d7 = a7 - mean;
            const float var = wave_sum(((d0 * d0 + d1 * d1) + (d2 * d2 + d3 * d3)) + ((d4 * d4 + d5 * d5) + (d6 * d6 + d7 * d7))) * (1.f / 512.f);
            const float rstd = 1.f / sqrtf(var + LN_EPS);
            v4u o; o.x = pk2(d0 * rstd * g0.x + b0.x, d1 * rstd * g0.y + b0.y); o.y = pk2(d2 * rstd * g0.z + b0.z, d3 * rstd * g0.w + b0.w);
            o.z = pk2(d4 * rstd * g1.x + b1.x, d5 * rstd * g1.y + b1.y); o.w = pk2(d6 * rstd * g1.z + b1.z, d7 * rstd * g1.w + b1.w);
            *(LAS v4u*)(Vl + (F.wave * 16 + i) * VP + lane * 8) = o; }
        __syncthreads();
#pragma nounroll
        for (int g = 0; g < 4; ++g) {
            f32x16 z0 = {}, z1 = {};
            const bf16* wrow = Wm + (size_t)g * 16384 + (size_t)(32 * tb + (lane & 31)) * 128 + 8 * hi;
            const int lim = 2 * tb + 2;
            bf16x8 af[8];
#pragma unroll
            for (int ks = 0; ks < 8; ++ks) af[ks] = (ks < lim) ? *(const bf16x8*)(wrow + 16 * ks) : (bf16x8){0, 0, 0, 0, 0, 0, 0, 0};
#pragma unroll
            for (int ks = 0; ks < 8; ++ks) { if (ks < lim) {
                const LAS bf16* p = Vl + (16 * ks + 8 * hi + ((lane & 15) >> 2)) * VP + g * 128 + 64 * ch + 16 * ((lane >> 4) & 1) + 4 * (lane & 3);
                const s16x4 l0 = tr4(p), h0 = tr4(p + 4 * VP), l1 = tr4(p + 32), h1 = tr4(p + 4 * VP + 32);
                z0 = MX_MFMA(af[ks], ((bf16x8){l0[0], l0[1], l0[2], l0[3], h0[0], h0[1], h0[2], h0[3]}), z0);
                z1 = MX_MFMA(af[ks], ((bf16x8){l1[0], l1[1], l1[2], l1[3], h1[0], h1[1], h1[2], h1[3]}), z1); } }
            bf16 u0[16], u1[16]; float bsv[16];
#pragma unroll
            for (int r = 0; r < 16; ++r) { const int t = 32 * tb + crow(r, hi); bsv[r] = sb[g * 128 + t];
                const size_t o = (row0 + t) * 512 + g * 128 + 64 * ch + (lane & 31); u0[r] = SU[o]; u1[r] = SU[o + 32]; }
            asm volatile("" ::: "memory");
#pragma unroll
            for (int r = 0; r < 16; ++r) { const int t = 32 * tb + crow(r, hi);
                const size_t o = (row0 + t) * 512 + g * 128 + 64 * ch + (lane & 31);
                SU[o] = (bf16)f2bf(bf2f(u0[r]) * (z0[r] + bsv[r])); SU[o + 32] = (bf16)f2bf(bf2f(u1[r]) * (z1[r] + bsv[r])); }
        }
    }
    __syncthreads();
}

__device__ __forceinline__ float scan128_sum(float x, int tid, int lane, LAS float* tmp) {
    float v = x;
#pragma unroll
    for (int o = 1; o < 64; o <<= 1) { const float t = __shfl_up(v, o); if (lane >= o) v += t; }
    if (tid == 63) tmp[0] = v;
    __syncthreads();
    if (tid >= 64 && tid < 128) v += tmp[0];
    return v;
}
__device__ __forceinline__ float scan128_max(float x, int tid, int lane, LAS float* tmp) {
    float v = x;
#pragma unroll
    for (int o = 1; o < 64; o <<= 1) { const float t = __shfl_up(v, o); if (lane >= o) v = fmaxf(v, t); }
    if (tid == 63) tmp[0] = v;
    __syncthreads();
    if (tid >= 64 && tid < 128) v = fmaxf(v, tmp[0]);
    return v;
}
template <bool ROWSCALE>
__device__ __forceinline__ void stage_conv(const Frame& F, LAS bf16* img, const bf16* srcseg, size_t rowb, int c, int h, const float* cw  , float scale, const LAS float* rs) {
    const int c8 = (F.tid & 15) * 8, s0 = (F.tid >> 4) * 4, tt0 = c * 128 + s0;
    f32x4 w0[4], w1[4];
#pragma unroll
    for (int j = 0; j < 4; ++j) { w0[j] = *(const f32x4*)(cw + j * 1024 + c8); w1[j] = *(const f32x4*)(cw + j * 1024 + c8 + 4); }
    v4u x[7];
#pragma unroll
    for (int r = 0; r < 7; ++r) { const int ts = tt0 - 3 + r; x[r] = (ts >= 0) ? *(const v4u*)(srcseg + (rowb + ts) * 512 + h * 128 + c8) : (v4u){0u, 0u, 0u, 0u}; }
#pragma unroll
    for (int i = 0; i < 4; ++i) { float acc[8] = {0.f, 0.f, 0.f, 0.f, 0.f, 0.f, 0.f, 0.f};
#pragma unroll
        for (int j = 0; j < 4; ++j) { const v4u xv = x[i + j];
            acc[0] += w0[j].x * bflo(xv.x); acc[1] += w0[j].y * bfhi(xv.x); acc[2] += w0[j].z * bflo(xv.y); acc[3] += w0[j].w * bfhi(xv.y);
            acc[4] += w1[j].x * bflo(xv.z); acc[5] += w1[j].y * bfhi(xv.z); acc[6] += w1[j].z * bflo(xv.w); acc[7] += w1[j].w * bfhi(xv.w); }
        float sc = scale; if (ROWSCALE) sc *= rs[s0 + i];
        v4u o; o.x = pk2(siluf_(acc[0]) * sc, siluf_(acc[1]) * sc); o.y = pk2(siluf_(acc[2]) * sc, siluf_(acc[3]) * sc); o.z = pk2(siluf_(acc[4]) * sc, siluf_(acc[5]) * sc); o.w = pk2(siluf_(acc[6]) * sc, siluf_(acc[7]) * sc);
        *(LAS v4u*)(img + (s0 + i) * mx::LP + c8) = o; }
}
__device__ __forceinline__ void stage_copy(const Frame& F, LAS bf16* img, const bf16* srcseg, size_t row0, int h) {
#pragma unroll
    for (int i = 0; i < 4; ++i) { const int e = F.tid + NTHR * i, s = e >> 4, c8 = (e & 15) * 8;
        *(LAS v4u*)(img + s * mx::LP + c8) = *(const v4u*)(srcseg + (row0 + s) * 512 + h * 128 + c8); }
}

__device__ __forceinline__ void mlstm_m1_mfma(const Frame& F, int l) {
    using namespace mx;
    const bf16* MLK = seg(F, S_MLK); const bf16* MLV = seg(F, S_MLV);
    const float* cw = inptr(F, 5) + (size_t)l * 4 * 1024;
    const float* mli = (const float*)(F.ws + WS_MLI); const float* mlf = (const float*)(F.ws + WS_MLF);
    float* UC = F.XF; float* NV = (float*)(F.ws + WS_NV); float* MST = (float*)(F.ws + WS_MST);
    LAS bf16* Kl = (LAS bf16*)F.lds; LAS bf16* Vl = (LAS bf16*)(F.lds + IMG);
    LAS float* sg = (LAS float*)(F.lds + 2 * IMG);
    const int lane = F.lane, hi = lane >> 5, db = F.wave & 3, eh = F.wave >> 2;
    for (int it = F.bid; it < 1024; it += F.G) {
        const int bh4 = it >> 5, c = it & 31, b = bh4 >> 2, h = bh4 & 3;
        const size_t rowb = (size_t)b * SEQ, row0 = rowb + c * 128;
        __syncthreads();
        float mg, blast;
        { const bool act = F.tid < 128; const float lf = act ? mlf[(row0 + F.tid) * 4 + h] : 0.f, li = act ? mli[(row0 + F.tid) * 4 + h] : 0.f;
          const float bc = scan128_sum(lf, F.tid, F.lane, sg + 384);
          if (F.tid == 127) sg[385] = bc;
          __syncthreads();
          blast = sg[385];
          const float g = blast - bc + li;
          float gm = act ? g : -INFINITY; gm = wave_max(gm);
          if (F.lane == 0 && F.wave < 2) sg[386 + F.wave] = gm;
          __syncthreads();
          mg = fmaxf(sg[386], sg[387]);
          if (act) sg[256 + F.tid] = fexp(g - mg);
          __syncthreads(); }
        stage_conv<true>(F, Kl, MLK, rowb, c, h, cw + 512 + h * 128, 0.08838834764831845f, sg + 256);
        stage_copy(F, Vl, MLV, row0, h);
        __syncthreads();
        f32x16 u0 = {}, u1 = {};
#pragma unroll
        for (int ks = 0; ks < 8; ++ks) { const bf16x8 a = frag_tr(Kl, 16 * ks, 32 * db, lane);
            u0 = MX_MFMA(a, frag_tr(Vl, 16 * ks, 64 * eh, lane), u0); u1 = MX_MFMA(a, frag_tr(Vl, 16 * ks, 64 * eh + 32, lane), u1); }
        bf16* Uo = (bf16*)UC + (size_t)it * 16384;
#pragma unroll
        for (int r = 0; r < 16; ++r) { const int d = 32 * db + crow(r, hi); Uo[d * 128 + 64 * eh + (lane & 31)] = (bf16)f2bf(u0[r]); Uo[d * 128 + 64 * eh + 32 + (lane & 31)] = (bf16)f2bf(u1[r]); }
        if (F.tid < 128) { float n0 = 0.f, n1 = 0.f, n2 = 0.f, n3 = 0.f;
#pragma unroll 2
            for (int s = 0; s < 128; s += 4) { n0 += bf2f(Kl[s * LP + F.tid]); n1 += bf2f(Kl[(s + 1) * LP + F.tid]); n2 += bf2f(Kl[(s + 2) * LP + F.tid]); n3 += bf2f(Kl[(s + 3) * LP + F.tid]); }
            NV[(size_t)it * 128 + F.tid] = (n0 + n1) + (n2 + n3); }
        if (F.tid == 0) { MST[it * 4] = mg; MST[it * 4 + 1] = blast; }
    }
    __syncthreads();
}

__device__ __forceinline__ void mlstm_m3_mfma(const Frame& F, int l) {
    using namespace mx;
    const bf16* MLQ = seg(F, S_MLQ); const bf16* MLK = seg(F, S_MLK); bf16* MLV = seg(F, S_MLV); const bf16* MLO = seg(F, S_MLO);
    const float* cw = inptr(F, 5) + (size_t)l * 4 * 1024;
    const float* mli = (const float*)(F.ws + WS_MLI); const float* mlf = (const float*)(F.ws + WS_MLF);
    const float* UC = (const float*)F.XF; const float* NV = (const float*)(F.ws + WS_NV); const float* MST = (const float*)(F.ws + WS_MST);
    LAS bf16* Ql = (LAS bf16*)F.lds; LAS bf16* Kl = (LAS bf16*)(F.lds + IMG); LAS bf16* Vl = (LAS bf16*)(F.lds + 2 * IMG); LAS bf16* Cl = (LAS bf16*)(F.lds + 3 * IMG);
    LAS float* sg = (LAS float*)(F.lds + 4 * IMG);
    static_assert(4 * IMG + (768 + 256) * 4 <= SCR_BYTES, "M3 LDS map");
    const int qb = F.wave & 3, eh = F.wave >> 2;
    for (int it = F.bid; it < 1024; it += F.G) {
        int lane = F.lane; asm volatile("" : "+v"(lane));
        const int hi = lane >> 5, r32 = lane & 31;
        const int bh4 = it >> 5, c = it & 31, b = bh4 >> 2, h = bh4 & 3;
        const size_t rowb = (size_t)b * SEQ, row0 = rowb + c * 128;
        const float m_in = MST[it * 4 + 2];
        __syncthreads();
#if defined(EXPT) && EXPT == 6
        if (F.cpass != 0)
#endif
        { const bool act = F.tid < 128; const float lf = act ? mlf[(row0 + F.tid) * 4 + h] : 0.f, li = act ? mli[(row0 + F.tid) * 4 + h] : 0.f;
          if (act) sg[512 + F.tid] = NV[(size_t)it * 128 + F.tid];
          const float bc = scan128_sum(lf, F.tid, F.lane, sg + 640);
          const float a = li - bc;
          const float pm = scan128_max(act ? a : -INFINITY, F.tid, F.lane, sg + 641);
          if (act) { const float inter = bc + m_in, mt = fmaxf(inter, bc + pm);
              sg[128 + F.tid] = a; sg[256 + F.tid] = fexp(inter - mt); sg[384 + F.tid] = fexp(-mt); sg[F.tid] = bc - mt; } }
#if defined(EXPT) && EXPT == 7
        if (F.cpass != 0)
#endif
        { stage_conv<false>(F, Ql, MLQ, rowb, c, h, cw + h * 128, 1.f, nullptr);
        stage_conv<false>(F, Kl, MLK, rowb, c, h, cw + 512 + h * 128, 0.08838834764831845f, nullptr); }
        stage_copy(F, Vl, MLV, row0, h);
        { const bf16* Cg = (const bf16*)UC + (size_t)it * 16384;
#pragma unroll
          for (int i = 0; i < 4; ++i) { const int e = F.tid + NTHR * i, d = e >> 4, c8 = (e & 15) * 8; *(LAS v4u*)(Cl + d * LP + c8) = *(const v4u*)(Cg + d * 128 + c8); } }
        __syncthreads();
        const int t = 32 * qb + r32;
        const float btl = sg[t];
        f32x16 o0 = {}, o1 = {}; float den = 0.f;
#pragma nounroll
        for (int j = 0; j <= qb; ++j) {
            f32x16 s = {};
#pragma unroll
            for (int ks = 0; ks < 8; ++ks) s = MX_MFMA(frag_row(Kl, 32 * j, 16 * ks, lane), frag_row(Ql, 32 * qb, 16 * ks, lane), s);
#pragma unroll
            for (int g = 0; g < 4; ++g) { const f32x4 av = *(const LAS f32x4*)(sg + 128 + 32 * j + 8 * g + 4 * hi);
#pragma unroll
                for (int i = 0; i < 4; ++i) { const int kv = 32 * j + 8 * g + 4 * hi + i; const float p = (kv <= t) ? s[4 * g + i] * fexp(btl + av[i]) : 0.f; s[4 * g + i] = p; den += p; } }
#pragma unroll
            for (int k2 = 0; k2 < 2; ++k2) { const bf16x8 pa = pack8(s, k2);
                o0 = MX_MFMA(pa, frag_tr_acc(Vl, 32 * j + 16 * k2, 64 * eh, lane), o0); o1 = MX_MFMA(pa, frag_tr_acc(Vl, 32 * j + 16 * k2, 64 * eh + 32, lane), o1); }
        }
        f32x16 c0 = {}, c1 = {};
#pragma unroll
        for (int ks = 0; ks < 8; ++ks) { const bf16x8 a = frag_row(Ql, 32 * qb, 16 * ks, lane);
            c0 = MX_MFMA(a, frag_tr(Cl, 16 * ks, 64 * eh, lane), c0); c1 = MX_MFMA(a, frag_tr(Cl, 16 * ks, 64 * eh + 32, lane), c1); }
        float qn = 0.f;
#pragma unroll
        for (int i = 0; i < 8; ++i) { const v4u qv = *(const LAS v4u*)(Ql + t * LP + 64 * hi + 8 * i); const LAS float* np = sg + 512 + 64 * hi + 8 * i;
            qn += bflo(qv.x) * np[0] + bfhi(qv.x) * np[1] + bflo(qv.y) * np[2] + bfhi(qv.y) * np[3] + bflo(qv.z) * np[4] + bfhi(qv.z) * np[5] + bflo(qv.w) * np[6] + bfhi(qv.w) * np[7]; }
        den = swap_add(den); qn = swap_add(qn);
        const float dtot = den + sg[256 + t] * qn;
        LAS float* wd = sg + 768 + F.wave * 32;
        if (hi == 0) wd[r32] = 1.f / fmaxf(fabsf(dtot), sg[384 + t]);
        asm volatile("s_waitcnt lgkmcnt(0)" ::: "memory");
#if defined(EXPT) && EXPT == 5
        if (F.cpass != 0)
#endif
        { bf16 g0[16], g1[16];
#pragma unroll
          for (int r = 0; r < 16; ++r) { const int tq = 32 * qb + crow(r, hi); const size_t o = (row0 + tq) * 512 + h * 128 + 64 * eh + r32; g0[r] = MLO[o]; g1[r] = MLO[o + 32]; }
          asm volatile("" ::: "memory");
#pragma unroll
          for (int r = 0; r < 16; ++r) { const int tl = crow(r, hi), tq = 32 * qb + tl; const float wi = sg[256 + tq], rd = wd[tl];
            const size_t o = (row0 + tq) * 512 + h * 128 + 64 * eh + r32;
            MLV[o] = (bf16)f2bf(bf2f(g0[r]) * (o0[r] + wi * c0[r]) * rd); MLV[o + 32] = (bf16)f2bf(bf2f(g1[r]) * (o1[r] + wi * c1[r]) * rd); } }
    }
    __syncthreads();
}


using pg8::Unit;
template <int K, int nM, int nN, int RB, int CB> struct SchedPlain {
    static_assert(RB * CB == 32 && nM % RB == 0 && nN % CB == 0, "block shape"); static constexpr bool GATHER = false;
    __device__ __forceinline__ unsigned rowoff(const Unit&, int) const { return 0u; }
    const char* A; const char* B; int G, c;
    __device__ __forceinline__ int ktiles() const { return K / 64; }
    __device__ __forceinline__ int lda() const { return K; }
    __device__ __forceinline__ int ldb() const { return K; }
    __device__ __forceinline__ bool next(int i, Unit& u) const {
        u.ex = 0;
        if (G == 256) { const int x = c & 7, j = c >> 3, bi = 8 * i + x; constexpr int nrb = nM / RB, ncb = nN / CB; if (bi >= nrb * ncb) return false;
            u.pm = (bi % nrb) * RB + (j % RB); u.pn = (bi / nrb) * CB + (j / RB); return true; }
        const int L = i * G + c; if (L >= nM * nN) return false; u.pm = L % nM; u.pn = L / nM; return true; }
    __device__ __forceinline__ const char* aptr(const Unit& u, int t) const { return A + ((size_t)u.pm * 256 * K + (size_t)t * 64) * 2; }
    __device__ __forceinline__ const char* bptr(const Unit& u, int t) const { return B + ((size_t)u.pn * 256 * K + (size_t)t * 64) * 2; }
};
struct SchedInProj {
    static constexpr bool GATHER = false;
    const char* A; const char* B; int G, c;
    __device__ __forceinline__ unsigned rowoff(const Unit&, int) const { return 0u; }
    __device__ __forceinline__ int ktiles() const { return 8; }
    __device__ __forceinline__ int lda() const { return 512; }
    __device__ __forceinline__ int ldb() const { return 512; }
    __device__ __forceinline__ bool next(int i, Unit& u) const {
        u.ex = 0; u.nv = 256;
        if (G == 256) { const int x = c & 7, j = c >> 3; if (i >= 15) return false;
            if (i < 14) { const int bi = 8 * i + x; u.pm = (bi & 15) * 8 + (j & 7); u.pn = (bi >> 4) * 4 + (j >> 3); }
            else { u.pm = x * 16 + (j & 15); u.pn = 28 + (j >> 4); }
            return true; }
        const int L = i * G + c; if (L >= 128 * 30) return false; u.pm = L % 128; u.pn = L / 128; return true; }
    __device__ __forceinline__ const char* aptr(const Unit& u, int t) const { return A + (size_t)u.pm * 256 * 1024 + (size_t)t * 128; }
    __device__ __forceinline__ const char* bptr(const Unit& u, int t) const { return B + (size_t)u.pn * 256 * 1024 + (size_t)t * 128; }
};
struct SchedMerge {
    static constexpr bool GATHER = false;
    __device__ __forceinline__ unsigned rowoff(const Unit&, int) const { return 0u; }
    const char* H0; const char* B; int G, c;
    __device__ __forceinline__ int ktiles() const { return 24; }
    __device__ __forceinline__ int lda() const { return 512; }
    __device__ __forceinline__ int ldb() const { return 1536; }
    __device__ __forceinline__ bool next(int i, Unit& u) const { u.ex = 0;
        if (G == 256) { const int x = c & 7, j = c >> 3, bi = 8 * i + x; if (bi >= 16) return false; u.pm = bi * 8 + (j & 7); u.pn = j >> 3; return true; }
        const int L = i * G + c; if (L >= 128 * 4) return false; u.pm = L >> 2; u.pn = L & 3; return true; }
    __device__ __forceinline__ const char* aptr(const Unit& u, int t) const { const int s = t >> 3; return H0 + ((size_t)(5 * s - 3 * (s >> 1)) * SEGE + (size_t)u.pm * 256 * 512 + (size_t)(t & 7) * 64) * 2; }
    __device__ __forceinline__ const char* bptr(const Unit& u, int t) const { return B + ((size_t)u.pn * 256 * 1536 + (size_t)t * 64) * 2; }
};
constexpr int MOE_CAP = 32768;
template <int K, int ROWB, bool BYTOK> struct SchedMoe {
    static constexpr bool GATHER = true;
    const char* A; const char* B; const int* ent2; int ntiles; const LAS int* tile_e; const LAS int* pst; const LAS int* cntl; int G, c;
    __device__ __forceinline__ int ktiles() const { return K / 64; }
    __device__ __forceinline__ int lda() const { return K; }
    __device__ __forceinline__ int ldb() const { return K; }
    __device__ __forceinline__ bool next(int i, Unit& u) const {
        int gt;
        if (G == 256) { const int x = c & 7, j = c >> 3; gt = (8 * i + x) * 8 + (j & 7); u.pn = j >> 3; if ((8 * i + x) * 8 >= ntiles) return false; if (gt >= ntiles) gt = ntiles - 1; }
        else { const int L = i * G + c; if (L >= ntiles * 4) return false; gt = L >> 2; u.pn = L & 3; }
        u.gt = gt; u.ex = __builtin_amdgcn_readfirstlane(tile_e[gt]); u.pm = gt - __builtin_amdgcn_readfirstlane(pst[u.ex]);
        const int left = __builtin_amdgcn_readfirstlane(cntl[u.ex]) - 256 * u.pm; u.nv = left < 256 ? left : 256; return true; }
    __device__ __forceinline__ const char* aptr(const Unit&, int t) const { return A + (size_t)t * 128; }
    __device__ __forceinline__ const char* bptr(const Unit& u, int t) const { return B + (((size_t)u.ex * 1024 + (size_t)u.pn * 256) * K + (size_t)t * 64) * 2; }
    __device__ __forceinline__ unsigned rowoff(const Unit& u, int r) const {
        const int rc = r < u.nv ? r : u.nv - 1;
        const int slot = ent2[(size_t)u.ex * MOE_CAP + 256 * u.pm + rc]; return (unsigned)(BYTOK ? (slot >> 1) : slot) * (unsigned)ROWB; }
};

struct SchedMoe1 {
    static constexpr bool GATHER = true;
    const char* A; const char* B; const int* ent2; int ntiles; const LAS int* tile_e; const LAS int* pst; const LAS int* cntl; int G, c;
    __device__ __forceinline__ int ktiles() const { return 8; }
    __device__ __forceinline__ int lda() const { return 512; }
    __device__ __forceinline__ int ldb() const { return 512; }
    __device__ __forceinline__ bool next(int i, Unit& u) const {
        int gt;
        if (G == 256) { const int x = c & 7, j = c >> 3; gt = (8 * i + x) * 8 + (j & 7); u.pn = j >> 3; if ((8 * i + x) * 8 >= ntiles) return false; if (gt >= ntiles) gt = ntiles - 1; }
        else { const int L = i * G + c; if (L >= ntiles * 4) return false; gt = L >> 2; u.pn = L & 3; }
        u.gt = gt; u.ex = __builtin_amdgcn_readfirstlane(tile_e[gt]); u.pm = gt - __builtin_amdgcn_readfirstlane(pst[u.ex]);
        const int left = __builtin_amdgcn_readfirstlane(cntl[u.ex]) - 256 * u.pm; u.nv = left < 256 ? left : 256; return true; }
    __device__ __forceinline__ const char* aptr(const Unit&, int t) const { return A + (size_t)t * 128; }
    __device__ __forceinline__ const char* bptr(const Unit& u, int t) const { return B + ((size_t)u.ex * 1024 + (size_t)u.pn * 256) * 1024 + (size_t)t * 128; }
    __device__ __forceinline__ unsigned rowoff(const Unit& u, int r) const {
        const int rc = r < u.nv ? r : u.nv - 1;
        const int slot = ent2[(size_t)u.ex * MOE_CAP + 256 * u.pm + rc]; return (unsigned)(slot >> 1) * 1024u; }
};
struct SchedMoe2 {
    static constexpr bool GATHER = false;
    const char* A; const char* B; int ntiles; const LAS int* tile_e; const LAS int* pst; const LAS int* cntl; int G, c;
    __device__ __forceinline__ unsigned rowoff(const Unit&, int) const { return 0u; }
    __device__ __forceinline__ int ktiles() const { return 4; }
    __device__ __forceinline__ int lda() const { return 256; }
    __device__ __forceinline__ int ldb() const { return 256; }
    __device__ __forceinline__ bool next(int i, Unit& u) const {
        int gt;
        if (G == 256) { const int x = c & 7, j = c >> 3; gt = (8 * i + x) * 8 + (j & 7); u.pn = j >> 3; if ((8 * i + x) * 8 >= ntiles) return false; if (gt >= ntiles) gt = ntiles - 1; }
        else { const int L = i * G + c; if (L >= ntiles * 4) return false; gt = L >> 2; u.pn = L & 3; }
        u.gt = gt; u.ex = __builtin_amdgcn_readfirstlane(tile_e[gt]); u.pm = gt - __builtin_amdgcn_readfirstlane(pst[u.ex]);
        const int left = __builtin_amdgcn_readfirstlane(cntl[u.ex]) - 256 * u.pm; u.nv = left < 256 ? left : 256; return true; }
    __device__ __forceinline__ const char* aptr(const Unit& u, int t) const { return A + (size_t)u.gt * 256 * 512 + (size_t)t * 128; }
    __device__ __forceinline__ const char* bptr(const Unit& u, int t) const { return B + ((size_t)u.ex * 1024 + (size_t)u.pn * 256) * 512 + (size_t)t * 128; }
};

typedef pg8::f32x4 (AccT)[2][2][4][2];
__device__ __forceinline__ void st16_wt(void* p, v4u v) { asm volatile("global_store_dwordx4 %0, %1, off sc1\n\ts_nop 1" :: "v"(p), "v"(v) : "memory"); }
__device__ __forceinline__ void st8_wt(void* p, v2u v) { asm volatile("global_store_dwordx2 %0, %1, off sc1\n\ts_nop 1" :: "v"(p), "v"(v) : "memory"); }
__device__ __forceinline__ unsigned char* gate_tile(bf16* H, int pm, int gt) { return (unsigned char*)(H + (size_t)S_G0 * SEGE) + ((size_t)(gt >> 2) * 128 * 4 + (size_t)pm * 4 + (gt & 3)) * 65536; }
__device__ __forceinline__ unsigned gate_q(float g) { const float q = fmaxf(__builtin_rintf(g * 255.f), 1.f); return (unsigned)q; }
struct EpiInProj {
    static constexpr bool PERM = true, HAS_MID = false, F8 = false, I8 = true; static constexpr int SEG = 0;
    bf16* H; const float* bias; const float* sA; const unsigned* cmax;
    __device__ __forceinline__ void mid(AccT&, const Unit&, int, int, int, int, int) const {}
    __device__ __forceinline__ void operator()(AccT& acc, const Unit& u, int wr, int wc, int fr, int fq) const {
        asm volatile("" : "+v"(fr), "+v"(fq));
        const int sg = u.pn >> 1; bf16* base = H + (size_t)sg * SEGE;
        const int act = (sg == S_Q) ? 1 : ((sg == S_MLO) ? 2 : ((sg == S_SU || sg == S_SV) ? 3 : 0));
        const int row0 = u.pm * 256 + wr * 64 + fr, col0 = (u.pn & 1) * 256 + wc * 32 + 8 * fq, bcol0 = u.pn * 256 + wc * 32 + 8 * fq;
        const int tid8 = (((wr * 4 + wc) * 64) + fq * 16 + fr) * 8;
        f32x4 bv[2][2], sw[2][2]; float sa8[2][4];
#pragma unroll
        for (int ai = 0; ai < 2; ++ai)
#pragma unroll
            for (int m = 0; m < 4; ++m) sa8[ai][m] = sA[row0 + ai * 128 + m * 16];
#pragma unroll
        for (int bj = 0; bj < 2; ++bj)
#pragma unroll
            for (int n = 0; n < 2; ++n) { bv[bj][n] = *(const f32x4*)(bias + bcol0 + bj * 128 + 4 * n); { const float c0 = __builtin_bit_cast(float, cmax[(bcol0 + bj * 128) >> 5]) * (1.f / 127.f); sw[bj][n] = (f32x4){c0, c0, c0, c0}; }
            }
        if (sg >= S_G0) {
            unsigned char* gt = gate_tile(H, u.pm, u.pn - 2 * S_G0) + 2 * tid8;
#pragma unroll
            for (int bj = 0; bj < 2; ++bj)
#pragma unroll
                for (int n = 0; n < 2; ++n) { bv[bj][n] = bv[bj][n] * (-LOG2E); sw[bj][n] = sw[bj][n] * (-LOG2E); }
#pragma unroll
            for (int ai = 0; ai < 2; ++ai)
#pragma unroll
                for (int m = 0; m < 4; ++m) { const float sa = sa8[ai][m]; unsigned q[2][2] = {{0u, 0u}, {0u, 0u}};
#pragma unroll
                    for (int bj = 0; bj < 2; ++bj) { const pg8::i32x4 i0 = __builtin_bit_cast(pg8::i32x4, acc[ai][bj][m][0]), i1 = __builtin_bit_cast(pg8::i32x4, acc[ai][bj][m][1]);
                        const float sc = sa * sw[bj][0][0];
#pragma unroll
                        for (int i = 0; i < 4; ++i) {
                            const float e0 = fexp2((float)i0[i] * sc + bv[bj][0][i]), e1 = fexp2((float)i1[i] * sc + bv[bj][1][i]);
                            const float c0 = fmaxf(__builtin_rintf(frcp(e0 * (1.f / 255.f) + (1.f / 255.f))), 1.f), c1 = fmaxf(__builtin_rintf(frcp(e1 * (1.f / 255.f) + (1.f / 255.f))), 1.f);
                            q[bj][0] = __builtin_amdgcn_cvt_pk_u8_f32(c0, (unsigned)i, q[bj][0]); q[bj][1] = __builtin_amdgcn_cvt_pk_u8_f32(c1, (unsigned)i, q[bj][1]); } }
                    v4u qq; qq.x = q[0][0]; qq.y = q[0][1]; qq.z = q[1][0]; qq.w = q[1][1];
                    st16_wt(gt + (size_t)((ai * 4 + m) * 8192), qq); }
            return; }
        { const float fs = (act == 1) ? QSCALE : ((act == 2) ? -LOG2E : 1.f);
#pragma unroll
          for (int bj = 0; bj < 2; ++bj)
#pragma unroll
            for (int n = 0; n < 2; ++n) { bv[bj][n] = bv[bj][n] * fs; sw[bj][n] = sw[bj][n] * fs; } }
        constexpr float GC1 = -2.f * LOG2E * 0.7978845608028654f, GC2 = GC1 * 0.044715f;
#pragma unroll
        for (int ai = 0; ai < 2; ++ai)
#pragma unroll
            for (int m = 0; m < 4; ++m) { const int row = row0 + ai * 128 + m * 16; bf16* rowp = base + (size_t)row * 512 + col0; const float sa = sa8[ai][m];
#pragma unroll
                for (int bj = 0; bj < 2; ++bj) { const pg8::i32x4 i0 = __builtin_bit_cast(pg8::i32x4, acc[ai][bj][m][0]), i1 = __builtin_bit_cast(pg8::i32x4, acc[ai][bj][m][1]); f32x4 v0, v1;
                    const float sc = sa * sw[bj][0][0];
#pragma unroll
                    for (int i = 0; i < 4; ++i) { v0[i] = (float)i0[i] * sc + bv[bj][0][i]; v1[i] = (float)i1[i] * sc + bv[bj][1][i]; }
                    if (act == 2) {
#pragma unroll
                        for (int i = 0; i < 4; ++i) { v0[i] = frcp(1.f + fexp2(v0[i])); v1[i] = frcp(1.f + fexp2(v1[i])); } }
                    else if (act == 3) {
#pragma unroll
                        for (int i = 0; i < 4; ++i) { const float x0 = v0[i], x1 = v1[i];
                            v0[i] = x0 * frcp(1.f + fexp2(x0 * (GC1 + GC2 * x0 * x0))); v1[i] = x1 * frcp(1.f + fexp2(x1 * (GC1 + GC2 * x1 * x1))); } }
                    v4u w; w.x = pg8::cvt_pk_bf16(v0[0], v0[1]); w.y = pg8::cvt_pk_bf16(v0[2], v0[3]); w.z = pg8::cvt_pk_bf16(v1[0], v1[1]); w.w = pg8::cvt_pk_bf16(v1[2], v1[3]);
                    st16_wt(rowp + bj * 128, w); } }
    }
};
struct EpiMerge {
    static constexpr bool PERM = true, HAS_MID = true, F8 = false, I8 = false;
    bf16* Hb;
    bf16* O;
    template <int MODE>
    __device__ __forceinline__ void scale(AccT& acc, const Unit& u, int n, int wr, int wc, int fr, int fq) const {
        const int tid16 = (((wr * 4 + wc) * 64) + fq * 16 + fr) * 16;
        const unsigned char* g0 = gate_tile(Hb, u.pm, n * 4 + u.pn) + tid16; const unsigned char* g1 = gate_tile(Hb, u.pm, (MODE == 0 ? n + 1 : n) * 4 + u.pn) + tid16;
#pragma unroll
        for (int ai = 0; ai < 2; ++ai) {
            v2u ga[4][2], gb[4][2];
#pragma unroll
            for (int m = 0; m < 4; ++m) { const int fo = (ai * 4 + m) * 8192; const v4u a4 = *(const v4u*)(g0 + fo); ga[m][0].x = a4.x; ga[m][0].y = a4.y; ga[m][1].x = a4.z; ga[m][1].y = a4.w;
                if (MODE == 0) { const v4u b4 = *(const v4u*)(g1 + fo); gb[m][0].x = b4.x; gb[m][0].y = b4.y; gb[m][1].x = b4.z; gb[m][1].y = b4.w; } }
            asm volatile("" ::: "memory");
#pragma unroll
            for (int m = 0; m < 4; ++m) {
#pragma unroll
                for (int bj = 0; bj < 2; ++bj) { const v2u a = ga[m][bj];
                    float r[8] = {(float)(a.x & 255u), (float)((a.x >> 8) & 255u), (float)((a.x >> 16) & 255u), (float)(a.x >> 24), (float)(a.y & 255u), (float)((a.y >> 8) & 255u), (float)((a.y >> 16) & 255u), (float)(a.y >> 24)};
                    if (MODE == 0) { const v2u b = gb[m][bj];
                        const float d[8] = {(float)(b.x & 255u), (float)((b.x >> 8) & 255u), (float)((b.x >> 16) & 255u), (float)(b.x >> 24), (float)(b.y & 255u), (float)((b.y >> 8) & 255u), (float)((b.y >> 16) & 255u), (float)(b.y >> 24)};
#pragma unroll
                        for (int i = 0; i < 8; ++i) r[i] = r[i] * frcp(fmaxf(d[i], 1.f)); }
                    else {
#pragma unroll
                        for (int i = 0; i < 8; ++i) r[i] *= (1.f / 255.f); }
#pragma unroll
                    for (int i = 0; i < 4; ++i) { acc[ai][bj][m][0][i] *= r[i]; acc[ai][bj][m][1][i] *= r[4 + i]; } } } }
    }
    static constexpr int SEG = 8;
    __device__ __forceinline__ void mid(AccT& acc, const Unit& u, int t, int wr, int wc, int fr, int fq) const { scale<0>(acc, u, (t >> 3) - 1, wr, wc, fr, fq); }
    __device__ __forceinline__ void operator()(AccT& acc, const Unit& u, int wr, int wc, int fr, int fq) const {
        scale<1>(acc, u, 2, wr, wc, fr, fq);
        const int row0 = u.pm * 256 + wr * 64 + fr, col0 = u.pn * 256 + wc * 32 + 8 * fq;
#pragma unroll
        for (int ai = 0; ai < 2; ++ai)
#pragma unroll
            for (int m = 0; m < 4; ++m) { bf16* rowp = O + (size_t)(row0 + ai * 128 + m * 16) * 1024 + col0;
#pragma unroll
                for (int bj = 0; bj < 2; ++bj) { const f32x4 v0 = acc[ai][bj][m][0], v1 = acc[ai][bj][m][1];
                    v4u w; w.x = pg8::cvt_pk_bf16(v0[0], v0[1]); w.y = pg8::cvt_pk_bf16(v0[2], v0[3]); w.z = pg8::cvt_pk_bf16(v1[0], v1[1]); w.w = pg8::cvt_pk_bf16(v1[2], v1[3]);
                    *(v4u*)(rowp + bj * 128) = w; } }
    }
};
struct EpiWout {
    static constexpr bool PERM = true, HAS_MID = false, F8 = false, I8 = false; static constexpr int SEG = 0;
    bf16* XB;
    __device__ __forceinline__ void mid(AccT&, const Unit&, int, int, int, int, int) const {}
    __device__ __forceinline__ void operator()(AccT& acc, const Unit& u, int wr, int wc, int fr, int fq) const {
        const int row0 = u.pm * 256 + wr * 64 + fr, col0 = u.pn * 256 + wc * 32 + 8 * fq;
#pragma unroll
        for (int ai = 0; ai < 2; ++ai) {
            v4u xs[4][2];
#pragma unroll
            for (int m = 0; m < 4; ++m)
#pragma unroll
                for (int bj = 0; bj < 2; ++bj) xs[m][bj] = *(const v4u*)(XB + (size_t)(row0 + ai * 128 + m * 16) * 1024 + col0 + bj * 128);
            asm volatile("" ::: "memory");
#pragma unroll
            for (int m = 0; m < 4; ++m) { bf16* rowp = XB + (size_t)(row0 + ai * 128 + m * 16) * 1024 + col0;
#pragma unroll
                for (int bj = 0; bj < 2; ++bj) { const v4u x = xs[m][bj]; const f32x4 v0 = acc[ai][bj][m][0], v1 = acc[ai][bj][m][1];
                    v4u w; w.x = pg8::cvt_pk_bf16(ALPHA * bflo(x.x) + v0[0], ALPHA * bfhi(x.x) + v0[1]); w.y = pg8::cvt_pk_bf16(ALPHA * bflo(x.y) + v0[2], ALPHA * bfhi(x.y) + v0[3]);
                    w.z = pg8::cvt_pk_bf16(ALPHA * bflo(x.z) + v1[0], ALPHA * bfhi(x.z) + v1[1]); w.w = pg8::cvt_pk_bf16(ALPHA * bflo(x.w) + v1[2], ALPHA * bfhi(x.w) + v1[3]);
                    *(v4u*)(rowp + bj * 128) = w; } }
            asm volatile("" ::: "memory"); }
    }
};
constexpr float HSCALE = 8.f;
__device__ __forceinline__ unsigned f8pk4s(float a, float b, float c, float d, float sc) { int w = 0; w = __builtin_amdgcn_cvt_pk_fp8_f32(f8clamp(a * sc), f8clamp(b * sc), w, false); w = __builtin_amdgcn_cvt_pk_fp8_f32(f8clamp(c * sc), f8clamp(d * sc), w, true); return (unsigned)w; }
struct EpiMoe1 {
    static constexpr bool PERM = true, HAS_MID = false, F8 = true, I8 = false; static constexpr int SEG = 0;
    unsigned char* HID;
    __device__ __forceinline__ void mid(AccT&, const Unit&, int, int, int, int, int) const {}
    __device__ __forceinline__ void operator()(AccT& acc, const Unit& u, int wr, int wc, int fr, int fq) const {
        asm volatile("" : "+v"(fr), "+v"(fq));
        const int r0 = wr * 64 + fr, col0 = u.pn * 128 + wc * 32 + 8 * fq; unsigned char* tp = HID + (size_t)u.gt * 256 * 512 + col0;
#pragma unroll
        for (int ai = 0; ai < 2; ++ai)
#pragma unroll
            for (int m = 0; m < 4; ++m) { const int r = r0 + ai * 128 + m * 16;
                if (r < u.nv) { float h[8];
#pragma unroll
                    for (int i = 0; i < 4; ++i) { h[i] = siluf_(acc[ai][0][m][0][i] * W8INV) * acc[ai][1][m][0][i]; h[4 + i] = siluf_(acc[ai][0][m][1][i] * W8INV) * acc[ai][1][m][1][i]; }
                    v2u w; w.x = f8pk4s(h[0], h[1], h[2], h[3], W8INV * HSCALE); w.y = f8pk4s(h[4], h[5], h[6], h[7], W8INV * HSCALE);
                    *(v2u*)(tp + (size_t)r * 512) = w; }
                asm volatile("" ::: "memory"); }
    }
};
constexpr float YSCALE = 16.f, YINV = 1.f / 16.f;
struct EpiMoe2 {
    static constexpr bool PERM = true, HAS_MID = false, F8 = true, I8 = false; static constexpr int SEG = 0;
    unsigned char* Y; const int* ent2;
    __device__ __forceinline__ void mid(AccT&, const Unit&, int, int, int, int, int) const {}
    __device__ __forceinline__ void operator()(AccT& acc, const Unit& u, int wr, int wc, int fr, int fq) const {
        asm volatile("" : "+v"(fr), "+v"(fq));
        const int r0 = wr * 64 + fr, col0 = u.pn * 256 + wc * 32 + 8 * fq; const int* ep = ent2 + (size_t)u.ex * MOE_CAP + 256 * u.pm;
        constexpr float sc = YSCALE / (W8SCALE * HSCALE);
        int slot[2][4];
#pragma unroll
        for (int ai = 0; ai < 2; ++ai)
#pragma unroll
            for (int m = 0; m < 4; ++m) { const int r = r0 + ai * 128 + m * 16; slot[ai][m] = ep[r < u.nv ? r : u.nv - 1]; }
#pragma unroll
        for (int ai = 0; ai < 2; ++ai)
#pragma unroll
            for (int m = 0; m < 4; ++m) { const int r = r0 + ai * 128 + m * 16;
                if (r < u.nv) { unsigned char* rowp = Y + (size_t)slot[ai][m] * 1024 + col0;
#pragma unroll
                    for (int bj = 0; bj < 2; ++bj) { const f32x4 v0 = acc[ai][bj][m][0], v1 = acc[ai][bj][m][1];
                        v2u w; w.x = f8pk4s(v0[0], v0[1], v0[2], v0[3], sc); w.y = f8pk4s(v1[0], v1[1], v1[2], v1[3], sc);
                        *(v2u*)(rowp + bj * 128) = w; } }
                asm volatile("" ::: "memory"); }
    }
};

#include <hip/hip_bf16.h>
#include <cmath>
namespace attn_body {
using bf16=__hip_bfloat16;
using bf16x8=__attribute__((ext_vector_type(8)))short;
using s16x4=__attribute__((ext_vector_type(4)))short;
using f32x16=__attribute__((ext_vector_type(16)))float;
using u32x4=__attribute__((ext_vector_type(4)))unsigned;
constexpr int BATCH=8,NHEAD=8,SEQ=4096,D=64,DM=NHEAD*D;
constexpr int NW=8,QBLK=32,QB=QBLK*NW,KVBLK=64,NQB=SEQ/QB;
constexpr int ATTN_PITCH=DM, ATTN_UNIT_ROWS=QB;
__device__ __forceinline__ int crow(int r,int hi){return (r&3)+8*(r>>2)+4*hi;}
#define SBAR() __builtin_amdgcn_sched_barrier(0)
__device__ __forceinline__ void cmask(f32x16&p0,f32x16&p1,int jb,int qrel,int hi){
  const float NEG=-INFINITY; int kb=64*jb+4*hi;
  #pragma unroll
  for(int r=0;r<16;++r){int kv=kb+(r&3)+8*(r>>2); if(kv>qrel)p0[r]=NEG; if(kv+32>qrel)p1[r]=NEG;}
}

constexpr int NSLOT=3, SLOTB=8192;
constexpr int LDS_K=0, LDS_V=NSLOT*SLOTB, LDS_WS=2*NSLOT*SLOTB, LDS_OST=LDS_WS+NW*64*4, LDS_BYTES=LDS_OST+NW*4096;
constexpr float C2=0.125f*1.4426950408889634f;
__device__ __forceinline__ void glds16(const void*gsrc,unsigned lds_dst){unsigned keep;
  asm volatile("s_mov_b32 %0, m0\n\ts_mov_b32 m0, %2\n\ts_nop 0\n\tglobal_load_lds_dwordx4 %1, off\n\ts_mov_b32 m0, %0":"=&s"(keep):"v"(gsrc),"s"(lds_dst):"memory");}
__device__ __forceinline__ float max3f(float a,float b,float c){float r;asm("v_max3_f32 %0, %1, %2, %3":"=v"(r):"v"(a),"v"(b),"v"(c));return r;}
__device__ __forceinline__ float max2f(float a,float b){float r;asm("v_max_f32_e32 %0, %1, %2":"=v"(r):"v"(a),"v"(b));return r;}
__device__ __forceinline__ float fadd_s(float a,float b){float r;asm("v_add_f32_e32 %0, %1, %2":"=v"(r):"v"(a),"v"(b));return r;}
__device__ __forceinline__ float fsub_s(float a,float b){float r;asm("v_sub_f32_e32 %0, %1, %2":"=v"(r):"v"(a),"v"(b));return r;}
typedef float f32x2_t __attribute__((ext_vector_type(2))); typedef float f32x4_t __attribute__((ext_vector_type(4))); typedef __bf16 bf16x2_t __attribute__((ext_vector_type(2)));
__device__ __forceinline__ unsigned cvtpk_s(float lo,float hi){f32x2_t v={lo,hi};bf16x2_t b=__builtin_convertvector(v,bf16x2_t);return __builtin_bit_cast(unsigned,b);}
#define WAIT_BAR(N) asm volatile("s_waitcnt vmcnt(" #N ") lgkmcnt(0)\n\ts_barrier":::"memory")

__device__ __forceinline__ void qkt(f32x16&p0,f32x16&p1,const char*Kslot,const bf16x8*qr,int r32,int hi){
  const char*kb=Kslot+hi*1024+r32*16;
  #pragma unroll
  for(int d0=0;d0<4;++d0){
    const bf16x8 b0=*reinterpret_cast<const bf16x8*>(kb+d0*2048);
    const bf16x8 b1=*reinterpret_cast<const bf16x8*>(kb+d0*2048+512);
    p0=__builtin_amdgcn_mfma_f32_32x32x16_bf16(b0,qr[d0],p0,0,0,0);p1=__builtin_amdgcn_mfma_f32_32x32x16_bf16(b1,qr[d0],p1,0,0,0);}
}
typedef __attribute__((address_space(3))) const char* lds_cptr;
typedef short v4i16_t __attribute__((ext_vector_type(4)));
__device__ __forceinline__ void kload8(bf16x8*kf,lds_cptr kp){
  kf[0]=*(const __attribute__((address_space(3))) bf16x8*)(kp);      kf[1]=*(const __attribute__((address_space(3))) bf16x8*)(kp+512);
  kf[2]=*(const __attribute__((address_space(3))) bf16x8*)(kp+2048); kf[3]=*(const __attribute__((address_space(3))) bf16x8*)(kp+2560);
  kf[4]=*(const __attribute__((address_space(3))) bf16x8*)(kp+4096); kf[5]=*(const __attribute__((address_space(3))) bf16x8*)(kp+4608);
  kf[6]=*(const __attribute__((address_space(3))) bf16x8*)(kp+6144); kf[7]=*(const __attribute__((address_space(3))) bf16x8*)(kp+6656);
}
__device__ __forceinline__ void kload2(bf16x8*kf,lds_cptr kp,int j){ kf[2*j]=*(const __attribute__((address_space(3))) bf16x8*)(kp+j*2048); kf[2*j+1]=*(const __attribute__((address_space(3))) bf16x8*)(kp+j*2048+512); }
__device__ __forceinline__ s16x4 vtr(lds_cptr p){ return __builtin_bit_cast(s16x4,__builtin_amdgcn_ds_read_tr16_b64_v4i16((__attribute__((address_space(3))) v4i16_t*)p)); }
__device__ __forceinline__ float rowmax(const f32x16&p0,const f32x16&p1){
  float a=max3f(p0[0],p0[1],p1[0]),b=max3f(p0[2],p0[3],p1[1]);a=max3f(a,p1[2],p1[3]);
  #pragma unroll
  for(int r=4;r<16;r+=4){a=max3f(a,p0[r],p0[r+1]);b=max3f(b,p0[r+2],p0[r+3]);a=max3f(a,p1[r],p1[r+1]);b=max3f(b,p1[r+2],p1[r+3]);}
  const float m=max2f(a,b);
  auto rr=__builtin_amdgcn_permlane32_swap(__float_as_uint(m),__float_as_uint(m),false,false);
  return max2f(__uint_as_float(rr[0]),__uint_as_float(rr[1]));
}
__device__ __forceinline__ void pv(f32x16*o,int vb,bf16x8 pa0,bf16x8 pa1,bf16x8 pa2,bf16x8 pa3){
  #pragma unroll
  for(int d0=0;d0<2;++d0){s16x4 lo[4],hi[4];
    #pragma unroll
    for(int ks=0;ks<4;++ks){
      asm volatile("ds_read_b64_tr_b16 %0,%1 offset:%c2":"=&v"(lo[ks]):"v"(vb),"i"(d0*4096+ks*1024):"memory");
      asm volatile("ds_read_b64_tr_b16 %0,%1 offset:%c2":"=&v"(hi[ks]):"v"(vb),"i"(d0*4096+ks*1024+512):"memory");}
    asm volatile("s_waitcnt lgkmcnt(0)":::"memory");SBAR();
    #define PK(k) (bf16x8){lo[k][0],lo[k][1],lo[k][2],lo[k][3],hi[k][0],hi[k][1],hi[k][2],hi[k][3]}
    o[d0]=__builtin_amdgcn_mfma_f32_32x32x16_bf16(pa0,PK(0),o[d0],0,0,0);
    o[d0]=__builtin_amdgcn_mfma_f32_32x32x16_bf16(pa1,PK(1),o[d0],0,0,0);
    o[d0]=__builtin_amdgcn_mfma_f32_32x32x16_bf16(pa2,PK(2),o[d0],0,0,0);
    o[d0]=__builtin_amdgcn_mfma_f32_32x32x16_bf16(pa3,PK(3),o[d0],0,0,0);
    #undef PK
  }
}

#ifndef ATTN_STORE16
#define ATTN_STORE16(p,v) asm volatile("global_store_dwordx4 %0, %1, off sc1\n\ts_nop 1" :: "v"(p), "v"(v) : "memory")
#endif
template<int THRL> __device__ __forceinline__ void attn_unit(int tid,int b,int h,int qb,const bf16*Q,const bf16*__restrict__ K,const bf16*__restrict__ V,bf16*O,char*shm,const __attribute__((address_space(3))) float*Fl){
  const int lane=tid&63,r32=lane&31,hi=lane>>5; const int wid=__builtin_amdgcn_readfirstlane(tid>>6);
  const long rowbase=(long)b*SEQ; const int q0=qb*QB;
  const bf16*Qw=Q+(rowbase+q0+wid*QBLK)*DM+h*D;
  const bf16*Kh=K+rowbase*DM+h*D,*Vh=V+rowbase*DM+h*D;
  const unsigned lds0=(unsigned)(uintptr_t)shm;
  float*wsf=(float*)(shm+LDS_WS)+wid*64;
  const bf16*ksrc=Kh+(long)lane*DM+wid*8;
  const bf16*vsrc=Vh+(long)(16*(wid&3)+(lane>>2))*DM+(wid>>2)*32+(lane&3)*8;
  const unsigned kdst=lds0+LDS_K+wid*1024, vdst=lds0+LDS_V+wid*1024;
  #define DMA_K(t,slot) glds16(ksrc+(long)(t)*KVBLK*DM,(unsigned)__builtin_amdgcn_readfirstlane(kdst+(slot)))
  #define DMA_V(t,slot) glds16(vsrc+(long)(t)*KVBLK*DM,(unsigned)__builtin_amdgcn_readfirstlane(vdst+(slot)))
  const int vb0=(int)(lds0+LDS_V)+((lane>>4)&1)*32+(lane&3)*8+(4*hi+((lane&15)>>2))*64;
  const char*Kbase=shm+LDS_K; bf16x8 kf[8];
  const lds_cptr shm3=(lds_cptr)shm; const lds_cptr kp0=shm3+LDS_K+hi*1024+r32*16; const lds_cptr vp0=shm3+LDS_V+((lane>>4)&1)*32+(lane&3)*8+(4*hi+((lane&15)>>2))*64;
  const int NT=(q0+QB)/KVBLK;
  DMA_K(0,0);DMA_V(0,0);DMA_K(1,SLOTB);
  bf16x8 qr[4];
  #pragma unroll
  for(int d0=0;d0<4;++d0)qr[d0]=*reinterpret_cast<const bf16x8*>(&Qw[(long)r32*DM+d0*16+hi*8]);
  const float ftq=Fl[q0+wid*QBLK+r32];
  float mhat=0.f,nm=ftq,l_reg=0.f;f32x16 o[2];o[0]=f32x16{};o[1]=f32x16{};
  #define CINIT(C0,C1,t) do{ const __attribute__((address_space(3))) float*fp_=Fl+(t)*64+4*hi; _Pragma("unroll") for(int g_=0;g_<4;++g_){ const f32x4_t a_=*(const __attribute__((address_space(3))) f32x4_t*)(fp_+8*g_),b_=*(const __attribute__((address_space(3))) f32x4_t*)(fp_+32+8*g_); _Pragma("unroll") for(int i_=0;i_<4;++i_){C0[4*g_+i_]=nm-a_[i_];C1[4*g_+i_]=nm-b_[i_];} } }while(0)
  const int qrel=wid*QBLK+r32;
  #define CMASK(P0,P1,t) do{int jb_=(t)-(NT-4); if(jb_>=0)cmask(P0,P1,jb_,qrel,hi);}while(0)
  bool resc=false;
  #define START(P0,P1) do{ const float rm=rowmax(P0,P1); resc=false; \
    { const float dl=rm; mhat=fadd_s(mhat,dl); \
      _Pragma("unroll") for(int r=0;r<16;++r){P0[r]=fsub_s(P0[r],dl);P1[r]=fsub_s(P1[r],dl);} \
      nm=ftq-mhat; } \
    _Pragma("unroll") for(int r=0;r<16;++r)P0[r]=__builtin_amdgcn_exp2f(P0[r]); }while(0)
  #define RESC() do{ if(resc){ asm volatile("s_waitcnt lgkmcnt(0)":::"memory"); \
      _Pragma("unroll") for(int d_=0;d_<2;++d_) _Pragma("unroll") for(int r=0;r<16;++r)o[d_][r]*=wsf[crow(r,hi)]; } }while(0)
  f32x16 pA0,pA1,pB0,pB1;
  int sl_prev=0,sl_cur=0,sl_next=SLOTB;
  #define ROT() do{sl_prev=sl_cur;sl_cur=sl_next;sl_next=(sl_next==(NSLOT-1)*SLOTB)?0:sl_next+SLOTB;}while(0)
  DMA_K(2,2*SLOTB);
  WAIT_BAR(3);
  CINIT(pA0,pA1,0); qkt(pA0,pA1,Kbase,qr,r32,hi);asm volatile("s_nop 15\n\ts_nop 7":"+v"(pA0),"+v"(pA1));CMASK(pA0,pA1,0);
  START(pA0,pA1);
  _Pragma("unroll") for(int r=0;r<16;++r)pA1[r]=__builtin_amdgcn_exp2f(pA1[r]);
  WAIT_BAR(0);
  DMA_K(3,0);DMA_V(1,SLOTB);
  ROT();
  kload8(kf,kp0+sl_cur);
  WAIT_BAR(2);
  s16x4 vlo[8],vhi[8]; u32x4 pw0,pw1,pw2,pw3;
  #define PKW(P,B) cvtpk_s(P[B],P[B+1])
  #define PAF(k) __builtin_bit_cast(bf16x8,pw##k)
  #define VFR(i) (bf16x8){vlo[i][0],vlo[i][1],vlo[i][2],vlo[i][3],vhi[i][0],vhi[i][1],vhi[i][2],vhi[i][3]}
  #define PIN(x) asm volatile("":"+v"(x))
  #define MX3(a,b,c) __builtin_fmaxf(__builtin_fmaxf((a),(b)),(c))
  #define GAPA(MF,A0,A1,A2,A3,W0,W1,PW) do{ MF; sacc+=A0; sacc+=A1; sacc+=A2; sacc+=A3; PIN(sacc); W0; W1; PIN(PW); SBAR(); }while(0)
  #define EX(v) __builtin_amdgcn_exp2f(v)
  #define GAPB(MF,X,B) do{ MF; X[B]=EX(X[B]); X[B+1]=EX(X[B+1]); X[B+2]=EX(X[B+2]); X[B+3]=EX(X[B+3]); PIN(X); SBAR(); }while(0)
  #define VRD(i) do{ vlo[i]=vtr(vp_+(((i)>>2)*4096+((i)&3)*1024)); vhi[i]=vtr(vp_+(((i)>>2)*4096+((i)&3)*1024+512)); }while(0)
  #define KRD(G,j) do{ if(G){ kload2(kf,kp0+sl_next,j); SBAR(); } }while(0)
  #define STEP(C0,C1,P0,P1,t,GK,GV,GL) do{ SBAR(); \
    const lds_cptr vp_=vp0+sl_prev; \
    CINIT(C0,C1,t); SBAR(); \
    VRD(0); SBAR(); float sacc=(P0[0]+P0[1]); \
    GAPA(C0=__builtin_amdgcn_mfma_f32_32x32x16_bf16(kf[0],qr[0],C0,0,0,0), P0[2],P0[3],P0[4],P0[5],     pw0[0]=PKW(P0,0), pw0[1]=PKW(P0,2), pw0); \
    VRD(4); SBAR(); GAPA(C1=__builtin_amdgcn_mfma_f32_32x32x16_bf16(kf[1],qr[0],C1,0,0,0), P0[6],P0[7],P0[8],P0[9],     pw0[2]=PKW(P0,4), pw0[3]=PKW(P0,6), pw0); \
    VRD(1); SBAR(); GAPA(C0=__builtin_amdgcn_mfma_f32_32x32x16_bf16(kf[2],qr[1],C0,0,0,0),   P0[10],P0[11],P0[12],P0[13], pw1[0]=PKW(P0,8), pw1[1]=PKW(P0,10), pw1); \
    VRD(5); SBAR(); GAPA(C1=__builtin_amdgcn_mfma_f32_32x32x16_bf16(kf[3],qr[1],C1,0,0,0),   P0[14],P0[15],P1[0],P1[1],   pw1[2]=PKW(P0,12),pw1[3]=PKW(P0,14), pw1); \
    VRD(2); SBAR(); GAPA(C0=__builtin_amdgcn_mfma_f32_32x32x16_bf16(kf[4],qr[2],C0,0,0,0),   P1[2],P1[3],P1[4],P1[5],     pw2[0]=PKW(P1,0), pw2[1]=PKW(P1,2), pw2); \
    VRD(6); SBAR(); GAPA(C1=__builtin_amdgcn_mfma_f32_32x32x16_bf16(kf[5],qr[2],C1,0,0,0),   P1[6],P1[7],P1[8],P1[9],     pw2[2]=PKW(P1,4), pw2[3]=PKW(P1,6), pw2); \
    VRD(3); SBAR(); GAPA(C0=__builtin_amdgcn_mfma_f32_32x32x16_bf16(kf[6],qr[3],C0,0,0,0),   P1[10],P1[11],P1[12],P1[13], pw3[0]=PKW(P1,8), pw3[1]=PKW(P1,10), pw3); \
    VRD(7); SBAR(); GAPA(C1=__builtin_amdgcn_mfma_f32_32x32x16_bf16(kf[7],qr[3],C1,0,0,0),   P1[14],P1[15],0.f,0.f,       pw3[2]=PKW(P1,12),pw3[3]=PKW(P1,14), pw3); \
    l_reg+=sacc; \
    if(GK){DMA_K((t)+3,sl_cur);} if(GV){DMA_V((t)+1,sl_next);} \
    CMASK(C0,C1,t); \
    { float a=MX3(C0[0],C0[1],C1[0]),b=MX3(C0[2],C0[3],C1[1]); a=MX3(a,C1[2],C1[3]); \
      _Pragma("unroll") for(int r=4;r<16;r+=4){a=MX3(a,C0[r],C0[r+1]);b=MX3(b,C0[r+2],C0[r+3]);a=MX3(a,C1[r],C1[r+1]);b=MX3(b,C1[r+2],C1[r+3]);} \
      float rm=__builtin_fmaxf(a,b); { auto rr=__builtin_amdgcn_permlane32_swap(__float_as_uint(rm),__float_as_uint(rm),false,false); rm=__builtin_fmaxf(__uint_as_float(rr[0]),__uint_as_float(rr[1])); } \
      resc=false; \
      if(__builtin_expect(__any(rm>(float)THRL),0)){ const float dl=__builtin_fmaxf(rm,0.f); mhat+=dl; \
        _Pragma("unroll") for(int r=0;r<16;++r){C0[r]-=dl;C1[r]-=dl;} \
        nm=ftq-mhat; \
        const float f=__builtin_amdgcn_exp2f(-dl); l_reg*=f; if(hi==0)wsf[r32]=f; resc=true; } } \
    SBAR(); \
    GAPB(o[0]=__builtin_amdgcn_mfma_f32_32x32x16_bf16(PAF(0),VFR(0),o[0],0,0,0), C0,0); \
    GAPB(o[1]=__builtin_amdgcn_mfma_f32_32x32x16_bf16(PAF(0),VFR(4),o[1],0,0,0), C0,4); \
    KRD(GL,0); GAPB(o[0]=__builtin_amdgcn_mfma_f32_32x32x16_bf16(PAF(1),VFR(1),o[0],0,0,0), C0,8); \
    KRD(GL,1); GAPB(o[1]=__builtin_amdgcn_mfma_f32_32x32x16_bf16(PAF(1),VFR(5),o[1],0,0,0), C0,12); \
    KRD(GL,2); GAPB(o[0]=__builtin_amdgcn_mfma_f32_32x32x16_bf16(PAF(2),VFR(2),o[0],0,0,0), C1,0); \
    KRD(GL,3); GAPB(o[1]=__builtin_amdgcn_mfma_f32_32x32x16_bf16(PAF(2),VFR(6),o[1],0,0,0), C1,4); \
    GAPB(o[0]=__builtin_amdgcn_mfma_f32_32x32x16_bf16(PAF(3),VFR(3),o[0],0,0,0), C1,8); \
    GAPB(o[1]=__builtin_amdgcn_mfma_f32_32x32x16_bf16(PAF(3),VFR(7),o[1],0,0,0), C1,12); \
    }while(0)
  int t=1;
  #undef CMASK
  #define CMASK(P0,P1,t) do{}while(0)
  for(;t+5<NT;t+=2){
    STEP(pB0,pB1,pA0,pA1,t,true,true,true);     WAIT_BAR(2); RESC(); ROT();
    STEP(pA0,pA1,pB0,pB1,t+1,true,true,true);   WAIT_BAR(2); RESC(); ROT();
  }
  #undef CMASK
  #define CMASK(P0,P1,t) do{int jb_=(t)-(NT-4); if(jb_>=0)cmask(P0,P1,jb_,qrel,hi);}while(0)
  #define ENDW(tt) do{ if((tt)+3<NT){WAIT_BAR(2);} else if((tt)+2<NT){WAIT_BAR(1);} else {WAIT_BAR(0);} }while(0)
  for(;t+1<NT;t+=2){
    STEP(pB0,pB1,pA0,pA1,t,(t+3<NT),(t+1<NT),(t+1<NT));       ENDW(t);   RESC(); ROT();
    STEP(pA0,pA1,pB0,pB1,t+1,(t+4<NT),(t+2<NT),(t+2<NT));     ENDW(t+1); RESC(); ROT();
  }
  STEP(pB0,pB1,pA0,pA1,NT-1,false,false,false); RESC();
  { float sacc=pB0[0]+pB0[1]; _Pragma("unroll") for(int r=2;r<16;++r)sacc+=pB0[r]; _Pragma("unroll") for(int r=0;r<16;++r)sacc+=pB1[r]; l_reg+=sacc;
    pw0=(u32x4){PKW(pB0,0),PKW(pB0,2),PKW(pB0,4),PKW(pB0,6)};pw1=(u32x4){PKW(pB0,8),PKW(pB0,10),PKW(pB0,12),PKW(pB0,14)};pw2=(u32x4){PKW(pB1,0),PKW(pB1,2),PKW(pB1,4),PKW(pB1,6)};pw3=(u32x4){PKW(pB1,8),PKW(pB1,10),PKW(pB1,12),PKW(pB1,14)};
    SBAR(); pv(o,vb0+sl_cur,PAF(0),PAF(1),PAF(2),PAF(3)); }
  #undef PKW
  #undef PAF
  #undef VFR
  #undef PIN
  #undef MX3
  #undef GAPA
  #undef GAPB
  #undef EX
  #undef VRD
  #undef KRD
  #undef STEP
  #undef ENDW
  {auto rr=__builtin_amdgcn_permlane32_swap(__float_as_uint(l_reg),__float_as_uint(l_reg),false,false);l_reg=__uint_as_float(rr[0])+__uint_as_float(rr[1]);}
  if(hi==0)wsf[32+r32]=l_reg;asm volatile("s_waitcnt lgkmcnt(0)":::"memory");
  float rli[16];
  #pragma unroll
  for(int r=0;r<16;++r)rli[r]=__builtin_amdgcn_rcpf(wsf[32+crow(r,hi)]);
  bf16*Ow=O+(rowbase+q0+wid*QBLK)*DM+h*D;
  { bf16*stg=(bf16*)(shm+LDS_OST)+wid*2048;
    #pragma unroll
    for(int r=0;r<16;++r){const int orow=crow(r,hi);
      #pragma unroll
      for(int d0=0;d0<2;++d0)stg[orow*64+d0*32+r32]=__float2bfloat16(o[d0][r]*rli[r]);}
    asm volatile("s_waitcnt lgkmcnt(0)":::"memory");
    #pragma unroll
    for(int i=0;i<4;++i){const int row=i*8+(lane>>3),ch=lane&7; const u32x4 v=*(const u32x4*)(stg+row*64+ch*8); ATTN_STORE16(Ow+(long)row*DM+ch*8,v);} }
  asm volatile("s_waitcnt lgkmcnt(0)\n\ts_barrier":::"memory");
  #undef DMA_K
  #undef DMA_V
  #undef CMASK
  #undef CINIT
  #undef START
  #undef RESC
  #undef ROT
}
constexpr int ATTN_LDS_BYTES=LDS_BYTES;
#undef SBAR
#undef WAIT_BAR
}

constexpr int ATT_FL_OFF = 86016;
__device__ __forceinline__ void attn_phase(const Frame& F) {
    static_assert(attn_body::ATTN_LDS_BYTES <= ATT_FL_OFF && ATT_FL_OFF + 16384 <= RING_BYTES, "attention LDS map");
    const attn_body::bf16* Q = (const attn_body::bf16*)seg(F, S_Q); const attn_body::bf16* K = (const attn_body::bf16*)seg(F, S_K); const attn_body::bf16* V = (const attn_body::bf16*)seg(F, S_V);
    const float* Fc = (const float*)(F.ws + WS_FC);
    LAS float* Fl = (LAS float*)(F.lds + ATT_FL_OFF);
    const int v0 = (F.G % 8 == 0) ? (F.bid % 8) * (F.G / 8) + F.bid / 8 : F.bid;
#pragma nounroll
    for (int vv = v0; vv < 512; vv += F.G) {
        const int pass = vv >> 8, v = vv & 255;
        const int bh = pass * 32 + (v >> 3), s = v & 7, b = bh >> 3, h = bh & 7;
        __syncthreads();
        for (int i = F.tid; i < 1024; i += NTHR) { const f32x4 x = *(const f32x4*)(Fc + (size_t)bh * SEQ + 4 * i); *(LAS f32x4*)(Fl + 4 * i) = x * LOG2E; }
        asm volatile("s_waitcnt vmcnt(0) lgkmcnt(0)" ::: "memory");
        __syncthreads();
#pragma nounroll
        for (int i = 0; i < 2; ++i) { const int qb = i ? 15 - s : s;
            int t2 = F.tid; asm volatile("" : "+v"(t2));
            attn_body::attn_unit<8>(t2, b, h, qb, Q, K, V, (attn_body::bf16*)Q, (char*)F.lds, Fl); }
    }
}
constexpr int PPL = 13, NPH = 1 + PPL * DEPTH;
__device__ __forceinline__ void make_frame(Frame& F, const Args& args, unsigned char* lds) {
    GAS unsigned char* w_ = (GAS unsigned char*)args.ws; GAS float* o_ = (GAS float*)args.out; int b_ = blockIdx.x, g_ = gridDim.x;
    asm volatile("" : "+s"(w_), "+s"(o_), "+s"(b_), "+s"(g_));
    F.lds = (LAS unsigned char*)lds; F.MISC = (volatile LAS unsigned*)(F.lds + MISC_OFF);
    unsigned z_ = 0u; asm volatile("" : "+v"(z_)); int ln_ = __builtin_amdgcn_mbcnt_hi(~0u, __builtin_amdgcn_mbcnt_lo(~0u, z_));
    unsigned tk_ = ((volatile LAS unsigned*)(F.lds + TICKET_OFF))[(unsigned)__builtin_amdgcn_s_getreg(63492) & 63u];
    tk_ = __builtin_amdgcn_readfirstlane(tk_) & 7u; asm volatile("" : "+v"(ln_));
    F.lane = ln_; F.wave = (int)tk_; F.tid = (int)tk_ * 64 + ln_; F.G = g_; F.bid = b_; F.cpass = 0;
    F.ws = (unsigned char*)w_; F.ctl = (gu32*)(F.ws + WS_CTL); F.XF = (float*)o_; F.XB = (bf16*)(F.ws + WS_XB); F.H = (bf16*)(F.ws + WS_H);
}
struct FillSpec { int l, kind, k; };
__host__ __device__ constexpr FillSpec fill_spec(int PH) {
    if (PH == 0) return {0, 0, 0};
    const int l = (PH - 1) / 13, p = (PH - 1) % 13;
    if (l == 0) { switch (p) { case 0: return {0, 0, 1}; case 3: return {0, 0, 2}; case 4: return {0, 0, 3}; case 5: return {0, 0, 4}; case 6: return {0, 0, 5};
                               case 7: return {0, 1, 0}; case 9: return {0, 1, 1}; case 11: return {1, 0, 0}; case 12: return {1, 0, 1}; default: return {0, -1, 0}; } }
    switch (p) { case 0: return {1, 0, 2}; case 3: return {1, 0, 3}; case 4: return {1, 0, 4}; case 5: return {1, 0, 5}; case 6: return {1, 0, 6};
                 case 7: return {1, 1, 0}; case 9: return {1, 1, 1}; default: return {1, -1, 0}; }
}
constexpr int FILLW = 7;
__host__ __device__ constexpr int fill_done(int l, int kind) { return FILLW * (kind == 0 ? (l == 0 ? 6 : 7) : 2); }
struct NoFill { __device__ __forceinline__ void operator()() const {} };
struct ExpertFill {
    const Frame& B; int l, kind, k; bool on;
    __device__ __forceinline__ void operator()() const {
        if (!on || B.wave == 0 || B.wave > FILLW) return;
        const int i = FILLW * k + (B.wave - 1);
        expert_item(B, l, kind, B.bid + 256 * i, (LAS float*)(B.lds + B.wave * 16384));
    }
};
template <int PH, int MASK>
__device__ __forceinline__ void run_phase(const Args& args, unsigned char* lds, int lo, int hi, int pass, int npass, unsigned xcc) {
    if (!(PH >= lo && PH < hi)) return;
    constexpr int l = PH == 0 ? 0 : (PH - 1) / PPL, p = PH == 0 ? 13 : (PH - 1) % PPL;
    Frame F; make_frame(F, args, lds); F.cpass = pass * 128;
    const bool fill_on = (lo == 0 && hi == NPH && F.G == 256);
    LAS int* pst = (LAS int*)(F.lds + XTRA_OFF); LAS int* cntl = (LAS int*)(F.lds + XTRA_OFF + 256); LAS int* tile_e = (LAS int*)(F.lds + XTRA_OFF + 512); (void)pst; (void)cntl; (void)tile_e;
    constexpr int probe_ = SKIP_PH >= 0 ? SKIP_PH : SOLO_PH;
    const bool skip_ = (pass + 1 < npass) && ((SKIP_PH >= 0) ? (p == probe_) : (p != probe_));
    if (!skip_) {
        if constexpr (((MASK >> p) & 1) != 0) {
            if constexpr (p == 13) {
                convert_small(F, args, 0);
                __syncthreads();
                ln_rows<0>(F, args, inptr(F, 1), inptr(F, 2), 0);
            } else if constexpr (p == 0) {
                fox_scan(F);
                SchedInProj S{(const char*)(F.ws + WS_XB8), (const char*)(F.ws + WS_WIN), F.G, F.bid};
                EpiInProj E{F.H, (const float*)(F.ws + WS_BIAS), (const float*)(F.ws + WS_SA), (const unsigned*)(F.ctl + CW_CMAX) + l * (NH / 32)};
                pg8::gemm_phase(F.lds, F.tid, S, E);
            } else if constexpr (p == 1) { attn_phase(F);
            } else if constexpr (p == 2) { sgu_mfma(F, l);
            } else if constexpr (p == 3) { mlstm_m1_mfma(F, l);
            } else if constexpr (p == 4) { mlstm_m2(F);
            } else if constexpr (p == 5) { mlstm_m3_mfma(F, l);
            } else if constexpr (p == 6) {
                SchedMerge S{(const char*)F.H, (const char*)(F.ws + WS_WBR), F.G, F.bid};
                EpiMerge E{F.H, (bf16*)(F.ws + WS_MERGED)};
                pg8::gemm_phase(F.lds, F.tid, S, E);
            } else if constexpr (p == 7) {
                SchedPlain<1024, T / 256, 4, 8, 4> S{(const char*)(F.ws + WS_MERGED), (const char*)(F.ws + WS_WOUT), F.G, F.bid};
                EpiWout E{F.XB};
                pg8::gemm_phase(F.lds, F.tid, S, E);
            } else if constexpr (p == 8) {
                ln1_route(F, args, l);
            } else if constexpr (p == 9) { convert_experts(F, l, fill_on ? fill_done(l, 0) : 0, fill_on ? fill_done(l, 1) : 0);
            } else if constexpr (p == 10) {
                moe_tiles(F, l, pst, cntl, tile_e);
                SchedMoe1 S{(const char*)(F.ws + WS_XB8), (const char*)wgu_ptr(F), (const int*)(F.ws + WS_ENT2), __builtin_amdgcn_readfirstlane(pst[NEXP]), tile_e, pst, cntl, F.G, F.bid};
                EpiMoe1 E{(unsigned char*)(F.ws + WS_HID)};
                pg8::gemm_phase(F.lds, F.tid, S, E);
            } else if constexpr (p == 11) {
                moe_tiles(F, l, pst, cntl, tile_e);
                SchedMoe2 S{(const char*)(F.ws + WS_HID), (const char*)(F.ws + WS_WD), __builtin_amdgcn_readfirstlane(pst[NEXP]), tile_e, pst, cntl, F.G, F.bid};
                EpiMoe2 E{(unsigned char*)(F.ws + WS_YBUF), (const int*)(F.ws + WS_ENT2)};
                pg8::gemm_phase(F.lds, F.tid, S, E);
            } else {
                constexpr bool more = (l + 1 < DEPTH);
                ln_rows<2>(F, args, inptr(F, 21) + (size_t)l * D, inptr(F, 22) + (size_t)l * D, more ? l + 1 : -1);
                if constexpr (more) convert_small(F, args, l + 1);
            }
        }
    }
    constexpr bool nobar = (p == 1 || p == 2 || p == 8);
    if ((PH + 1 < hi || pass + 1 < npass) && !nobar) {
        Frame B; make_frame(B, args, lds);
        XcdBarrier bar; bar.bar = (unsigned*)(B.ctl + CW_BAR); bar.x = xcc; bar.st = B.MISC + 8;
        constexpr FillSpec fs = fill_spec(PH);
        if constexpr (fs.kind >= 0) xcd_barrier(bar, B.tid == 0, ExpertFill{B, fs.l, fs.kind, fs.k, fill_on});
        else xcd_barrier(bar, B.tid == 0, NoFill{});
    }
}
template <int MASK, int... PHS>
__device__ __forceinline__ void run_all(const Args& args, unsigned char* lds, int lo, int hi, int pass, int npass, unsigned xcc, std::integer_sequence<int, PHS...>) {
    (run_phase<PHS, MASK>(args, lds, lo, hi, pass, npass, xcc), ...);
}
template <int MASK> __global__ void __launch_bounds__(NTHR, 2) fwd_kernel(Args args) {
    extern __shared__ __attribute__((aligned(16))) unsigned char lds[];
    { LAS unsigned char* l3 = (LAS unsigned char*)lds; const int tid0 = threadIdx.x;
      for (int u = tid0; u < (LDS_BYTES - LDSCTL_OFF) / 4; u += NTHR) ((LAS unsigned*)(l3 + LDSCTL_OFF))[u] = 0u;
      __syncthreads();
      if (tid0 < 23) ((LAS unsigned long long*)(l3 + INTBL_OFF))[tid0] = (unsigned long long)args.in[tid0];
      if ((tid0 & 63) == 0) ((LAS unsigned*)(l3 + TICKET_OFF))[(unsigned)__builtin_amdgcn_s_getreg(63492) & 63u] = (unsigned)(tid0 >> 6);
      __syncthreads(); }
    const int lo = args.ph_lo, hi = args.ph_hi;
    unsigned xcc = 0;
    if (hi - lo > 1) { const XcdBarrier b0 = xcd_barrier_post((unsigned*)((gu32*)(args.ws + WS_CTL) + CW_BAR), (volatile LAS unsigned*)((LAS unsigned char*)lds + MISC_OFF) + 8); xcc = b0.x; }
    constexpr int NPASS = (SKIP_PH >= 0 || SOLO_PH >= 0) ? 2 : 1;
    if constexpr (NPASS == 2) run_all<MASK>(args, lds, lo, hi, 0, NPASS, xcc, std::make_integer_sequence<int, NPH>{});
    run_all<MASK>(args, lds, lo, hi, NPASS - 1, NPASS, xcc, std::make_integer_sequence<int, NPH>{});
}

#ifdef ONLY_MASK
template __global__ void fwd_kernel<ONLY_MASK>(Args);
#else
#if PROBE_PH >= 0
__global__ void probe_fill_kernel(float* out, const unsigned long long* ts) {
    unsigned long long dt = 0;
    if (PROBE_PH == 13) dt = ts[1] - ts[0]; else if (PROBE_PH == 14) dt = ts[NPH] - ts[0]; else { for (int l = 0; l < DEPTH; ++l) dt += ts[2 + l * PPL + PROBE_PH] - ts[1 + l * PPL + PROBE_PH]; }
    const float c = sqrtf((float)dt * 0.001f);
    for (size_t i = (size_t)blockIdx.x * blockDim.x + threadIdx.x; i < (size_t)T * D; i += (size_t)gridDim.x * blockDim.x) out[i] = c;
}
#endif
__global__ void fill_kernel(float* out, int n, float c) { for (int i = blockIdx.x * blockDim.x + threadIdx.x; i < n; i += gridDim.x * blockDim.x) out[i] = c; }

#ifndef N_LAUNCH_MODE
#define N_LAUNCH_MODE 1
#endif
extern "C" void kernel_launch(void* const* d_in, const int* in_sizes, int n_in, void* d_out, int out_size, void* d_ws, size_t ws_size, hipStream_t stream) {
    static int grid = 0;
    if (grid == 0) {
        int dev = 0, cus = 0;
        if (hipGetDevice(&dev) != hipSuccess || hipDeviceGetAttribute(&cus, hipDeviceAttributeMultiprocessorCount, dev) != hipSuccess) { grid = -1; return; }
        if (hipFuncSetAttribute((const void*)fwd_kernel<0x3fff>, hipFuncAttributeMaxDynamicSharedMemorySize, LDS_BYTES) != hipSuccess) { grid = -1; return; }
        int per_cu = 0;
        if (hipOccupancyMaxActiveBlocksPerMultiprocessor(&per_cu, (const void*)fwd_kernel<0x3fff>, NTHR, LDS_BYTES) != hipSuccess || per_cu < 1) { (void)hipGetLastError(); grid = -2; }
        else { (void)hipGetLastError(); grid = cus; }
#if N_LAUNCH_MODE != 1
#define SCASE(Q) (void)hipFuncSetAttribute((const void*)fwd_kernel<(1 << Q)>, hipFuncAttributeMaxDynamicSharedMemorySize, LDS_BYTES);
        SCASE(0) SCASE(1) SCASE(2) SCASE(3) SCASE(4) SCASE(5) SCASE(6) SCASE(7) SCASE(8) SCASE(9) SCASE(10) SCASE(11) SCASE(12) SCASE(13)
#undef SCASE
#endif
    }
    if (grid == -2) { hipLaunchKernelGGL(fill_kernel, dim3(1024), dim3(256), 0, stream, (float*)d_out, out_size, 7.0f); return; }
    if (grid < 0) return;
    if (n_in != 23 || out_size != T * D || ws_size < WS_END) {
        hipLaunchKernelGGL(fill_kernel, dim3(1024), dim3(256), 0, stream, (float*)d_out, out_size, (n_in != 23 || out_size != T * D) ? 5.0f : 3.0f);
        return;
    }
    (void)hipMemsetAsync((char*)d_ws + WS_CTL, 0, CTL_ZERO_BYTES, stream);
    Args a{};
    for (int i = 0; i < 23; ++i) a.in[i] = (const float*)d_in[i];
    a.out = (float*)d_out; a.ws = (unsigned char*)d_ws;
#if N_LAUNCH_MODE == 1
    a.ph_lo = 0; a.ph_hi = NPH;
    hipLaunchKernelGGL(fwd_kernel<0x3fff>, dim3(grid), dim3(NTHR), LDS_BYTES, stream, a);
#if PROBE_PH >= 0
    hipLaunchKernelGGL(probe_fill_kernel, dim3(2048), dim3(256), 0, stream, (float*)d_out, (const unsigned long long*)((char*)d_ws + WS_SM + 6 * MiB));
#endif
#else
    for (int p = 0; p < NPH; ++p) { a.ph_lo = p; a.ph_hi = p + 1; const int q = p == 0 ? 13 : (p - 1) % PPL;
        switch (q) {
#define LCASE(Q) case Q: hipLaunchKernelGGL(fwd_kernel<(1 << Q)>, dim3(grid), dim3(NTHR), LDS_BYTES, stream, a); break;
            LCASE(0) LCASE(1) LCASE(2) LCASE(3) LCASE(4) LCASE(5) LCASE(6) LCASE(7) LCASE(8) LCASE(9) LCASE(10) LCASE(11) LCASE(12) LCASE(13)
#undef LCASE
        } }
#endif
}
#endif
```
